# Optimizing an MI355X kernel written in HIP

```python
import jax, jax.numpy as jnp
from jax import lax
import numpy as np

D_MODEL = 1024
BATCH = 8
SEQ = 4096
DEPTH = 1

RET_HEADS = 4
RET_DK = 128
RET_DV = 256
RET_CHUNK = 128
RET_QK = RET_HEADS * RET_DK
RET_V = RET_HEADS * RET_DV
ROPE_BASE = 10000.0
CONV_WIDTH = 1024
CONV_K = 3
IN_SPLITS = (RET_QK, RET_QK, RET_V, RET_V, CONV_WIDTH, CONV_WIDTH, CONV_WIDTH, D_MODEL, D_MODEL)
IN_WIDTH = 2 * RET_QK + 2 * RET_V + 3 * CONV_WIDTH + 2 * D_MODEL
PEER_HEADS = 8
PEER_NKEYS = 128
PEER_NEXPERTS = PEER_NKEYS * PEER_NKEYS
PEER_QDIM = 256
PEER_HALF = PEER_QDIM // 2
PEER_TOPK = 16
PEER_TOK_BLOCK = 128
PLE_DIM = 256
EPS = 1e-6

kernel_name = "hybrid_retention_shortconv_peer_block"


def rms_norm(x, g):
    xf = x.astype(jnp.float32)
    y = xf * lax.rsqrt(jnp.mean(xf * xf, axis=-1, keepdims=True) + EPS)
    return (y * g.astype(jnp.float32)).astype(x.dtype)


def rotary(x):
    s, half = x.shape[1], x.shape[-1] // 2
    inv = ROPE_BASE ** (-jnp.arange(half, dtype=jnp.float32) / half)
    ang = jnp.arange(s, dtype=jnp.float32)[:, None] * inv[None, :]
    cos = jnp.cos(ang)[None, :, None, :]
    sin = jnp.sin(ang)[None, :, None, :]
    x1, x2 = x[..., :half], x[..., half:]
    out = jnp.concatenate([x1 * cos - x2 * sin, x1 * sin + x2 * cos], axis=-1)
    return out.astype(x.dtype)


def chunkwise_retention(q, k, v):
    b, s, h, dk = q.shape
    dv = v.shape[-1]
    c = RET_CHUNK
    n = s // c
    log_gamma = jnp.log1p(-(2.0 ** (-5.0 - jnp.arange(h, dtype=jnp.float32))))
    pos = jnp.arange(c, dtype=jnp.float32)
    diff = pos[:, None] - pos[None, :]
    causal = diff >= 0
    decay = jnp.where(causal[None], jnp.exp(log_gamma[:, None, None] * jnp.where(causal, diff, 0.0)[None]), 0.0)
    xi = jnp.exp(log_gamma[:, None] * (pos[None, :] + 1.0))
    zeta = jnp.exp(log_gamma[:, None] * (c - 1.0 - pos[None, :]))
    chunk_decay = jnp.exp(log_gamma * c)
    qc = q.reshape(b, n, c, h, dk)
    kc = k.reshape(b, n, c, h, dk)
    vc = v.reshape(b, n, c, h, dv)
    scores = jnp.einsum('bnihd,bnjhd->bnhij', qc, kc).astype(jnp.float32) * decay[None, None]
    intra = jnp.einsum('bnhij,bnjhe->bnihe', scores, vc.astype(jnp.float32))
    kv = jnp.einsum('bnjhd,hj,bnjhe->bnhde', kc.astype(jnp.float32), zeta, vc.astype(jnp.float32))

    def step(state, kv_n):
        return state * chunk_decay[None, :, None, None] + kv_n, state

    init = jnp.zeros((b, h, dk, dv), jnp.float32)
    _, prev = lax.scan(step, init, jnp.moveaxis(kv, 1, 0))
    prev = jnp.moveaxis(prev, 0, 1)
    cross = jnp.einsum('bnihd,hi,bnhde->bnihe', qc.astype(jnp.float32), xi, prev)
    return (intra + cross).reshape(b, s, h, dv)


def head_group_norm(y):
    mu = jnp.mean(y, axis=-1, keepdims=True)
    yc = y - mu
    return yc * lax.rsqrt(jnp.mean(yc * yc, axis=-1, keepdims=True) + EPS)


def causal_short_conv(z, w, bias):
    width = z.shape[-1]
    y = lax.conv_general_dilated(z, w[:, None, :].astype(z.dtype), window_strides=(1,),
                                 padding=[(CONV_K - 1, 0)],
                                 dimension_numbers=('NWC', 'WIO', 'NWC'),
                                 feature_group_count=width)
    return y + bias.astype(z.dtype)


def peer_ffn(a, w_q, k1, k2, u, v):
    b, s, d = a.shape
    t = b * s
    af = a.reshape(t, d)
    q = (af @ w_q).reshape(t, PEER_HEADS, 2, PEER_HALF)
    s1 = jnp.einsum('thd,hnd->thn', q[:, :, 0], k1).astype(jnp.float32)
    s2 = jnp.einsum('thd,hnd->thn', q[:, :, 1], k2).astype(jnp.float32)
    v1, i1 = lax.top_k(s1, PEER_TOPK)
    v2, i2 = lax.top_k(s2, PEER_TOPK)
    cand_s = (v1[..., :, None] + v2[..., None, :]).reshape(t, PEER_HEADS, PEER_TOPK * PEER_TOPK)
    cand_i = (i1[..., :, None] * PEER_NKEYS + i2[..., None, :]).reshape(t, PEER_HEADS, PEER_TOPK * PEER_TOPK)
    top_s, top_pos = lax.top_k(cand_s, PEER_TOPK)
    idx = jnp.take_along_axis(cand_i, top_pos, axis=-1)
    gate = jax.nn.softmax(top_s, axis=-1)
    n_sel = PEER_HEADS * PEER_TOPK
    nb = t // PEER_TOK_BLOCK
    idx = idx.reshape(nb, PEER_TOK_BLOCK, n_sel)
    gate = gate.reshape(nb, PEER_TOK_BLOCK, n_sel)
    xb_all = af.reshape(nb, PEER_TOK_BLOCK, d)

    def block(args):
        xb, ib, gb = args
        ue = jnp.take(u, ib, axis=0)
        act = jax.nn.gelu(jnp.einsum('td,ted->te', xb, ue).astype(jnp.float32), approximate=False)
        ve = jnp.take(v, ib, axis=0)
        return jnp.einsum('te,ted->td', (gb * act).astype(xb.dtype), ve)

    out = lax.map(block, (xb_all, idx, gate))
    return out.reshape(b, s, d)


def setup_inputs(seed: int = 0) -> dict:
    key = jax.random.key(seed)
    ks = jax.random.split(key, 24)
    f32 = jnp.float32
    nrm = lambda k, shape, scale: jax.random.normal(k, shape, f32) * scale
    return {
        "x": nrm(ks[0], (BATCH, SEQ, D_MODEL), 1.0),
        "p": nrm(ks[1], (DEPTH, BATCH, SEQ, PLE_DIM), 1.0),
        "g_mix": 1.0 + nrm(ks[2], (DEPTH, D_MODEL), 0.01),
        "w_in": nrm(ks[3], (DEPTH, D_MODEL, IN_WIDTH), D_MODEL ** -0.5),
        "conv_w": nrm(ks[4], (DEPTH, CONV_K, CONV_WIDTH), CONV_K ** -0.5),
        "conv_b": nrm(ks[5], (DEPTH, CONV_WIDTH), 0.01),
        "w_ret_up": nrm(ks[6], (DEPTH, RET_V, D_MODEL), RET_V ** -0.5),
        "w_conv_up": nrm(ks[7], (DEPTH, CONV_WIDTH, D_MODEL), CONV_WIDTH ** -0.5),
        "w_out": nrm(ks[8], (DEPTH, D_MODEL, D_MODEL), D_MODEL ** -0.5),
        "g_ffn": 1.0 + nrm(ks[9], (DEPTH, D_MODEL), 0.01),
        "w_peer_q": nrm(ks[10], (DEPTH, D_MODEL, PEER_HEADS * PEER_QDIM), D_MODEL ** -0.5),
        "peer_k1": nrm(ks[11], (DEPTH, PEER_HEADS, PEER_NKEYS, PEER_HALF), PEER_HALF ** -0.5),
        "peer_k2": nrm(ks[12], (DEPTH, PEER_HEADS, PEER_NKEYS, PEER_HALF), PEER_HALF ** -0.5),
        "peer_u": nrm(ks[13], (DEPTH, PEER_NEXPERTS, D_MODEL), D_MODEL ** -0.5),
        "peer_v": nrm(ks[14], (DEPTH, PEER_NEXPERTS, D_MODEL), 0.5),
        "g_ple": 1.0 + nrm(ks[15], (DEPTH, D_MODEL), 0.01),
        "w_ple_proj": nrm(ks[16], (DEPTH, PLE_DIM, D_MODEL), PLE_DIM ** -0.5),
        "w_ple_gate": nrm(ks[17], (DEPTH, D_MODEL, D_MODEL), D_MODEL ** -0.5),
        "g_final": 1.0 + nrm(ks[18], (D_MODEL,), 0.01),
    }


def reference(x, p, g_mix, w_in, conv_w, conv_b, w_ret_up, w_conv_up, w_out, g_ffn,
              w_peer_q, peer_k1, peer_k2, peer_u, peer_v, g_ple, w_ple_proj, w_ple_gate, g_final):
    b, s, d = x.shape
    offsets = np.cumsum(IN_SPLITS)[:-1].tolist()
    h = x
    for i in range(DEPTH):
        a = rms_norm(h, g_mix[i])
        proj = a @ w_in[i]
        q, k, v, g_ret, cb, cc, ch, gate_r, gate_c = jnp.split(proj, offsets, axis=-1)
        q = rotary(q.reshape(b, s, RET_HEADS, RET_DK))
        k = rotary(k.reshape(b, s, RET_HEADS, RET_DK)) * (RET_DK ** -0.5)
        v = v.reshape(b, s, RET_HEADS, RET_DV)
        ret = head_group_norm(chunkwise_retention(q, k, v)).reshape(b, s, RET_V)
        ret = (jax.nn.silu(g_ret.astype(jnp.float32)) * ret).astype(x.dtype)
        y_ret = ret @ w_ret_up[i]
        z = causal_short_conv(cc * ch, conv_w[i], conv_b[i])
        y_conv = (cb * z) @ w_conv_up[i]
        merged = jax.nn.sigmoid(gate_r) * y_ret + jax.nn.sigmoid(gate_c) * y_conv
        h = h + merged @ w_out[i]
        h = h + peer_ffn(rms_norm(h, g_ffn[i]), w_peer_q[i], peer_k1[i], peer_k2[i], peer_u[i], peer_v[i])
        ple = p[i] @ w_ple_proj[i]
        h = h + jax.nn.sigmoid(rms_norm(h, g_ple[i]) @ w_ple_gate[i]) * ple
    return rms_norm(h, g_final)
```

```cpp
#include <hip/hip_runtime.h>
#include <hip/hip_cooperative_groups.h>
#include <cstdio>
#include <cstdint>
#include <cmath>
namespace cg = cooperative_groups;

#ifndef MK_ONE_LAUNCH
#define MK_ONE_LAUNCH 0
#endif

namespace pg8 {
#define PG8_LAS __attribute__((address_space(3)))
typedef unsigned short bf16_t;
typedef short bf16x8 __attribute__((ext_vector_type(8)));
typedef float f32x4 __attribute__((ext_vector_type(4)));
typedef unsigned u32x4 __attribute__((ext_vector_type(4)));
typedef unsigned u32x2 __attribute__((ext_vector_type(2)));
constexpr int BM = 256, BK = 64, HALF = 128, HTB = HALF * BK * 2, STAGE_BYTES = 8 * HTB, NXCD = 8, WGM = 8;

__host__ __device__ __forceinline__ int lds_byte(int r, int c) { const int st = (r >> 4) * 2 + (c >> 5), rr = r & 15, cc = c & 31, ob = rr * 64 + cc * 2; return st * 1024 + (ob ^ (((ob >> 9) & 1) << 5)); }
__host__ __device__ __forceinline__ void stage_rc(int b, int& R, int& C) { const int st = b / 1024, sb = b % 1024, swz = sb ^ (((sb >> 9) & 1) << 5); R = (st >> 1) * 16 + swz / 64; C = (st & 1) * 32 + (swz % 64) / 2; }
__host__ __device__ __forceinline__ int perm32(int rho) { const int n = rho >> 4, i = rho & 15; return 8 * (i >> 2) + 4 * n + (i & 3); }

struct Unit { int pm, pn; };
struct Gemm { const bf16_t* A; const bf16_t* Bt; int M, N, K, lda, a_pn_cols; };

struct StaticOrder {
    int nM, nN, nwg, G, c;
    __host__ __device__ void init(int M, int N, int G_, int c_) { nM = M / BM; nN = N / BM; nwg = nM * nN; G = G_; c = c_; }
    __host__ __device__ bool next(int i, Unit& u) const {
        const long L = (long)i * G + c; if (L >= nwg) return false;
        int wgid = (int)L; { const int q = nwg / NXCD, r = nwg % NXCD, xcd = wgid % NXCD, off = wgid / NXCD; wgid = (xcd < r ? xcd * (q + 1) : r * (q + 1) + (xcd - r) * q) + off; }
        const int nig = WGM * nN, gid = wgid / nig, fm = gid * WGM, gsz = (nM - fm) < WGM ? (nM - fm) : WGM;
        u.pm = fm + ((wgid % nig) % gsz); u.pn = (wgid % nig) / gsz; return true;
    }
    __device__ __forceinline__ void a_ready(const Unit&) const {}
    __device__ __forceinline__ void done(const Unit&) const {}
};

__device__ __forceinline__ unsigned cvt_pk_bf16(float lo, float hi) { unsigned r; asm volatile("v_cvt_pk_bf16_f32 %0, %1, %2" : "=v"(r) : "v"(lo), "v"(hi)); return r; }
__device__ __forceinline__ float bf_lo(unsigned w) { return __uint_as_float(w << 16); }
__device__ __forceinline__ float bf_hi(unsigned w) { return __uint_as_float(w & 0xffff0000u); }
__device__ __forceinline__ float sigmoidf_(float x) { return 1.0f / (1.0f + __expf(-x)); }

struct EpiBf16 {
    static constexpr bool PERM = true, AFTER_DRAIN = false;
    bf16_t* O; int ldc;
    __device__ __forceinline__ void operator()(const f32x4 (&acc)[2][2][4][2], const Unit& u, int wr, int wc, int fr, int fq) const {
        const int row0 = u.pm * BM + wr * 64 + fr; const int col0 = u.pn * BM + wc * 32 + 8 * fq;
#pragma unroll
        for (int ai = 0; ai < 2; ++ai)
#pragma unroll
            for (int m = 0; m < 4; ++m) { bf16_t* rowp = O + (size_t)(row0 + ai * HALF + m * 16) * ldc + col0;
#pragma unroll
                for (int bj = 0; bj < 2; ++bj) { const f32x4 v0 = acc[ai][bj][m][0], v1 = acc[ai][bj][m][1];
                    u32x4 w; w.x = cvt_pk_bf16(v0[0], v0[1]); w.y = cvt_pk_bf16(v0[2], v0[3]); w.z = cvt_pk_bf16(v1[0], v1[1]); w.w = cvt_pk_bf16(v1[2], v1[3]);
                    *(u32x4*)(rowp + bj * HALF) = w; } }
    }
};
template <bool ACCUM> struct EpiGate {
    static constexpr bool PERM = true, AFTER_DRAIN = false;
    bf16_t* O; int ldc; const bf16_t* G; int ldg; int gcol;
    __device__ __forceinline__ void operator()(const f32x4 (&acc)[2][2][4][2], const Unit& u, int wr, int wc, int fr, int fq) const {
        const int row0 = u.pm * BM + wr * 64 + fr; const int col0 = u.pn * BM + wc * 32 + 8 * fq;
#pragma unroll
        for (int ai = 0; ai < 2; ++ai)
#pragma unroll
            for (int m = 0; m < 4; ++m) { const size_t r = (size_t)(row0 + ai * HALF + m * 16);
#pragma unroll
                for (int bj = 0; bj < 2; ++bj) { const f32x4 v0 = acc[ai][bj][m][0], v1 = acc[ai][bj][m][1];
                    const u32x4 g = *(const u32x4*)(G + r * ldg + gcol + col0 + bj * HALF);
                    float o[8];
                    o[0] = sigmoidf_(bf_lo(g.x)) * v0[0]; o[1] = sigmoidf_(bf_hi(g.x)) * v0[1]; o[2] = sigmoidf_(bf_lo(g.y)) * v0[2]; o[3] = sigmoidf_(bf_hi(g.y)) * v0[3];
                    o[4] = sigmoidf_(bf_lo(g.z)) * v1[0]; o[5] = sigmoidf_(bf_hi(g.z)) * v1[1]; o[6] = sigmoidf_(bf_lo(g.w)) * v1[2]; o[7] = sigmoidf_(bf_hi(g.w)) * v1[3];
                    bf16_t* op = O + r * ldc + col0 + bj * HALF;
                    if (ACCUM) { const u32x4 p = *(const u32x4*)op;
                        o[0] += bf_lo(p.x); o[1] += bf_hi(p.x); o[2] += bf_lo(p.y); o[3] += bf_hi(p.y); o[4] += bf_lo(p.z); o[5] += bf_hi(p.z); o[6] += bf_lo(p.w); o[7] += bf_hi(p.w); }
                    u32x4 w; w.x = cvt_pk_bf16(o[0], o[1]); w.y = cvt_pk_bf16(o[2], o[3]); w.z = cvt_pk_bf16(o[4], o[5]); w.w = cvt_pk_bf16(o[6], o[7]);
                    *(u32x4*)op = w; } }
    }
};
struct EpiResF32 {
    static constexpr bool PERM = false, AFTER_DRAIN = false;
    const float* base; float* out; int ldc;
    __device__ __forceinline__ void operator()(const f32x4 (&acc)[2][2][4][2], const Unit& u, int wr, int wc, int fr, int fq) const {
        const int row0 = u.pm * BM + wr * 64 + fr; const int col0 = u.pn * BM + wc * 32 + 4 * fq;
#pragma unroll
        for (int ai = 0; ai < 2; ++ai)
#pragma unroll
            for (int m = 0; m < 4; ++m) { const size_t off = (size_t)(row0 + ai * HALF + m * 16) * ldc + col0;
#pragma unroll
                for (int bj = 0; bj < 2; ++bj)
#pragma unroll
                    for (int n = 0; n < 2; ++n) { const f32x4 b = *(const f32x4*)(base + off + bj * HALF + n * 16); *(f32x4*)(out + off + bj * HALF + n * 16) = b + acc[ai][bj][m][n]; } }
    }
};
struct EpiPle {
    static constexpr bool PERM = false, AFTER_DRAIN = false;
    const float* base; float* out; const bf16_t* P; int ldc;
    __device__ __forceinline__ void operator()(const f32x4 (&acc)[2][2][4][2], const Unit& u, int wr, int wc, int fr, int fq) const {
        const int row0 = u.pm * BM + wr * 64 + fr; const int col0 = u.pn * BM + wc * 32 + 4 * fq;
#pragma unroll
        for (int ai = 0; ai < 2; ++ai)
#pragma unroll
            for (int m = 0; m < 4; ++m) { const size_t off = (size_t)(row0 + ai * HALF + m * 16) * ldc + col0;
#pragma unroll
                for (int bj = 0; bj < 2; ++bj)
#pragma unroll
                    for (int n = 0; n < 2; ++n) { const size_t o = off + bj * HALF + n * 16; const f32x4 b = *(const f32x4*)(base + o); const u32x2 p = *(const u32x2*)(P + o); const f32x4 a = acc[ai][bj][m][n];
                        f32x4 r; r[0] = b[0] + sigmoidf_(a[0]) * bf_lo(p.x); r[1] = b[1] + sigmoidf_(a[1]) * bf_hi(p.x); r[2] = b[2] + sigmoidf_(a[2]) * bf_lo(p.y); r[3] = b[3] + sigmoidf_(a[3]) * bf_hi(p.y);
                        *(f32x4*)(out + o) = r; } }
    }
};

template <class Epi, class Sched, bool ALIGN_EPI>
__device__ __forceinline__ void gemm_phase(PG8_LAS unsigned char* lds, const Gemm g, const Sched& S, const Epi& E) {
    const int tid = threadIdx.x, wid = __builtin_amdgcn_readfirstlane(tid >> 6), lane = tid & 63, wr = wid >> 2, wc = wid & 3, fr = lane & 15, fq = lane >> 4;
    const int K = g.K, nt = K / BK, lda = g.lda;
    unsigned voffA[2], voffB[2];
#pragma unroll
    for (int i = 0; i < 2; ++i) { int R, C; stage_rc(tid * 16 + i * 8192, R, C); const int Rb = Epi::PERM ? ((R & ~31) + perm32(R & 31)) : R;
        voffA[i] = (unsigned)(R * lda + C) * 2u; voffB[i] = (unsigned)(Rb * K + C) * 2u; }
    const size_t kstep = (size_t)(BK * 2);
    const size_t hstepA = (size_t)HALF * lda * 2, hstepB = (size_t)HALF * K * 2;
    const size_t tstepA = 2 * hstepA, tstepB = 2 * hstepB;
    const size_t pnstepA = (size_t)g.a_pn_cols * 2;
    const unsigned ldsw = (unsigned)wid * 1024u;
    const int aoff = lds_byte(wr * 64 + fr, fq * 8), boff = lds_byte(wc * 32 + fr, fq * 8);
#define PG8_SA(b, h) (((b) * 2 + (h)) * HTB)
#define PG8_SB(b, h) ((4 + (b) * 2 + (h)) * HTB)
#define PG8_STAGE(bufoff, gbase, voff) do { _Pragma("unroll") for (int _i = 0; _i < 2; ++_i) \
        __builtin_amdgcn_global_load_lds((const unsigned*)((const char*)(gbase) + (voff)[_i]), (PG8_LAS unsigned*)(lds + (bufoff) + ldsw + _i * 8192), 16, 0, 0); } while (0)
#define PG8_LDA(dst, b, h) do { _Pragma("unroll") for (int m = 0; m < 4; ++m) _Pragma("unroll") for (int k = 0; k < 2; ++k) dst[m][k] = *(const PG8_LAS bf16x8*)(lds + PG8_SA(b, h) + aoff + m * 2048 + k * 1024); } while (0)
#define PG8_LDB(dst, b, h) do { _Pragma("unroll") for (int n = 0; n < 2; ++n) _Pragma("unroll") for (int k = 0; k < 2; ++k) dst[n][k] = *(const PG8_LAS bf16x8*)(lds + PG8_SB(b, h) + boff + n * 2048 + k * 1024); } while (0)
#define PG8_MMA(ai, bj, At, Bt) do { __builtin_amdgcn_s_setprio(1); _Pragma("unroll") for (int m = 0; m < 4; ++m) _Pragma("unroll") for (int n = 0; n < 2; ++n) _Pragma("unroll") for (int k = 0; k < 2; ++k) \
        acc[ai][bj][m][n] = __builtin_amdgcn_mfma_f32_16x16x32_bf16(Bt[n][k], At[m][k], acc[ai][bj][m][n], 0, 0, 0); __builtin_amdgcn_s_setprio(0); } while (0)
#define PG8_WAIT_V(n) asm volatile("s_waitcnt vmcnt(" #n ")" ::: "memory")
#define PG8_WAIT_L(n) asm volatile("s_waitcnt lgkmcnt(" #n ")" ::: "memory")
#define PG8_BAR __builtin_amdgcn_s_barrier()
#define PG8_SCHED __builtin_amdgcn_sched_barrier(0)
    Unit cur, nxt; int ui = 0;
    if (!S.next(0, cur)) return;
    f32x4 acc[2][2][4][2];
#pragma unroll
    for (int a = 0; a < 2; ++a)
#pragma unroll
        for (int b = 0; b < 2; ++b)
#pragma unroll
            for (int m = 0; m < 4; ++m)
#pragma unroll
                for (int n = 0; n < 2; ++n) acc[a][b][m][n] = (f32x4){0.f, 0.f, 0.f, 0.f};
    bf16x8 At[4][2], B0[2][2], B1[2][2];
    const char* cA = (const char*)g.A + (size_t)cur.pm * tstepA + (size_t)cur.pn * pnstepA; const char* cB = (const char*)g.Bt + (size_t)cur.pn * tstepB;
    S.a_ready(cur);
    PG8_STAGE(PG8_SB(0, 0), cB, voffB); PG8_STAGE(PG8_SB(0, 1), cB + hstepB, voffB); PG8_STAGE(PG8_SA(0, 0), cA, voffA); PG8_STAGE(PG8_SA(0, 1), cA + hstepA, voffA);
    if (wr == 1) PG8_BAR;
    PG8_WAIT_V(2); PG8_BAR;
    PG8_STAGE(PG8_SB(1, 0), cB + kstep, voffB); PG8_STAGE(PG8_SA(1, 0), cA + kstep, voffA); PG8_STAGE(PG8_SB(1, 1), cB + hstepB + kstep, voffB);
    PG8_WAIT_V(6); PG8_BAR;
    for (;;) {
        const bool has_next = S.next(ui + 1, nxt);
        const char* nA = has_next ? (const char*)g.A + (size_t)nxt.pm * tstepA + (size_t)nxt.pn * pnstepA : cA; const char* nB = has_next ? (const char*)g.Bt + (size_t)nxt.pn * tstepB : cB;
        for (int t = 0; t < nt; t += 2) {
            const bool last = (t == nt - 2);
            const char* a1 = cA + (size_t)(t + 1) * kstep;
            const char* a2 = last ? nA : cA + (size_t)(t + 2) * kstep; const char* b2 = last ? nB : cB + (size_t)(t + 2) * kstep;
            const char* a3 = a2 + kstep; const char* b3 = b2 + kstep;
            if (last && has_next) S.a_ready(nxt);
            PG8_LDB(B0, 0, 0); PG8_LDB(B1, 0, 1); PG8_SCHED; PG8_LDA(At, 0, 0); PG8_STAGE(PG8_SA(1, 1), a1 + hstepA, voffA);
            PG8_WAIT_V(8); PG8_WAIT_L(0); PG8_BAR; PG8_MMA(0, 0, At, B0); PG8_MMA(0, 1, At, B1); PG8_BAR; PG8_SCHED;
            PG8_LDA(At, 0, 1); PG8_STAGE(PG8_SB(0, 0), b2, voffB); PG8_STAGE(PG8_SB(0, 1), b2 + hstepB, voffB); PG8_STAGE(PG8_SA(0, 0), a2, voffA);
            PG8_WAIT_V(8); PG8_WAIT_L(0); PG8_BAR; PG8_MMA(1, 0, At, B0); PG8_MMA(1, 1, At, B1); PG8_BAR; PG8_SCHED;
            PG8_LDB(B0, 1, 0); PG8_LDB(B1, 1, 1); PG8_SCHED; PG8_LDA(At, 1, 0); PG8_STAGE(PG8_SA(0, 1), a2 + hstepA, voffA);
            PG8_WAIT_V(8); PG8_WAIT_L(0); PG8_BAR; PG8_MMA(0, 0, At, B0); PG8_MMA(0, 1, At, B1); PG8_BAR; PG8_SCHED;
            PG8_LDA(At, 1, 1); PG8_STAGE(PG8_SB(1, 0), b3, voffB); PG8_STAGE(PG8_SB(1, 1), b3 + hstepB, voffB); PG8_STAGE(PG8_SA(1, 0), a3, voffA);
            PG8_WAIT_V(8); PG8_WAIT_L(0); PG8_BAR; PG8_MMA(1, 0, At, B0); PG8_MMA(1, 1, At, B1); PG8_BAR; PG8_SCHED;
        }
        if constexpr (ALIGN_EPI) { if (wr == 0) PG8_BAR; }
        E(acc, cur, wr, wc, fr, fq); S.done(cur);
        if (!has_next) break;
#pragma unroll
        for (int a = 0; a < 2; ++a)
#pragma unroll
            for (int b = 0; b < 2; ++b)
#pragma unroll
                for (int m = 0; m < 4; ++m)
#pragma unroll
                    for (int n = 0; n < 2; ++n) acc[a][b][m][n] = (f32x4){0.f, 0.f, 0.f, 0.f};
        cur = nxt; cA = nA; cB = nB; ++ui;
        if constexpr (ALIGN_EPI) { if (wr == 1) PG8_BAR; }
    }
    PG8_WAIT_V(0);
    if constexpr (!ALIGN_EPI) { if (wr == 0) PG8_BAR; }
    PG8_BAR;
#undef PG8_SA
#undef PG8_SB
#undef PG8_STAGE
#undef PG8_LDA
#undef PG8_LDB
#undef PG8_MMA
#undef PG8_WAIT_V
#undef PG8_WAIT_L
#undef PG8_BAR
#undef PG8_SCHED
}
}

constexpr int NWAVES = 8, NTHREADS = NWAVES * 64;
constexpr int BATCH = 8, SEQ = 4096, D = 1024, T = BATCH * SEQ;
constexpr int RH = 4, RDK = 128, RDV = 256, RC = 128, NCH = SEQ / RC;
constexpr int RQK = RH * RDK, RV = RH * RDV;
constexpr int INW = 8192;
constexpr int PH = 8, PNK = 128, PNE = PNK * PNK, PQD = 256, PHALF = 128, PTOPK = 16, NSEL = PH * PTOPK;
constexpr int PLE = 256;
constexpr float EPS = 1e-6f;
constexpr int NUNITS_R = BATCH * NCH * RH;

constexpr size_t MiB = 1u << 20;
constexpr size_t WS_CTL = 0, CTL_ZERO_BYTES = 64 * 1024;
constexpr size_t WS_COS = 1 * MiB, WS_SIN = 2 * MiB;
constexpr size_t WS_WIN = 3 * MiB;
constexpr size_t WS_WRU = 19 * MiB, WS_WCU = 21 * MiB, WS_WOUT = 23 * MiB;
constexpr size_t WS_WPQ = 25 * MiB;
constexpr size_t WS_WPP = 29 * MiB;
constexpr size_t WS_K1 = 29 * MiB + 512 * 1024, WS_K2 = 29 * MiB + 768 * 1024;
constexpr size_t WS_WPG = 30 * MiB;
constexpr size_t WS_UB = 32 * MiB, WS_VB = 64 * MiB;
constexpr size_t WS_XN = 96 * MiB;
constexpr size_t WS_BIG = 160 * MiB;
constexpr size_t WS_PREV = 352 * MiB;
constexpr size_t WS_ARET = 416 * MiB;
constexpr size_t WS_IDX = 480 * MiB, WS_GATE = 496 * MiB;
constexpr size_t WS_END = 512 * MiB;

constexpr int LDS_BYTES = 160 * 1024;

typedef unsigned short bf16;
typedef unsigned v4u __attribute__((ext_vector_type(4)));
typedef unsigned v2u __attribute__((ext_vector_type(2)));
typedef float f32x4 __attribute__((ext_vector_type(4)));
#define LAS __attribute__((address_space(3)))

__device__ __forceinline__ unsigned f2bf(float f) { unsigned u = __float_as_uint(f); return (u + 0x7fffu + ((u >> 16) & 1u)) >> 16; }
__device__ __forceinline__ unsigned pk2(float lo, float hi) { return f2bf(lo) | (f2bf(hi) << 16); }
__device__ __forceinline__ float bflo(unsigned w) { return __uint_as_float(w << 16); }
__device__ __forceinline__ float bfhi(unsigned w) { return __uint_as_float(w & 0xffff0000u); }
__device__ __forceinline__ float bf2f(bf16 h) { return __uint_as_float(((unsigned)h) << 16); }
__device__ __forceinline__ float wave_sum(float v) {
#pragma unroll
    for (int o = 1; o < 64; o <<= 1) v += __shfl_xor(v, o);
    return v;
}
__device__ __forceinline__ float wave_max(float v) {
#pragma unroll
    for (int o = 1; o < 64; o <<= 1) v = fmaxf(v, __shfl_xor(v, o));
    return v;
}
__device__ __forceinline__ void unpack8(const v4u w, float* f) { f[0] = bflo(w.x); f[1] = bfhi(w.x); f[2] = bflo(w.y); f[3] = bfhi(w.y); f[4] = bflo(w.z); f[5] = bfhi(w.z); f[6] = bflo(w.w); f[7] = bfhi(w.w); }

struct Args {
    const float* in[19]; float* out; unsigned char* ws; int ph_lo, ph_hi;
};

struct Frame {
    unsigned char* lds;
    int tid, lane, wave, G, gw, NGW, gt, NGT;
};

__device__ __forceinline__ void p0_transpose_item(const float* W, int K, int N, bf16* WT, float* scr, int item, int lane) {
    const int nblk = N / 32, kb = item / nblk, nb = item % nblk, k0 = 64 * kb, n0 = 32 * nb;
#pragma unroll 8
    for (int i = 0; i < 32; ++i) { const int kk = 2 * i + (lane >> 5); scr[kk * 33 + (lane & 31)] = W[(size_t)(k0 + kk) * N + n0 + (lane & 31)]; }
    asm volatile("s_waitcnt lgkmcnt(0)" ::: "memory");
    const int c = lane & 7;
#pragma unroll
    for (int j = 0; j < 4; ++j) { const int n = (lane >> 3) + 8 * j; const float* s = scr + (8 * c) * 33 + n;
        v4u o; o.x = pk2(s[0 * 33], s[1 * 33]); o.y = pk2(s[2 * 33], s[3 * 33]); o.z = pk2(s[4 * 33], s[5 * 33]); o.w = pk2(s[6 * 33], s[7 * 33]);
        *(v4u*)(WT + (size_t)(n0 + n) * K + k0 + 8 * c) = o; }
    asm volatile("s_waitcnt lgkmcnt(0)" ::: "memory");
}
__device__ __forceinline__ void cvt_f32_bf16(const Frame& F, const float* src, bf16* dst, size_t count) {
    const size_t n4 = count / 4;
    for (size_t i = F.gt; i < n4; i += F.NGT) { const f32x4 v = ((const f32x4*)src)[i]; v2u o; o.x = pk2(v[0], v[1]); o.y = pk2(v[2], v[3]); ((v2u*)dst)[i] = o; }
}
__device__ __forceinline__ void rms_row_to_bf16(const float* xrow, const float* g, bf16* orow, int lane) {
    const f32x4* xr = (const f32x4*)xrow + lane; const f32x4* gr = (const f32x4*)g + lane;
    f32x4 v[4]; float s = 0.f;
#pragma unroll
    for (int j = 0; j < 4; ++j) { v[j] = xr[64 * j]; s += (v[j][0] * v[j][0] + v[j][1] * v[j][1]) + (v[j][2] * v[j][2] + v[j][3] * v[j][3]); }
    const float rs = 1.0f / sqrtf(wave_sum(s) * (1.f / D) + EPS);
    unsigned long long* o8 = (unsigned long long*)orow + lane;
#pragma unroll
    for (int j = 0; j < 4; ++j) { const f32x4 gg = gr[64 * j]; o8[64 * j] = (unsigned long long)pk2(v[j][0] * rs * gg[0], v[j][1] * rs * gg[1]) | ((unsigned long long)pk2(v[j][2] * rs * gg[2], v[j][3] * rs * gg[3]) << 32); }
}

__device__ __forceinline__ float gamma_of(int h) { return 1.0f - exp2f(-5.0f - (float)h); }

__global__ void __launch_bounds__(NTHREADS, 2) mega(Args args) {
    extern __shared__ __attribute__((aligned(16))) unsigned char lds[];
    Frame F;
    F.lds = lds; F.tid = threadIdx.x; F.lane = F.tid & 63; F.wave = __builtin_amdgcn_readfirstlane(F.tid >> 6);
    F.G = gridDim.x; F.gw = blockIdx.x * NWAVES + F.wave; F.NGW = F.G * NWAVES; F.gt = blockIdx.x * NTHREADS + F.tid; F.NGT = F.G * NTHREADS;
    unsigned char* ws = args.ws;
    const float* x = args.in[0]; const float* p = args.in[1]; const float* g_mix = args.in[2]; const float* w_in = args.in[3];
    const float* conv_w = args.in[4]; const float* conv_b = args.in[5]; const float* w_ret_up = args.in[6]; const float* w_conv_up = args.in[7];
    const float* w_out = args.in[8]; const float* g_ffn = args.in[9]; const float* w_peer_q = args.in[10]; const float* peer_k1 = args.in[11];
    const float* peer_k2 = args.in[12]; const float* peer_u = args.in[13]; const float* peer_v = args.in[14]; const float* g_ple = args.in[15];
    const float* w_ple_proj = args.in[16]; const float* w_ple_gate = args.in[17]; const float* g_final = args.in[18];
    float* out = args.out;
    float* COS = (float*)(ws + WS_COS); float* SIN = (float*)(ws + WS_SIN);
    bf16* WIN = (bf16*)(ws + WS_WIN); bf16* WRU = (bf16*)(ws + WS_WRU); bf16* WCU = (bf16*)(ws + WS_WCU); bf16* WOUT = (bf16*)(ws + WS_WOUT);
    bf16* WPQ = (bf16*)(ws + WS_WPQ); bf16* WPP = (bf16*)(ws + WS_WPP); bf16* K1 = (bf16*)(ws + WS_K1); bf16* K2 = (bf16*)(ws + WS_K2); bf16* WPG = (bf16*)(ws + WS_WPG);
    bf16* UB = (bf16*)(ws + WS_UB); bf16* VB = (bf16*)(ws + WS_VB);
    bf16* XN = (bf16*)(ws + WS_XN); bf16* BIG = (bf16*)(ws + WS_BIG); bf16* PREV = (bf16*)(ws + WS_PREV); bf16* ARET = (bf16*)(ws + WS_ARET);
    int* IDX = (int*)(ws + WS_IDX); float* GATE = (float*)(ws + WS_GATE);
    bf16* ACONV = PREV;
    bf16* GATES = BIG;
    bf16* M1 = BIG + (size_t)T * 2048;
    bf16* A2 = XN;
    bf16* PB = BIG + (size_t)T * 2048;
    bf16* QP = PREV;
    bf16* PLEB = BIG;
    bf16* A3 = BIG + (size_t)T * 1024;
    PG8_LAS unsigned char* ldsl = (PG8_LAS unsigned char*)lds;

    const int lo = args.ph_lo, hi = args.ph_hi;
#if MK_ONE_LAUNCH
    cg::grid_group grid = cg::this_grid();
#define SEAM(k) do { if ((k) + 1 < hi) grid.sync(); } while (0)
#else
#define SEAM(k) do { } while (0)
#endif
#define IN(k) (lo <= (k) && (k) < hi)

    if (IN(0)) {
        float* scr = (float*)(lds + F.wave * 16384);
        constexpr int I_IN = (D / 64) * (INW / 32), I_SQ = (D / 64) * (D / 32), I_PQ = (D / 64) * (2048 / 32), I_PP = (PLE / 64) * (D / 32);
        constexpr int NITEMS = I_IN + 4 * I_SQ + I_PQ + I_PP;
        for (int it = F.gw; it < NITEMS; it += F.NGW) {
            int r = it;
            if (r < I_IN) { p0_transpose_item(w_in, D, INW, WIN, scr, r, F.lane); continue; } r -= I_IN;
            if (r < I_SQ) { p0_transpose_item(w_ret_up, D, D, WRU, scr, r, F.lane); continue; } r -= I_SQ;
            if (r < I_SQ) { p0_transpose_item(w_conv_up, D, D, WCU, scr, r, F.lane); continue; } r -= I_SQ;
            if (r < I_SQ) { p0_transpose_item(w_out, D, D, WOUT, scr, r, F.lane); continue; } r -= I_SQ;
            if (r < I_SQ) { p0_transpose_item(w_ple_gate, D, D, WPG, scr, r, F.lane); continue; } r -= I_SQ;
            if (r < I_PQ) { p0_transpose_item(w_peer_q, D, 2048, WPQ, scr, r, F.lane); continue; } r -= I_PQ;
            p0_transpose_item(w_ple_proj, PLE, D, WPP, scr, r, F.lane);
        }
        cvt_f32_bf16(F, peer_k1, K1, (size_t)PH * PNK * PHALF);
        cvt_f32_bf16(F, peer_k2, K2, (size_t)PH * PNK * PHALF);
        cvt_f32_bf16(F, peer_u, UB, (size_t)PNE * D);
        cvt_f32_bf16(F, peer_v, VB, (size_t)PNE * D);
        for (int e = F.gt; e < SEQ * 64; e += F.NGT) { const int s = e >> 6, i = e & 63; const double inv = pow(10000.0, -(double)i / 64.0); const double ang = (double)s * inv; COS[e] = (float)cos(ang); SIN[e] = (float)sin(ang); }
        for (int m = F.gw; m < T; m += F.NGW) rms_row_to_bf16(x + (size_t)m * D, g_mix, XN + (size_t)m * D, F.lane);
        SEAM(0);
    }

    if (IN(1)) {
        pg8::Gemm g{XN, WIN, T, 3072, D, D, 0}; pg8::StaticOrder S; S.init(T, 3072, F.G, (int)blockIdx.x);
        pg8::EpiBf16 E{BIG, 3072};
        pg8::gemm_phase<pg8::EpiBf16, pg8::StaticOrder, true>(ldsl, g, S, E);
        SEAM(1);
    }

    if (IN(2)) {
        float* ks = (float*)lds;
        float* vh = (float*)(lds + 65536);
        for (int u = blockIdx.x; u < NUNITS_R; u += F.G) {
            const int h = u & 3, n = (u >> 2) & 31, b = u >> 7; const size_t t0 = (size_t)b * SEQ + (size_t)n * RC;
            const float gam = gamma_of(h), lg = logf(gam);
            __syncthreads();
            for (int pidx = F.tid; pidx < 128 * 64; pidx += NTHREADS) {
                const int j = pidx >> 6, i = pidx & 63; const int s = n * RC + j;
                const float c = COS[s * 64 + i], sn = SIN[s * 64 + i];
                bf16* qrow = BIG + (t0 + j) * 3072 + h * RDK; bf16* krow = BIG + (t0 + j) * 3072 + RQK + h * RDK;
                const float q1 = bf2f(qrow[i]), q2 = bf2f(qrow[i + 64]);
                qrow[i] = (bf16)f2bf(q1 * c - q2 * sn); qrow[i + 64] = (bf16)f2bf(q1 * sn + q2 * c);
                const float k1 = bf2f(krow[i]), k2 = bf2f(krow[i + 64]);
                const float r1 = (k1 * c - k2 * sn) * 0.08838834764831845f, r2 = (k1 * sn + k2 * c) * 0.08838834764831845f;
                const bf16 b1 = (bf16)f2bf(r1), b2 = (bf16)f2bf(r2);
                krow[i] = b1; krow[i + 64] = b2;
                const float zeta = __expf(lg * (float)(RC - 1 - j));
                ks[j * 128 + i] = bf2f(b1) * zeta; ks[j * 128 + i + 64] = bf2f(b2) * zeta;
            }
            for (int half = 0; half < 2; ++half) {
                __syncthreads();
                for (int e8 = F.tid; e8 < 128 * 16; e8 += NTHREADS) { const int j = e8 >> 4, c8 = e8 & 15;
                    const v4u w = *(const v4u*)(BIG + (t0 + j) * 3072 + 2 * RQK + h * RDV + half * 128 + c8 * 8); float f[8]; unpack8(w, f);
#pragma unroll
                    for (int q = 0; q < 8; ++q) vh[j * 128 + c8 * 8 + q] = f[q]; }
                __syncthreads();
                const int d0 = (F.tid >> 4) * 4, e0 = (F.tid & 15) * 8;
                float acc[4][8];
#pragma unroll
                for (int a = 0; a < 4; ++a)
#pragma unroll
                    for (int q = 0; q < 8; ++q) acc[a][q] = 0.f;
                for (int j = 0; j < 128; ++j) {
                    const f32x4 kd = *(const f32x4*)(ks + j * 128 + d0); const f32x4 v0 = *(const f32x4*)(vh + j * 128 + e0), v1 = *(const f32x4*)(vh + j * 128 + e0 + 4);
#pragma unroll
                    for (int a = 0; a < 4; ++a) {
#pragma unroll
                        for (int q = 0; q < 4; ++q) { acc[a][q] += kd[a] * v0[q]; acc[a][q + 4] += kd[a] * v1[q]; } }
                }
#pragma unroll
                for (int a = 0; a < 4; ++a) { v4u o; o.x = pk2(acc[a][0], acc[a][1]); o.y = pk2(acc[a][2], acc[a][3]); o.z = pk2(acc[a][4], acc[a][5]); o.w = pk2(acc[a][6], acc[a][7]);
                    *(v4u*)(PREV + ((size_t)u * 128 + d0 + a) * 256 + half * 128 + e0) = o; }
            }
        }
        SEAM(2);
    }

    if (IN(3)) {
        for (int c = F.gt; c < BATCH * RH * 128 * 32; c += F.NGT) {
            const int e8 = c & 31, d = (c >> 5) & 127, h = (c >> 12) & 3, b = c >> 14;
            const float cd = powf(gamma_of(h), (float)RC);
            float st[8];
#pragma unroll
            for (int q = 0; q < 8; ++q) st[q] = 0.f;
            for (int n = 0; n < NCH; ++n) {
                const int u = b * 128 + n * 4 + h; v4u* ptr = (v4u*)(PREV + ((size_t)u * 128 + d) * 256 + e8 * 8);
                const v4u w = *ptr; float f[8]; unpack8(w, f);
                v4u o; o.x = pk2(st[0], st[1]); o.y = pk2(st[2], st[3]); o.z = pk2(st[4], st[5]); o.w = pk2(st[6], st[7]); *ptr = o;
#pragma unroll
                for (int q = 0; q < 8; ++q) st[q] = st[q] * cd + f[q];
            }
        }
        SEAM(3);
    }

    if (IN(4)) {
        constexpr int LS = 136;
        bf16* qs = (bf16*)lds; bf16* kps = qs + 128 * LS; bf16* Ss = kps + 128 * LS; bf16* vs = Ss + 128 * LS;
        for (int u = blockIdx.x; u < NUNITS_R; u += F.G) {
            const int h = u & 3, n = (u >> 2) & 31, b = u >> 7; const size_t t0 = (size_t)b * SEQ + (size_t)n * RC;
            const float gam = gamma_of(h), lg = logf(gam);
            __syncthreads();
            for (int c = F.tid; c < 128 * 16; c += NTHREADS) { const int j = c >> 4, c8 = c & 15;
                *(v4u*)(qs + j * LS + c8 * 8) = *(const v4u*)(BIG + (t0 + j) * 3072 + h * RDK + c8 * 8);
                *(v4u*)(kps + j * LS + c8 * 8) = *(const v4u*)(BIG + (t0 + j) * 3072 + RQK + h * RDK + c8 * 8); }
            __syncthreads();
            {
                const int i0 = (F.tid >> 4) * 4, j0 = (F.tid & 15) * 8;
                float acc[4][8];
#pragma unroll
                for (int a = 0; a < 4; ++a)
#pragma unroll
                    for (int q = 0; q < 8; ++q) acc[a][q] = 0.f;
                for (int d = 0; d < 128; d += 8) {
                    float qf[4][8], kf[8];
#pragma unroll
                    for (int a = 0; a < 4; ++a) unpack8(*(const v4u*)(qs + (i0 + a) * LS + d), qf[a]);
#pragma unroll
                    for (int q = 0; q < 8; ++q) { unpack8(*(const v4u*)(kps + (j0 + q) * LS + d), kf);
#pragma unroll
                        for (int a = 0; a < 4; ++a)
#pragma unroll
                            for (int z = 0; z < 8; ++z) acc[a][q] += qf[a][z] * kf[z]; }
                }
#pragma unroll
                for (int a = 0; a < 4; ++a) { float o[8];
#pragma unroll
                    for (int q = 0; q < 8; ++q) { const int df = (i0 + a) - (j0 + q); o[q] = df >= 0 ? acc[a][q] * __expf(lg * (float)df) : 0.f; }
                    v4u w; w.x = pk2(o[0], o[1]); w.y = pk2(o[2], o[3]); w.z = pk2(o[4], o[5]); w.w = pk2(o[6], o[7]);
                    *(v4u*)(Ss + (i0 + a) * LS + j0) = w; }
            }
            const int i = F.tid >> 2, eq = F.tid & 3;
            float outv[2][32];
#pragma unroll
            for (int half = 0; half < 2; ++half) {
                __syncthreads();
                for (int c = F.tid; c < 128 * 16; c += NTHREADS) { const int j = c >> 4, c8 = c & 15;
                    *(v4u*)(vs + j * LS + c8 * 8) = *(const v4u*)(BIG + (t0 + j) * 3072 + 2 * RQK + h * RDV + half * 128 + c8 * 8);
                    *(v4u*)(kps + j * LS + c8 * 8) = *(const v4u*)(PREV + ((size_t)u * 128 + j) * 256 + half * 128 + c8 * 8); }
                __syncthreads();
                const float xi = __expf(lg * (float)(i + 1));
#pragma unroll
                for (int q = 0; q < 32; ++q) outv[half][q] = 0.f;
                for (int j = 0; j < 128; ++j) {
                    const float sv = bf2f(Ss[i * LS + j]), qv = bf2f(qs[i * LS + j]) * xi;
#pragma unroll
                    for (int c8 = 0; c8 < 4; ++c8) { float vf[8], pf[8]; unpack8(*(const v4u*)(vs + j * LS + eq * 32 + c8 * 8), vf); unpack8(*(const v4u*)(kps + j * LS + eq * 32 + c8 * 8), pf);
#pragma unroll
                        for (int z = 0; z < 8; ++z) outv[half][c8 * 8 + z] += sv * vf[z] + qv * pf[z]; }
                }
            }
            float s = 0.f;
#pragma unroll
            for (int hf = 0; hf < 2; ++hf)
#pragma unroll
                for (int q = 0; q < 32; ++q) s += outv[hf][q];
            s += __shfl_xor(s, 1); s += __shfl_xor(s, 2);
            const float mu = s * (1.f / 256.f); float v2 = 0.f;
#pragma unroll
            for (int hf = 0; hf < 2; ++hf)
#pragma unroll
                for (int q = 0; q < 32; ++q) { const float dd = outv[hf][q] - mu; v2 += dd * dd; }
            v2 += __shfl_xor(v2, 1); v2 += __shfl_xor(v2, 2);
            const float rstd = 1.0f / sqrtf(v2 * (1.f / 256.f) + EPS);
#pragma unroll
            for (int hf = 0; hf < 2; ++hf)
#pragma unroll
                for (int c8 = 0; c8 < 4; ++c8) {
                    const int col = h * RDV + hf * 128 + eq * 32 + c8 * 8;
                    float gf[8]; unpack8(*(const v4u*)(BIG + (t0 + i) * 3072 + 2 * RQK + RV + col), gf);
                    float o[8];
#pragma unroll
                    for (int z = 0; z < 8; ++z) { const float y = (outv[hf][c8 * 8 + z] - mu) * rstd; const float gg = gf[z]; o[z] = y * gg / (1.0f + __expf(-gg)); }
                    v4u w; w.x = pk2(o[0], o[1]); w.y = pk2(o[2], o[3]); w.z = pk2(o[4], o[5]); w.w = pk2(o[6], o[7]);
                    *(v4u*)(ARET + (t0 + i) * 1024 + col) = w; }
        }
        SEAM(4);
    }

    if (IN(5)) {
        pg8::Gemm g{XN, WIN + (size_t)3072 * D, T, 3072, D, D, 0}; pg8::StaticOrder S; S.init(T, 3072, F.G, (int)blockIdx.x);
        pg8::EpiBf16 E{BIG, 3072};
        pg8::gemm_phase<pg8::EpiBf16, pg8::StaticOrder, true>(ldsl, g, S, E);
        SEAM(5);
    }

    if (IN(6)) {
        for (int c = F.gt; c < T * 128; c += F.NGT) {
            const int c8 = c & 127, t = c >> 7, s = t & (SEQ - 1); const int col = c8 * 8;
            const bf16* row = BIG + (size_t)t * 3072;
            float cb[8], u0[8], u1[8], u2[8], a[8], bb[8];
            unpack8(*(const v4u*)(row + col), cb);
            unpack8(*(const v4u*)(row + 1024 + col), a); unpack8(*(const v4u*)(row + 2048 + col), bb);
#pragma unroll
            for (int z = 0; z < 8; ++z) u2[z] = a[z] * bb[z];
            if (s >= 1) { unpack8(*(const v4u*)(row - 3072 + 1024 + col), a); unpack8(*(const v4u*)(row - 3072 + 2048 + col), bb);
#pragma unroll
                for (int z = 0; z < 8; ++z) u1[z] = a[z] * bb[z]; }
            else {
#pragma unroll
                for (int z = 0; z < 8; ++z) u1[z] = 0.f; }
            if (s >= 2) { unpack8(*(const v4u*)(row - 2 * 3072 + 1024 + col), a); unpack8(*(const v4u*)(row - 2 * 3072 + 2048 + col), bb);
#pragma unroll
                for (int z = 0; z < 8; ++z) u0[z] = a[z] * bb[z]; }
            else {
#pragma unroll
                for (int z = 0; z < 8; ++z) u0[z] = 0.f; }
            float o[8];
#pragma unroll
            for (int z = 0; z < 8; ++z) { const float zz = conv_w[col + z] * u0[z] + conv_w[1024 + col + z] * u1[z] + conv_w[2048 + col + z] * u2[z] + conv_b[col + z]; o[z] = cb[z] * zz; }
            v4u w; w.x = pk2(o[0], o[1]); w.y = pk2(o[2], o[3]); w.z = pk2(o[4], o[5]); w.w = pk2(o[6], o[7]);
            *(v4u*)(ACONV + (size_t)t * 1024 + col) = w;
        }
        SEAM(6);
    }

    if (IN(7)) {
        pg8::Gemm g{XN, WIN + (size_t)6144 * D, T, 2048, D, D, 0}; pg8::StaticOrder S; S.init(T, 2048, F.G, (int)blockIdx.x);
        pg8::EpiBf16 E{GATES, 2048};
        pg8::gemm_phase<pg8::EpiBf16, pg8::StaticOrder, true>(ldsl, g, S, E);
        SEAM(7);
    }

    if (IN(8)) {
        pg8::StaticOrder S; S.init(T, D, F.G, (int)blockIdx.x);
        { pg8::Gemm g{ARET, WRU, T, D, D, D, 0}; pg8::EpiGate<false> E{M1, D, GATES, 2048, 0};
          pg8::gemm_phase<pg8::EpiGate<false>, pg8::StaticOrder, true>(ldsl, g, S, E); }
        asm volatile("s_waitcnt vmcnt(0)" ::: "memory"); __syncthreads();
        { pg8::Gemm g{ACONV, WCU, T, D, D, D, 0}; pg8::EpiGate<true> E{M1, D, GATES, 2048, 1024};
          pg8::gemm_phase<pg8::EpiGate<true>, pg8::StaticOrder, true>(ldsl, g, S, E); }
        SEAM(8);
    }

    if (IN(9)) {
        pg8::Gemm g{M1, WOUT, T, D, D, D, 0}; pg8::StaticOrder S; S.init(T, D, F.G, (int)blockIdx.x);
        pg8::EpiResF32 E{x, out, D};
        pg8::gemm_phase<pg8::EpiResF32, pg8::StaticOrder, true>(ldsl, g, S, E);
        SEAM(9);
    }

    if (IN(10)) {
        for (int m = F.gw; m < T; m += F.NGW) rms_row_to_bf16(out + (size_t)m * D, g_ffn, A2 + (size_t)m * D, F.lane);
        cvt_f32_bf16(F, p, PB, (size_t)T * PLE);
        SEAM(10);
    }

    if (IN(11)) {
        pg8::Gemm g{A2, WPQ, T, 2048, D, D, 0}; pg8::StaticOrder S; S.init(T, 2048, F.G, (int)blockIdx.x);
        pg8::EpiBf16 E{QP, 2048};
        pg8::gemm_phase<pg8::EpiBf16, pg8::StaticOrder, true>(ldsl, g, S, E);
        SEAM(11);
    }

    if (IN(12)) {
        constexpr int LS = 136;
        bf16* k1s = (bf16*)lds; bf16* k2s = k1s + 128 * LS; float* qsh = (float*)(lds + 2 * 128 * LS * 2);
        const int h = blockIdx.x & 7;
        __syncthreads();
        for (int c = F.tid; c < 128 * 16; c += NTHREADS) { const int j = c >> 4, c8 = c & 15;
            *(v4u*)(k1s + j * LS + c8 * 8) = *(const v4u*)(K1 + ((size_t)h * 128 + j) * 128 + c8 * 8);
            *(v4u*)(k2s + j * LS + c8 * 8) = *(const v4u*)(K2 + ((size_t)h * 128 + j) * 128 + c8 * 8); }
        __syncthreads();
        float* qw = qsh + F.wave * 256;
        const int nblk8 = F.G >> 3;
        for (int t = (blockIdx.x >> 3) * NWAVES + F.wave; t < T; t += nblk8 * NWAVES) {
            { const v2u w = *(const v2u*)(QP + (size_t)t * 2048 + h * 256 + F.lane * 4); qw[F.lane * 4 + 0] = bflo(w.x); qw[F.lane * 4 + 1] = bfhi(w.x); qw[F.lane * 4 + 2] = bflo(w.y); qw[F.lane * 4 + 3] = bfhi(w.y); }
            asm volatile("s_waitcnt lgkmcnt(0)" ::: "memory");
            float s1a = 0.f, s1b = 0.f, s2a = 0.f, s2b = 0.f;
            for (int d = 0; d < 128; d += 8) {
                float q1[8], q2[8], kf[8];
                *(f32x4*)q1 = *(const f32x4*)(qw + d); *(f32x4*)(q1 + 4) = *(const f32x4*)(qw + d + 4);
                *(f32x4*)q2 = *(const f32x4*)(qw + 128 + d); *(f32x4*)(q2 + 4) = *(const f32x4*)(qw + 128 + d + 4);
                unpack8(*(const v4u*)(k1s + F.lane * LS + d), kf);
#pragma unroll
                for (int z = 0; z < 8; ++z) s1a += q1[z] * kf[z];
                unpack8(*(const v4u*)(k1s + (F.lane + 64) * LS + d), kf);
#pragma unroll
                for (int z = 0; z < 8; ++z) s1b += q1[z] * kf[z];
                unpack8(*(const v4u*)(k2s + F.lane * LS + d), kf);
#pragma unroll
                for (int z = 0; z < 8; ++z) s2a += q2[z] * kf[z];
                unpack8(*(const v4u*)(k2s + (F.lane + 64) * LS + d), kf);
#pragma unroll
                for (int z = 0; z < 8; ++z) s2b += q2[z] * kf[z];
            }
            float tv1 = 0.f, tv2 = 0.f; int ti1 = 0, ti2 = 0;
            const float NEG = -3.0e38f;
            for (int r = 0; r < PTOPK; ++r) {
                { const float m = wave_max(fmaxf(s1a, s1b)); const unsigned long long ba = __ballot(s1a == m); int idx;
                  if (ba) { const int ln = __ffsll((long long)ba) - 1; idx = ln; if (F.lane == ln) s1a = NEG; }
                  else { const unsigned long long bb = __ballot(s1b == m); const int ln = __ffsll((long long)bb) - 1; idx = ln + 64; if (F.lane == ln) s1b = NEG; }
                  if (F.lane == r) { tv1 = m; ti1 = idx; } }
                { const float m = wave_max(fmaxf(s2a, s2b)); const unsigned long long ba = __ballot(s2a == m); int idx;
                  if (ba) { const int ln = __ffsll((long long)ba) - 1; idx = ln; if (F.lane == ln) s2a = NEG; }
                  else { const unsigned long long bb = __ballot(s2b == m); const int ln = __ffsll((long long)bb) - 1; idx = ln + 64; if (F.lane == ln) s2b = NEG; }
                  if (F.lane == r) { tv2 = m; ti2 = idx; } }
            }
            float cs[4];
#pragma unroll
            for (int q = 0; q < 4; ++q) { const int c = F.lane * 4 + q; cs[q] = __shfl(tv1, c >> 4) + __shfl(tv2, c & 15); }
            float top_s = 0.f; int top_c = 0;
            for (int r = 0; r < PTOPK; ++r) {
                const float m = wave_max(fmaxf(fmaxf(cs[0], cs[1]), fmaxf(cs[2], cs[3])));
                int mine = 1000;
#pragma unroll
                for (int q = 3; q >= 0; --q) if (cs[q] == m) mine = F.lane * 4 + q;
                int best = mine;
#pragma unroll
                for (int o = 1; o < 64; o <<= 1) best = min(best, __shfl_xor(best, o));
#pragma unroll
                for (int q = 0; q < 4; ++q) if (F.lane * 4 + q == best) cs[q] = NEG;
                if (F.lane == r) { top_s = m; top_c = best; }
            }
            const int ia = __shfl(ti1, top_c >> 4), ib = __shfl(ti2, top_c & 15);
            const float mx = __shfl(top_s, 0);
            float ex = (F.lane < PTOPK) ? __expf(top_s - mx) : 0.f;
            const float den = wave_sum(ex);
            if (F.lane < PTOPK) { IDX[(size_t)t * NSEL + h * PTOPK + F.lane] = ia * PNK + ib; GATE[(size_t)t * NSEL + h * PTOPK + F.lane] = ex / den; }
        }
        SEAM(12);
    }

    if (IN(13)) {
        for (int t = F.gw; t < T; t += F.NGW) {
            float xf[16];
            { const v4u w0 = *(const v4u*)(A2 + (size_t)t * D + F.lane * 16), w1 = *(const v4u*)(A2 + (size_t)t * D + F.lane * 16 + 8); unpack8(w0, xf); unpack8(w1, xf + 8); }
            const int myidx0 = IDX[(size_t)t * NSEL + F.lane], myidx1 = IDX[(size_t)t * NSEL + 64 + F.lane];
            const float myg0 = GATE[(size_t)t * NSEL + F.lane], myg1 = GATE[(size_t)t * NSEL + 64 + F.lane];
            float acc[16];
#pragma unroll
            for (int z = 0; z < 16; ++z) acc[z] = 0.f;
            for (int e0 = 0; e0 < NSEL; e0 += 4) {
                int id[4]; float gt[4]; v4u uw[4][2];
#pragma unroll
                for (int q = 0; q < 4; ++q) { const int e = e0 + q; id[q] = __builtin_amdgcn_readlane(e < 64 ? myidx0 : myidx1, e & 63); gt[q] = __builtin_bit_cast(float, __builtin_amdgcn_readlane(__builtin_bit_cast(int, e < 64 ? myg0 : myg1), e & 63)); }
#pragma unroll
                for (int q = 0; q < 4; ++q) { const bf16* ur = UB + (size_t)id[q] * D + F.lane * 16; uw[q][0] = *(const v4u*)ur; uw[q][1] = *(const v4u*)(ur + 8); }
                float wgt[4];
#pragma unroll
                for (int q = 0; q < 4; ++q) { float uf[16]; unpack8(uw[q][0], uf); unpack8(uw[q][1], uf + 8); float s = 0.f;
#pragma unroll
                    for (int z = 0; z < 16; ++z) s += xf[z] * uf[z];
                    s = wave_sum(s);
                    wgt[q] = gt[q] * 0.5f * s * (1.0f + erff(s * 0.70710678118654752f)); }
#pragma unroll
                for (int q = 0; q < 4; ++q) { const bf16* vr = VB + (size_t)id[q] * D + F.lane * 16; uw[q][0] = *(const v4u*)vr; uw[q][1] = *(const v4u*)(vr + 8); }
#pragma unroll
                for (int q = 0; q < 4; ++q) { float vf[16]; unpack8(uw[q][0], vf); unpack8(uw[q][1], vf + 8);
#pragma unroll
                    for (int z = 0; z < 16; ++z) acc[z] += wgt[q] * vf[z]; }
            }
            float* hrow = out + (size_t)t * D + F.lane * 16; float hv[16]; float ss = 0.f;
#pragma unroll
            for (int q = 0; q < 4; ++q) { const f32x4 b = *(const f32x4*)(hrow + 4 * q);
#pragma unroll
                for (int z = 0; z < 4; ++z) { hv[4 * q + z] = b[z] + acc[4 * q + z]; ss += hv[4 * q + z] * hv[4 * q + z]; } }
#pragma unroll
            for (int q = 0; q < 4; ++q) *(f32x4*)(hrow + 4 * q) = (f32x4){hv[4 * q], hv[4 * q + 1], hv[4 * q + 2], hv[4 * q + 3]};
            const float rs = 1.0f / sqrtf(wave_sum(ss) * (1.f / D) + EPS);
            float o[16];
#pragma unroll
            for (int z = 0; z < 16; ++z) o[z] = hv[z] * rs * g_ple[F.lane * 16 + z];
            v4u w0, w1; w0.x = pk2(o[0], o[1]); w0.y = pk2(o[2], o[3]); w0.z = pk2(o[4], o[5]); w0.w = pk2(o[6], o[7]); w1.x = pk2(o[8], o[9]); w1.y = pk2(o[10], o[11]); w1.z = pk2(o[12], o[13]); w1.w = pk2(o[14], o[15]);
            *(v4u*)(A3 + (size_t)t * D + F.lane * 16) = w0; *(v4u*)(A3 + (size_t)t * D + F.lane * 16 + 8) = w1;
        }
        SEAM(13);
    }

    if (IN(14)) {
        pg8::Gemm g{PB, WPP, T, D, PLE, PLE, 0}; pg8::StaticOrder S; S.init(T, D, F.G, (int)blockIdx.x);
        pg8::EpiBf16 E{PLEB, D};
        pg8::gemm_phase<pg8::EpiBf16, pg8::StaticOrder, true>(ldsl, g, S, E);
        SEAM(14);
    }

    if (IN(15)) {
        pg8::Gemm g{A3, WPG, T, D, D, D, 0}; pg8::StaticOrder S; S.init(T, D, F.G, (int)blockIdx.x);
        pg8::EpiPle E{out, out, PLEB, D};
        pg8::gemm_phase<pg8::EpiPle, pg8::StaticOrder, true>(ldsl, g, S, E);
        SEAM(15);
    }

    if (IN(16)) {
        for (int m = F.gw; m < T; m += F.NGW) {
            f32x4* xr = (f32x4*)(out + (size_t)m * D) + F.lane; const f32x4* gr = (const f32x4*)g_final + F.lane;
            f32x4 v[4]; float s = 0.f;
#pragma unroll
            for (int j = 0; j < 4; ++j) { v[j] = xr[64 * j]; s += (v[j][0] * v[j][0] + v[j][1] * v[j][1]) + (v[j][2] * v[j][2] + v[j][3] * v[j][3]); }
            const float rs = 1.0f / sqrtf(wave_sum(s) * (1.f / D) + EPS);
#pragma unroll
            for (int j = 0; j < 4; ++j) { const f32x4 gg = gr[64 * j]; xr[64 * j] = v[j] * rs * gg; }
        }
    }
#undef IN
#undef SEAM
}

constexpr int N_PHASES = 17;

extern "C" void kernel_launch(void* const* d_in, const int* in_sizes, int n_in, void* d_out, int out_size, void* d_ws, size_t ws_size, hipStream_t stream) {
    static int grid = 0;
    if (grid == 0) {
        if (n_in != 19 || out_size != T * D || ws_size < WS_END) { fprintf(stderr, "kernel_launch: unexpected shapes: n_in %d out %d ws %zu\n", n_in, out_size, ws_size); grid = -1; return; }
        int dev = 0, cus = 0, per_cu = 0;
        hipGetDevice(&dev); hipDeviceGetAttribute(&cus, hipDeviceAttributeMultiprocessorCount, dev);
        if (hipFuncSetAttribute((const void*)mega, hipFuncAttributeMaxDynamicSharedMemorySize, LDS_BYTES) != hipSuccess) { fprintf(stderr, "kernel_launch: hipFuncSetAttribute failed\n"); grid = -1; return; }
        if (hipOccupancyMaxActiveBlocksPerMultiprocessor(&per_cu, (const void*)mega, NTHREADS, LDS_BYTES) != hipSuccess || per_cu < 1) { fprintf(stderr, "kernel_launch: occupancy query says %d\n", per_cu); per_cu = 1; }
        (void)hipGetLastError();
        grid = cus;
        if (grid % 8 != 0) fprintf(stderr, "kernel_launch: grid %d not a multiple of 8\n", grid);
    }
    if (grid < 0) return;
    Args a{};
    for (int i = 0; i < 19; ++i) a.in[i] = (const float*)d_in[i];
    a.out = (float*)d_out; a.ws = (unsigned char*)d_ws;
#if MK_ONE_LAUNCH
    a.ph_lo = 0; a.ph_hi = N_PHASES;
    void* kargs[] = {&a};
    hipError_t e = hipLaunchCooperativeKernel((const void*)mega, dim3(grid), dim3(NTHREADS), kargs, LDS_BYTES, stream);
    if (e != hipSuccess) fprintf(stderr, "cooperative launch failed: %s (grid %d)\n", hipGetErrorString(e), grid);
#else
    for (int ph = 0; ph < N_PHASES; ++ph) {
        a.ph_lo = ph; a.ph_hi = ph + 1;
        hipLaunchKernelGGL(mega, dim3(grid), dim3(NTHREADS), LDS_BYTES, stream, a);
    }
#endif
}
```

```cpp
#include <hip/hip_runtime.h>
#include <hip/hip_cooperative_groups.h>
#include <cstdio>
#include <cstdint>
#include <cmath>
namespace cg = cooperative_groups;

#ifndef MK_ONE_LAUNCH
#define MK_ONE_LAUNCH 1
#endif

namespace pg8 {
#define PG8_LAS __attribute__((address_space(3)))
typedef unsigned short bf16_t;
typedef short bf16x8 __attribute__((ext_vector_type(8)));
typedef float f32x4 __attribute__((ext_vector_type(4)));
typedef unsigned u32x4 __attribute__((ext_vector_type(4)));
typedef unsigned u32x2 __attribute__((ext_vector_type(2)));
constexpr int BM = 256, BK = 64, HALF = 128, HTB = HALF * BK * 2, STAGE_BYTES = 8 * HTB, NXCD = 8, WGM = 8;

__host__ __device__ __forceinline__ int lds_byte(int r, int c) { const int st = (r >> 4) * 2 + (c >> 5), rr = r & 15, cc = c & 31, ob = rr * 64 + cc * 2; return st * 1024 + (ob ^ (((ob >> 9) & 1) << 5)); }
__host__ __device__ __forceinline__ void stage_rc(int b, int& R, int& C) { const int st = b / 1024, sb = b % 1024, swz = sb ^ (((sb >> 9) & 1) << 5); R = (st >> 1) * 16 + swz / 64; C = (st & 1) * 32 + (swz % 64) / 2; }
__host__ __device__ __forceinline__ int perm32(int rho) { const int n = rho >> 4, i = rho & 15; return 8 * (i >> 2) + 4 * n + (i & 3); }

struct Unit { int pm, pn; };
struct Gemm { const bf16_t* A; const bf16_t* Bt; int M, N, K, lda, a_pn_cols; };

struct StaticOrder {
    int nM, nN, nwg, G, c;
    __host__ __device__ void init(int M, int N, int G_, int c_) { nM = M / BM; nN = N / BM; nwg = nM * nN; G = G_; c = c_; }
    __host__ __device__ bool next(int i, Unit& u) const {
        const long L = (long)i * G + c; if (L >= nwg) return false;
        int wgid = (int)L; { const int q = nwg / NXCD, r = nwg % NXCD, xcd = wgid % NXCD, off = wgid / NXCD; wgid = (xcd < r ? xcd * (q + 1) : r * (q + 1) + (xcd - r) * q) + off; }
        const int nig = WGM * nN, gid = wgid / nig, fm = gid * WGM, gsz = (nM - fm) < WGM ? (nM - fm) : WGM;
        u.pm = fm + ((wgid % nig) % gsz); u.pn = (wgid % nig) / gsz; return true;
    }
    __device__ __forceinline__ void a_ready(const Unit&) const {}
    __device__ __forceinline__ void done(const Unit&) const {}
};

__device__ __forceinline__ unsigned cvt_pk_bf16(float lo, float hi) { unsigned r; asm volatile("v_cvt_pk_bf16_f32 %0, %1, %2" : "=v"(r) : "v"(lo), "v"(hi)); return r; }
__device__ __forceinline__ float bf_lo(unsigned w) { return __uint_as_float(w << 16); }
__device__ __forceinline__ float bf_hi(unsigned w) { return __uint_as_float(w & 0xffff0000u); }
__device__ __forceinline__ float sigmoidf_(float x) { return 1.0f / (1.0f + __expf(-x)); }

struct EpiBf16 {
    static constexpr bool PERM = true, AFTER_DRAIN = false;
    bf16_t* O; int ldc;
    __device__ __forceinline__ void operator()(const f32x4 (&acc)[2][2][4][2], const Unit& u, int wr, int wc, int fr, int fq) const {
        const int row0 = u.pm * BM + wr * 64 + fr; const int col0 = u.pn * BM + wc * 32 + 8 * fq;
#pragma unroll
        for (int ai = 0; ai < 2; ++ai)
#pragma unroll
            for (int m = 0; m < 4; ++m) { bf16_t* rowp = O + (size_t)(row0 + ai * HALF + m * 16) * ldc + col0;
#pragma unroll
                for (int bj = 0; bj < 2; ++bj) { const f32x4 v0 = acc[ai][bj][m][0], v1 = acc[ai][bj][m][1];
                    u32x4 w; w.x = cvt_pk_bf16(v0[0], v0[1]); w.y = cvt_pk_bf16(v0[2], v0[3]); w.z = cvt_pk_bf16(v1[0], v1[1]); w.w = cvt_pk_bf16(v1[2], v1[3]);
                    *(u32x4*)(rowp + bj * HALF) = w; } }
    }
};
template <bool ACCUM> struct EpiGate {
    static constexpr bool PERM = true, AFTER_DRAIN = false;
    bf16_t* O; int ldc; const bf16_t* G; int ldg; int gcol;
    __device__ __forceinline__ void operator()(const f32x4 (&acc)[2][2][4][2], const Unit& u, int wr, int wc, int fr, int fq) const {
        const int row0 = u.pm * BM + wr * 64 + fr; const int col0 = u.pn * BM + wc * 32 + 8 * fq;
#pragma unroll
        for (int ai = 0; ai < 2; ++ai) {
            u32x4 gpre[4][2], opre[4][2];
#pragma unroll
            for (int m = 0; m < 4; ++m)
#pragma unroll
                for (int bj = 0; bj < 2; ++bj) { const size_t r = (size_t)(row0 + ai * HALF + m * 16); gpre[m][bj] = *(const u32x4*)(G + r * ldg + gcol + col0 + bj * HALF);
                    if (ACCUM) opre[m][bj] = *(const u32x4*)(O + r * ldc + col0 + bj * HALF); }
            asm volatile("" ::: "memory");
#pragma unroll
            for (int m = 0; m < 4; ++m) { const size_t r = (size_t)(row0 + ai * HALF + m * 16);
#pragma unroll
                for (int bj = 0; bj < 2; ++bj) { const f32x4 v0 = acc[ai][bj][m][0], v1 = acc[ai][bj][m][1];
                    const u32x4 g = gpre[m][bj];
                    float o[8];
                    o[0] = sigmoidf_(bf_lo(g.x)) * v0[0]; o[1] = sigmoidf_(bf_hi(g.x)) * v0[1]; o[2] = sigmoidf_(bf_lo(g.y)) * v0[2]; o[3] = sigmoidf_(bf_hi(g.y)) * v0[3];
                    o[4] = sigmoidf_(bf_lo(g.z)) * v1[0]; o[5] = sigmoidf_(bf_hi(g.z)) * v1[1]; o[6] = sigmoidf_(bf_lo(g.w)) * v1[2]; o[7] = sigmoidf_(bf_hi(g.w)) * v1[3];
                    bf16_t* op = O + r * ldc + col0 + bj * HALF;
                    if (ACCUM) { const u32x4 p = opre[m][bj];
                        o[0] += bf_lo(p.x); o[1] += bf_hi(p.x); o[2] += bf_lo(p.y); o[3] += bf_hi(p.y); o[4] += bf_lo(p.z); o[5] += bf_hi(p.z); o[6] += bf_lo(p.w); o[7] += bf_hi(p.w); }
                    u32x4 w; w.x = cvt_pk_bf16(o[0], o[1]); w.y = cvt_pk_bf16(o[2], o[3]); w.z = cvt_pk_bf16(o[4], o[5]); w.w = cvt_pk_bf16(o[6], o[7]);
                    *(u32x4*)op = w; } }
        }
    }
};
struct EpiResF32 {
    static constexpr bool PERM = false, AFTER_DRAIN = false;
    const float* base; float* out; int ldc;
    __device__ __forceinline__ void operator()(const f32x4 (&acc)[2][2][4][2], const Unit& u, int wr, int wc, int fr, int fq) const {
        const int row0 = u.pm * BM + wr * 64 + fr; const int col0 = u.pn * BM + wc * 32 + 4 * fq;
#pragma unroll
        for (int ai = 0; ai < 2; ++ai)
#pragma unroll
            for (int m = 0; m < 4; ++m) { const size_t off = (size_t)(row0 + ai * HALF + m * 16) * ldc + col0;
#pragma unroll
                for (int bj = 0; bj < 2; ++bj)
#pragma unroll
                    for (int n = 0; n < 2; ++n) { const f32x4 b = *(const f32x4*)(base + off + bj * HALF + n * 16); *(f32x4*)(out + off + bj * HALF + n * 16) = b + acc[ai][bj][m][n]; } }
    }
};
struct EpiQKVG {
    static constexpr bool PERM = true, AFTER_DRAIN = false;
    bf16_t* O; const float* COS; const float* SIN;
    __device__ __forceinline__ void operator()(const f32x4 (&acc)[2][2][4][2], const Unit& u, int wr, int wc, int fr, int fq) const {
        const int row0 = u.pm * BM + wr * 64 + fr; const int col0 = u.pn * BM + wc * 32 + 8 * fq;
        const bool rot = u.pn < 4; const float sc = (u.pn >= 2 && u.pn < 4) ? 0.08838834764831845f : 1.0f; const int i0 = 4 * (wc * 4 + fq);
#pragma unroll
        for (int ai = 0; ai < 2; ++ai)
#pragma unroll
            for (int m = 0; m < 4; ++m) { const int row = row0 + ai * HALF + m * 16; bf16_t* rowp = O + (size_t)row * 3072 + col0;
                f32x4 c = (f32x4){1.f, 1.f, 1.f, 1.f}, s = (f32x4){0.f, 0.f, 0.f, 0.f};
                if (rot) { const size_t ti = (size_t)(row & 4095) * 64 + i0; c = *(const f32x4*)(COS + ti) * sc; s = *(const f32x4*)(SIN + ti) * sc; }
#pragma unroll
                for (int bj = 0; bj < 2; ++bj) { f32x4 v0 = acc[ai][bj][m][0], v1 = acc[ai][bj][m][1];
                    if (rot) { const f32x4 r1 = v0 * c - v1 * s, r2 = v0 * s + v1 * c; v0 = r1; v1 = r2; }
                    u32x4 w; w.x = cvt_pk_bf16(v0[0], v0[1]); w.y = cvt_pk_bf16(v0[2], v0[3]); w.z = cvt_pk_bf16(v1[0], v1[1]); w.w = cvt_pk_bf16(v1[2], v1[3]);
                    *(u32x4*)(rowp + bj * HALF) = w; } }
    }
};
struct EpiConvGates {
    static constexpr bool PERM = true, AFTER_DRAIN = false;
    bf16_t* CB; bf16_t* UU; bf16_t* GT;
    __device__ __forceinline__ void operator()(const f32x4 (&acc)[2][2][4][2], const Unit& u, int wr, int wc, int fr, int fq) const {
        const int row0 = u.pm * BM + wr * 64 + fr;
        if (u.pn >= 4 && u.pn < 12) {
            const int col0 = (u.pn - 4) * 128 + wc * 32 + 8 * fq;
#pragma unroll
            for (int ai = 0; ai < 2; ++ai)
#pragma unroll
                for (int m = 0; m < 4; ++m) { const f32x4 v0 = acc[ai][0][m][0] * acc[ai][1][m][0], v1 = acc[ai][0][m][1] * acc[ai][1][m][1];
                    u32x4 w; w.x = cvt_pk_bf16(v0[0], v0[1]); w.y = cvt_pk_bf16(v0[2], v0[3]); w.z = cvt_pk_bf16(v1[0], v1[1]); w.w = cvt_pk_bf16(v1[2], v1[3]);
                    *(u32x4*)(UU + (size_t)(row0 + ai * HALF + m * 16) * 1024 + col0) = w; }
        } else {
            bf16_t* O = u.pn < 4 ? CB : GT; const int ldc = u.pn < 4 ? 1024 : 2048; const int col0 = (u.pn < 4 ? u.pn : u.pn - 12) * BM + wc * 32 + 8 * fq;
#pragma unroll
            for (int ai = 0; ai < 2; ++ai)
#pragma unroll
                for (int m = 0; m < 4; ++m) { bf16_t* rowp = O + (size_t)(row0 + ai * HALF + m * 16) * ldc + col0;
#pragma unroll
                    for (int bj = 0; bj < 2; ++bj) { const f32x4 v0 = acc[ai][bj][m][0], v1 = acc[ai][bj][m][1];
                        u32x4 w; w.x = cvt_pk_bf16(v0[0], v0[1]); w.y = cvt_pk_bf16(v0[2], v0[3]); w.z = cvt_pk_bf16(v1[0], v1[1]); w.w = cvt_pk_bf16(v1[2], v1[3]);
                        *(u32x4*)(rowp + bj * HALF) = w; } }
        }
    }
};
struct EpiResBf16SS {
    static constexpr bool PERM = true, AFTER_DRAIN = false;
    const float* base; bf16_t* O; float* SS; int ldc;
    __device__ __forceinline__ void operator()(const f32x4 (&acc)[2][2][4][2], const Unit& u, int wr, int wc, int fr, int fq) const {
        const int row0 = u.pm * BM + wr * 64 + fr; const int col0 = u.pn * BM + wc * 32 + 8 * fq;
#pragma unroll
        for (int ai = 0; ai < 2; ++ai) {
            f32x4 pre[4][2][2];
#pragma unroll
            for (int m = 0; m < 4; ++m)
#pragma unroll
                for (int bj = 0; bj < 2; ++bj) { const size_t o = (size_t)(row0 + ai * HALF + m * 16) * ldc + col0 + bj * HALF; pre[m][bj][0] = *(const f32x4*)(base + o); pre[m][bj][1] = *(const f32x4*)(base + o + 4); }
            asm volatile("" ::: "memory");
#pragma unroll
            for (int m = 0; m < 4; ++m) { const size_t r = (size_t)(row0 + ai * HALF + m * 16); float ssq = 0.f;
#pragma unroll
                for (int bj = 0; bj < 2; ++bj) { const size_t o = r * ldc + col0 + bj * HALF;
                    const f32x4 h0 = pre[m][bj][0] + acc[ai][bj][m][0], h1 = pre[m][bj][1] + acc[ai][bj][m][1];
                    ssq += (h0[0] * h0[0] + h0[1] * h0[1]) + (h0[2] * h0[2] + h0[3] * h0[3]) + (h1[0] * h1[0] + h1[1] * h1[1]) + (h1[2] * h1[2] + h1[3] * h1[3]);
                    u32x4 w; w.x = cvt_pk_bf16(h0[0], h0[1]); w.y = cvt_pk_bf16(h0[2], h0[3]); w.z = cvt_pk_bf16(h1[0], h1[1]); w.w = cvt_pk_bf16(h1[2], h1[3]);
                    *(u32x4*)(O + o) = w; }
                ssq += __shfl_xor(ssq, 16); ssq += __shfl_xor(ssq, 32);
                if (fq == 0) SS[r * 16 + u.pn * 4 + wc] = ssq; }
        }
    }
};
struct EpiPleBf16SS {
    static constexpr bool PERM = true, AFTER_DRAIN = false;
    const bf16_t* H; const bf16_t* P; bf16_t* O; const float* RS; float* SS; int ldc;
    __device__ __forceinline__ void operator()(const f32x4 (&acc)[2][2][4][2], const Unit& u, int wr, int wc, int fr, int fq) const {
        const int row0 = u.pm * BM + wr * 64 + fr; const int col0 = u.pn * BM + wc * 32 + 8 * fq;
#pragma unroll
        for (int ai = 0; ai < 2; ++ai) {
            float rsv[4];
#pragma unroll
            for (int m = 0; m < 4; ++m) { const size_t r = (size_t)(row0 + ai * HALF + m * 16); const f32x4 s0 = *(const f32x4*)(RS + r * 8), s1 = *(const f32x4*)(RS + r * 8 + 4);
                rsv[m] = 1.0f / sqrtf((((s0[0] + s0[1]) + (s0[2] + s0[3])) + ((s1[0] + s1[1]) + (s1[2] + s1[3]))) * (1.0f / 1024.0f) + 1e-6f); }
            asm volatile("" : "+v"(rsv[0]), "+v"(rsv[1]), "+v"(rsv[2]), "+v"(rsv[3]) :: "memory");
            u32x4 hpre[4][2], ppre[4][2];
#pragma unroll
            for (int m = 0; m < 4; ++m) { const size_t r = (size_t)(row0 + ai * HALF + m * 16);
#pragma unroll
                for (int bj = 0; bj < 2; ++bj) { const size_t o = r * ldc + col0 + bj * HALF; hpre[m][bj] = *(const u32x4*)(H + o); ppre[m][bj] = *(const u32x4*)(P + o); } }
            asm volatile("" ::: "memory");
#pragma unroll
            for (int m = 0; m < 4; ++m) { const size_t r = (size_t)(row0 + ai * HALF + m * 16); float ssq = 0.f; const float rs = rsv[m];
#pragma unroll
                for (int bj = 0; bj < 2; ++bj) { const size_t o = r * ldc + col0 + bj * HALF;
                    const u32x4 hw = hpre[m][bj], pw = ppre[m][bj]; const f32x4 a0 = acc[ai][bj][m][0], a1 = acc[ai][bj][m][1];
                    float h[8];
                    h[0] = bf_lo(hw.x) + sigmoidf_(rs * a0[0]) * bf_lo(pw.x); h[1] = bf_hi(hw.x) + sigmoidf_(rs * a0[1]) * bf_hi(pw.x);
                    h[2] = bf_lo(hw.y) + sigmoidf_(rs * a0[2]) * bf_lo(pw.y); h[3] = bf_hi(hw.y) + sigmoidf_(rs * a0[3]) * bf_hi(pw.y);
                    h[4] = bf_lo(hw.z) + sigmoidf_(rs * a1[0]) * bf_lo(pw.z); h[5] = bf_hi(hw.z) + sigmoidf_(rs * a1[1]) * bf_hi(pw.z);
                    h[6] = bf_lo(hw.w) + sigmoidf_(rs * a1[2]) * bf_lo(pw.w); h[7] = bf_hi(hw.w) + sigmoidf_(rs * a1[3]) * bf_hi(pw.w);
#pragma unroll
                    for (int z = 0; z < 8; ++z) ssq += h[z] * h[z];
                    u32x4 w; w.x = cvt_pk_bf16(h[0], h[1]); w.y = cvt_pk_bf16(h[2], h[3]); w.z = cvt_pk_bf16(h[4], h[5]); w.w = cvt_pk_bf16(h[6], h[7]);
                    *(u32x4*)(O + o) = w; }
                ssq += __shfl_xor(ssq, 16); ssq += __shfl_xor(ssq, 32);
                if (fq == 0) SS[r * 16 + u.pn * 4 + wc] = ssq; }
        }
    }
};
struct EpiPle {
    static constexpr bool PERM = false, AFTER_DRAIN = false;
    const float* base; float* out; const bf16_t* P; int ldc;
    __device__ __forceinline__ void operator()(const f32x4 (&acc)[2][2][4][2], const Unit& u, int wr, int wc, int fr, int fq) const {
        const int row0 = u.pm * BM + wr * 64 + fr; const int col0 = u.pn * BM + wc * 32 + 4 * fq;
#pragma unroll
        for (int ai = 0; ai < 2; ++ai)
#pragma unroll
            for (int m = 0; m < 4; ++m) { const size_t off = (size_t)(row0 + ai * HALF + m * 16) * ldc + col0;
#pragma unroll
                for (int bj = 0; bj < 2; ++bj)
#pragma unroll
                    for (int n = 0; n < 2; ++n) { const size_t o = off + bj * HALF + n * 16; const f32x4 b = *(const f32x4*)(base + o); const u32x2 p = *(const u32x2*)(P + o); const f32x4 a = acc[ai][bj][m][n];
                        f32x4 r; r[0] = b[0] + sigmoidf_(a[0]) * bf_lo(p.x); r[1] = b[1] + sigmoidf_(a[1]) * bf_hi(p.x); r[2] = b[2] + sigmoidf_(a[2]) * bf_lo(p.y); r[3] = b[3] + sigmoidf_(a[3]) * bf_hi(p.y);
                        *(f32x4*)(out + o) = r; } }
    }
};

template <class Epi, class Sched, bool ALIGN_EPI>
__device__ __forceinline__ void gemm_phase(PG8_LAS unsigned char* lds, const Gemm g, const Sched& S, const Epi& E) {
    const int tid = threadIdx.x, wid = __builtin_amdgcn_readfirstlane(tid >> 6), lane = tid & 63, wr = wid >> 2, wc = wid & 3, fr = lane & 15, fq = lane >> 4;
    const int K = g.K, nt = K / BK, lda = g.lda;
    unsigned voffA[2], voffB[2];
#pragma unroll
    for (int i = 0; i < 2; ++i) { int R, C; stage_rc(tid * 16 + i * 8192, R, C); const int Rb = Epi::PERM ? ((R & ~31) + perm32(R & 31)) : R;
        voffA[i] = (unsigned)(R * lda + C) * 2u; voffB[i] = (unsigned)(Rb * K + C) * 2u; }
    const size_t kstep = (size_t)(BK * 2);
    const size_t hstepA = (size_t)HALF * lda * 2, hstepB = (size_t)HALF * K * 2;
    const size_t tstepA = 2 * hstepA, tstepB = 2 * hstepB;
    const size_t pnstepA = (size_t)g.a_pn_cols * 2;
    const unsigned ldsw = (unsigned)wid * 1024u;
    const int aoff = lds_byte(wr * 64 + fr, fq * 8), boff = lds_byte(wc * 32 + fr, fq * 8);
#define PG8_SA(b, h) (((b) * 2 + (h)) * HTB)
#define PG8_SB(b, h) ((4 + (b) * 2 + (h)) * HTB)
#define PG8_STAGE(bufoff, gbase, voff) do { _Pragma("unroll") for (int _i = 0; _i < 2; ++_i) \
        __builtin_amdgcn_global_load_lds((const unsigned*)((const char*)(gbase) + (voff)[_i]), (PG8_LAS unsigned*)(lds + (bufoff) + ldsw + _i * 8192), 16, 0, 0); } while (0)
#define PG8_LDA(dst, b, h) do { _Pragma("unroll") for (int m = 0; m < 4; ++m) _Pragma("unroll") for (int k = 0; k < 2; ++k) dst[m][k] = *(const PG8_LAS bf16x8*)(lds + PG8_SA(b, h) + aoff + m * 2048 + k * 1024); } while (0)
#define PG8_LDB(dst, b, h) do { _Pragma("unroll") for (int n = 0; n < 2; ++n) _Pragma("unroll") for (int k = 0; k < 2; ++k) dst[n][k] = *(const PG8_LAS bf16x8*)(lds + PG8_SB(b, h) + boff + n * 2048 + k * 1024); } while (0)
#define PG8_MMA(ai, bj, At, Bt) do { __builtin_amdgcn_s_setprio(1); _Pragma("unroll") for (int m = 0; m < 4; ++m) _Pragma("unroll") for (int n = 0; n < 2; ++n) _Pragma("unroll") for (int k = 0; k < 2; ++k) \
        acc[ai][bj][m][n] = __builtin_amdgcn_mfma_f32_16x16x32_bf16(Bt[n][k], At[m][k], acc[ai][bj][m][n], 0, 0, 0); __builtin_amdgcn_s_setprio(0); } while (0)
#define PG8_WAIT_V(n) asm volatile("s_waitcnt vmcnt(" #n ")" ::: "memory")
#define PG8_WAIT_L(n) asm volatile("s_waitcnt lgkmcnt(" #n ")" ::: "memory")
#define PG8_BAR __builtin_amdgcn_s_barrier()
#define PG8_SCHED __builtin_amdgcn_sched_barrier(0)
    Unit cur, nxt; int ui = 0;
    if (!S.next(0, cur)) return;
    f32x4 acc[2][2][4][2];
#pragma unroll
    for (int a = 0; a < 2; ++a)
#pragma unroll
        for (int b = 0; b < 2; ++b)
#pragma unroll
            for (int m = 0; m < 4; ++m)
#pragma unroll
                for (int n = 0; n < 2; ++n) acc[a][b][m][n] = (f32x4){0.f, 0.f, 0.f, 0.f};
    bf16x8 At[4][2], B0[2][2], B1[2][2];
    const char* cA = (const char*)g.A + (size_t)cur.pm * tstepA + (size_t)cur.pn * pnstepA; const char* cB = (const char*)g.Bt + (size_t)cur.pn * tstepB;
    S.a_ready(cur);
    PG8_STAGE(PG8_SB(0, 0), cB, voffB); PG8_STAGE(PG8_SB(0, 1), cB + hstepB, voffB); PG8_STAGE(PG8_SA(0, 0), cA, voffA); PG8_STAGE(PG8_SA(0, 1), cA + hstepA, voffA);
    if (wr == 1) PG8_BAR;
    PG8_WAIT_V(2); PG8_BAR;
    PG8_STAGE(PG8_SB(1, 0), cB + kstep, voffB); PG8_STAGE(PG8_SA(1, 0), cA + kstep, voffA); PG8_STAGE(PG8_SB(1, 1), cB + hstepB + kstep, voffB);
    PG8_WAIT_V(6); PG8_BAR;
    for (;;) {
        const bool has_next = S.next(ui + 1, nxt);
        const char* nA = has_next ? (const char*)g.A + (size_t)nxt.pm * tstepA + (size_t)nxt.pn * pnstepA : cA; const char* nB = has_next ? (const char*)g.Bt + (size_t)nxt.pn * tstepB : cB;
        for (int t = 0; t < nt; t += 2) {
            const bool last = (t == nt - 2);
            const char* a1 = cA + (size_t)(t + 1) * kstep;
            const char* a2 = last ? nA : cA + (size_t)(t + 2) * kstep; const char* b2 = last ? nB : cB + (size_t)(t + 2) * kstep;
            const char* a3 = a2 + kstep; const char* b3 = b2 + kstep;
            if (last && has_next) S.a_ready(nxt);
            PG8_LDB(B0, 0, 0); PG8_LDB(B1, 0, 1); PG8_SCHED; PG8_LDA(At, 0, 0); PG8_STAGE(PG8_SA(1, 1), a1 + hstepA, voffA);
            PG8_WAIT_V(8); PG8_WAIT_L(0); PG8_BAR; PG8_MMA(0, 0, At, B0); PG8_MMA(0, 1, At, B1); PG8_BAR; PG8_SCHED;
            PG8_LDA(At, 0, 1); PG8_STAGE(PG8_SB(0, 0), b2, voffB); PG8_STAGE(PG8_SB(0, 1), b2 + hstepB, voffB); PG8_STAGE(PG8_SA(0, 0), a2, voffA);
            PG8_WAIT_V(8); PG8_WAIT_L(0); PG8_BAR; PG8_MMA(1, 0, At, B0); PG8_MMA(1, 1, At, B1); PG8_BAR; PG8_SCHED;
            PG8_LDB(B0, 1, 0); PG8_LDB(B1, 1, 1); PG8_SCHED; PG8_LDA(At, 1, 0); PG8_STAGE(PG8_SA(0, 1), a2 + hstepA, voffA);
            PG8_WAIT_V(8); PG8_WAIT_L(0); PG8_BAR; PG8_MMA(0, 0, At, B0); PG8_MMA(0, 1, At, B1); PG8_BAR; PG8_SCHED;
            PG8_LDA(At, 1, 1); PG8_STAGE(PG8_SB(1, 0), b3, voffB); PG8_STAGE(PG8_SB(1, 1), b3 + hstepB, voffB); PG8_STAGE(PG8_SA(1, 0), a3, voffA);
            PG8_WAIT_V(8); PG8_WAIT_L(0); PG8_BAR; PG8_MMA(1, 0, At, B0); PG8_MMA(1, 1, At, B1); PG8_BAR; PG8_SCHED;
        }
        if constexpr (ALIGN_EPI) { if (wr == 0) PG8_BAR; }
        E(acc, cur, wr, wc, fr, fq); S.done(cur);
        if (!has_next) break;
#pragma unroll
        for (int a = 0; a < 2; ++a)
#pragma unroll
            for (int b = 0; b < 2; ++b)
#pragma unroll
                for (int m = 0; m < 4; ++m)
#pragma unroll
                    for (int n = 0; n < 2; ++n) acc[a][b][m][n] = (f32x4){0.f, 0.f, 0.f, 0.f};
        cur = nxt; cA = nA; cB = nB; ++ui;
        if constexpr (ALIGN_EPI) { if (wr == 1) PG8_BAR; }
    }
    PG8_WAIT_V(0);
    if constexpr (!ALIGN_EPI) { if (wr == 0) PG8_BAR; }
    PG8_BAR;
#undef PG8_SA
#undef PG8_SB
#undef PG8_STAGE
#undef PG8_LDA
#undef PG8_LDB
#undef PG8_MMA
#undef PG8_WAIT_V
#undef PG8_WAIT_L
#undef PG8_BAR
#undef PG8_SCHED
}
}

constexpr int NWAVES = 8, NTHREADS = NWAVES * 64;
constexpr int BATCH = 8, SEQ = 4096, D = 1024, T = BATCH * SEQ;
constexpr int RH = 4, RDK = 128, RDV = 256, RC = 128, NCH = SEQ / RC;
constexpr int RQK = RH * RDK, RV = RH * RDV;
constexpr int INW = 8192;
constexpr int PH = 8, PNK = 128, PNE = PNK * PNK, PQD = 256, PHALF = 128, PTOPK = 16, NSEL = PH * PTOPK;
constexpr int PLE = 256;
constexpr float EPS = 1e-6f;
constexpr int NUNITS_R = BATCH * NCH * RH;

constexpr size_t MiB = 1u << 20;
constexpr size_t WS_CTL = 0, CTL_ZERO_BYTES = 64 * 1024;
constexpr size_t WS_COS = 1 * MiB, WS_SIN = 2 * MiB;
constexpr size_t WS_WIN = 3 * MiB;
constexpr size_t WS_WRU = 19 * MiB, WS_WCU = 21 * MiB, WS_WOUT = 23 * MiB;
constexpr size_t WS_WPQ = 25 * MiB;
constexpr size_t WS_WPP = 29 * MiB;
constexpr size_t WS_K1 = 29 * MiB + 512 * 1024, WS_K2 = 29 * MiB + 768 * 1024;
constexpr size_t WS_WPG = 30 * MiB;
constexpr size_t WS_UB = 32 * MiB, WS_VB = 64 * MiB;
constexpr size_t WS_XN = 96 * MiB;
constexpr size_t WS_BIG = 160 * MiB;
constexpr size_t WS_PREV = 352 * MiB;
constexpr size_t WS_ARET = 416 * MiB;
constexpr size_t WS_IDX = 480 * MiB, WS_GATE = 496 * MiB;
constexpr size_t WS_END = 512 * MiB;

constexpr int LDS_BYTES = 160 * 1024;

constexpr int PNE_ROWS = 16384;
typedef unsigned short bf16;
typedef unsigned v4u __attribute__((ext_vector_type(4)));
typedef unsigned v2u __attribute__((ext_vector_type(2)));
typedef float f32x4 __attribute__((ext_vector_type(4)));
#define LAS __attribute__((address_space(3)))

__device__ __forceinline__ unsigned f2bf(float f) { unsigned u = __float_as_uint(f); return (u + 0x7fffu + ((u >> 16) & 1u)) >> 16; }
__device__ __forceinline__ unsigned pk2(float lo, float hi) { return f2bf(lo) | (f2bf(hi) << 16); }
__device__ __forceinline__ float bflo(unsigned w) { return __uint_as_float(w << 16); }
__device__ __forceinline__ float bfhi(unsigned w) { return __uint_as_float(w & 0xffff0000u); }
__device__ __forceinline__ float bf2f(bf16 h) { return __uint_as_float(((unsigned)h) << 16); }
__device__ __forceinline__ float wave_sum(float v) {
#pragma unroll
    for (int o = 1; o < 64; o <<= 1) v += __shfl_xor(v, o);
    return v;
}
__device__ __forceinline__ float wave_max(float v) {
#pragma unroll
    for (int o = 1; o < 64; o <<= 1) v = fmaxf(v, __shfl_xor(v, o));
    return v;
}
__device__ __forceinline__ void unpack8(const v4u w, float* f) { f[0] = bflo(w.x); f[1] = bfhi(w.x); f[2] = bflo(w.y); f[3] = bfhi(w.y); f[4] = bflo(w.z); f[5] = bfhi(w.z); f[6] = bflo(w.w); f[7] = bfhi(w.w); }


typedef float f32x16 __attribute__((ext_vector_type(16)));
typedef short bf16x8v __attribute__((ext_vector_type(8)));
__device__ __forceinline__ unsigned ord_key(float f) { const unsigned u = __float_as_uint(f); return u ^ ((unsigned)((int)u >> 31) | 0x80000000u); }
__device__ __forceinline__ float ord_val(unsigned k) { return __uint_as_float(k ^ (~(unsigned)((int)k >> 31) | 0x80000000u)); }
__device__ __forceinline__ void sort16_desc(unsigned (&x)[16]) {
#pragma unroll
    for (int ks = 1; ks <= 4; ++ks) {
#pragma unroll
        for (int js = ks - 1; js >= 0; --js) {
#pragma unroll
            for (int i = 0; i < 16; ++i) { const int k = 1 << ks, j = 1 << js, l = i ^ j;
                if (l > i) { const unsigned hi = max(x[i], x[l]), lo = min(x[i], x[l]); if ((i & k) == 0) { x[i] = hi; x[l] = lo; } else { x[i] = lo; x[l] = hi; } } }
        }
    }
}
__device__ __forceinline__ void merge16_desc(unsigned (&a)[16], const unsigned (&b)[16]) {
#pragma unroll
    for (int i = 0; i < 16; ++i) a[i] = max(a[i], b[15 - i]);
#pragma unroll
    for (int js = 3; js >= 0; --js) {
#pragma unroll
        for (int i = 0; i < 16; ++i) { const int j = 1 << js, l = i ^ j;
            if (l > i) { const unsigned hi = max(a[i], a[l]), lo = min(a[i], a[l]); a[i] = hi; a[l] = lo; } }
    }
}

__device__ __forceinline__ void peer_half_topk(const bf16* qrow, const bf16* kb, int hg, unsigned (&V)[16]) {
    constexpr int LS = 136;
    bf16x8v qf[8];
#pragma unroll
    for (int ks = 0; ks < 8; ++ks) qf[ks] = *(const bf16x8v*)(qrow + 16 * ks);
    f32x16 acc[4];
#pragma unroll
    for (int b = 0; b < 4; ++b)
#pragma unroll
        for (int z = 0; z < 16; ++z) acc[b][z] = 0.f;
#pragma unroll
    for (int ks = 0; ks < 8; ++ks)
#pragma unroll
        for (int b = 0; b < 4; ++b) { const bf16x8v a = *(const bf16x8v*)(kb + b * 32 * LS + 16 * ks); acc[b] = __builtin_amdgcn_mfma_f32_32x32x16_bf16(a, qf[ks], acc[b], 0, 0, 0); }
    unsigned x0[16], x1[16], x2[16], x3[16];
#pragma unroll
    for (int z = 0; z < 16; ++z) { const int nb = (z & 3) + 8 * (z >> 2) + 4 * hg;
        x0[z] = (ord_key(acc[0][z]) & ~0x7Fu) | (unsigned)(127 - nb);
        x1[z] = (ord_key(acc[1][z]) & ~0x7Fu) | (unsigned)(127 - (32 + nb));
        x2[z] = (ord_key(acc[2][z]) & ~0x7Fu) | (unsigned)(127 - (64 + nb));
        x3[z] = (ord_key(acc[3][z]) & ~0x7Fu) | (unsigned)(127 - (96 + nb)); }
    sort16_desc(x0); sort16_desc(x1); merge16_desc(x0, x1);
    sort16_desc(x2); sort16_desc(x3); merge16_desc(x2, x3);
    merge16_desc(x0, x2);
    unsigned pz[16];
#pragma unroll
    for (int z = 0; z < 16; ++z) { auto rr = __builtin_amdgcn_permlane32_swap(x0[z], x0[z], false, false); pz[z] = hg ? rr[0] : rr[1]; }
    merge16_desc(x0, pz);
#pragma unroll
    for (int z = 0; z < 16; ++z) V[z] = x0[z];
}

typedef short v4i16_t __attribute__((ext_vector_type(4)));
__device__ __forceinline__ v4i16_t ds_tr4(LAS const unsigned char* p) { return __builtin_amdgcn_ds_read_tr16_b64_v4i16((LAS v4i16_t*)p); }
__device__ __forceinline__ bf16x8v cat8(v4i16_t a, v4i16_t b) { return __builtin_shufflevector(a, b, 0, 1, 2, 3, 4, 5, 6, 7); }

__device__ __forceinline__ void sort128_asc(unsigned& k0, unsigned& k1, int lane) {
#pragma unroll
    for (int ks = 1; ks <= 7; ++ks) {
#pragma unroll
        for (int js = ks - 1; js >= 0; --js) {
            const int K = 1 << ks, J = 1 << js;
            if (J == 64) { const unsigned lo = min(k0, k1), hi = max(k0, k1); k0 = lo; k1 = hi; }
            else {
                const bool lower = (lane & J) == 0;
                const bool up0 = (K <= 32) ? ((lane & K) == 0) : true;
                const bool up1 = (K <= 32) ? ((lane & K) == 0) : (K == 128);
                const unsigned o0 = __shfl_xor(k0, J), o1 = __shfl_xor(k1, J);
                k0 = (lower == up0) ? min(k0, o0) : max(k0, o0);
                k1 = (lower == up1) ? min(k1, o1) : max(k1, o1);
            }
        }
    }
}

#define XB_TMO      128
#define XB_XCNT(j)  (256  + 64 * (j))
#define XB_XSUB(j)  (1280 + 64 * (j))
#define XB_XGEN(j)  (2304 + 64 * (j))
#define XB_TOP      3328
#define XB_TOPGEN   3392
#define XCD_BAR_WORDS 3456
#define XB_SPIN_CAP (1u << 20)
__device__ __forceinline__ unsigned xb_ld(unsigned* p)              { return __hip_atomic_load(p, __ATOMIC_RELAXED, __HIP_MEMORY_SCOPE_AGENT); }
__device__ __forceinline__ unsigned xb_add(unsigned* p, unsigned v) { return __hip_atomic_fetch_add(p, v, __ATOMIC_RELAXED, __HIP_MEMORY_SCOPE_AGENT); }
__device__ __forceinline__ unsigned xb_xcc_id() { return (unsigned)__builtin_amdgcn_s_getreg((3 << 11) | 20) & 0xFu; }
#define XB_SPIN(cond, bar) do { unsigned _sp = 0; while (cond) { __builtin_amdgcn_s_sleep(1); \
    if ((++_sp & 255u) == 0u) { if (xb_ld(&(bar)[XB_TMO])) break; if (_sp > XB_SPIN_CAP) { atomicAdd(&(bar)[XB_TMO], 1u); break; } } } } while (0)
struct XcdBarrier { unsigned* bar; unsigned x; volatile LAS unsigned* st; };
__device__ __forceinline__ XcdBarrier xcd_barrier_post(unsigned* bar, volatile LAS unsigned* st) {
    XcdBarrier b; b.bar = bar; b.x = xb_xcc_id(); b.st = st;
    if (threadIdx.x == 0) (void)xb_add(&bar[XB_XCNT(b.x)], 1u);
    return b;
}
__device__ __forceinline__ void xcd_barrier_complete(unsigned* bar, unsigned x, unsigned& nloc, unsigned& nx) {
    const unsigned G = gridDim.x * gridDim.y * gridDim.z;
    unsigned sum, cnt, mine, sp = 0u;
    for (;;) {
        sum = 0u; cnt = 0u; mine = 0u;
#pragma unroll
        for (unsigned j = 0; j < 16; ++j) { const unsigned c = xb_ld(&bar[XB_XCNT(j)]); sum += c; cnt += (c > 0u) ? 1u : 0u; mine = (j == x) ? c : mine; }
        if (sum == G) break;
        __builtin_amdgcn_s_sleep(1);
        if ((++sp & 255u) == 0u) { if (xb_ld(&bar[XB_TMO])) break; if (sp > XB_SPIN_CAP) { atomicAdd(&bar[XB_TMO], 1u); break; } }
    }
    nloc = mine > 0u ? mine : 1u; nx = cnt > 0u ? cnt : 1u;
}
__device__ __forceinline__ void xcd_barrier(const XcdBarrier& b) {
    asm volatile("s_waitcnt vmcnt(0)" ::: "memory");
    __syncthreads();
    if (threadIdx.x == 0) {
        unsigned* bar = b.bar;
        __builtin_amdgcn_s_waitcnt(0);
        unsigned nloc = b.st[0], nx = b.st[1];
        if (nloc == 0u) { xcd_barrier_complete(bar, b.x, nloc, nx); b.st[0] = nloc; b.st[1] = nx; }
        const unsigned old = xb_add(&bar[XB_XSUB(b.x)], 1u);
        const unsigned gen = old / nloc;
        if (old + 1u == (gen + 1u) * nloc) {
            __builtin_amdgcn_fence(__ATOMIC_RELEASE, "agent");
            asm volatile("s_waitcnt vmcnt(0)" ::: "memory");
            const unsigned og = xb_add(&bar[XB_TOP], 1u);
            const unsigned tg = og / nx;
            if (og + 1u == (tg + 1u) * nx) xb_add(&bar[XB_TOPGEN], 1u);
            else XB_SPIN(xb_ld(&bar[XB_TOPGEN]) == tg, bar);
            __builtin_amdgcn_fence(__ATOMIC_ACQUIRE, "agent");
            xb_add(&bar[XB_XGEN(b.x)], 1u);
            asm volatile("s_waitcnt vmcnt(0)" ::: "memory");
        } else {
            XB_SPIN(xb_ld(&bar[XB_XGEN(b.x)]) == gen, bar);
            __builtin_amdgcn_fence(__ATOMIC_ACQUIRE, "agent");
            asm volatile("s_waitcnt vmcnt(0)" ::: "memory");
        }
    }
    __syncthreads();
}

struct Args {
    const float* in[19]; float* out; unsigned char* ws; int ph_lo, ph_hi;
};

struct Frame {
    unsigned char* lds;
    int tid, lane, wave, G, gw, NGW, gt, NGT;
};

__device__ __forceinline__ void p0_transpose_item(const float* W, int K, int N, bf16* WT, float* scr, int item, int lane, const float* gk = nullptr, bool win_remap = false) {
    const int nblk = N / 32, kb = item / nblk, nb = item % nblk, k0 = 64 * kb, n0 = 32 * nb;

#pragma unroll 8
    for (int i = 0; i < 32; ++i) { const int kk = 2 * i + (lane >> 5); scr[kk * 33 + (lane & 31)] = W[(size_t)(k0 + kk) * N + n0 + (lane & 31)] * (gk ? gk[k0 + kk] : 1.0f); }
    asm volatile("s_waitcnt lgkmcnt(0)" ::: "memory");
    const int c = lane & 7;
#pragma unroll
    for (int j = 0; j < 4; ++j) { const int n = (lane >> 3) + 8 * j; const float* s = scr + (8 * c) * 33 + n;
        v4u o; o.x = pk2(s[0 * 33], s[1 * 33]); o.y = pk2(s[2 * 33], s[3 * 33]); o.z = pk2(s[4 * 33], s[5 * 33]); o.w = pk2(s[6 * 33], s[7 * 33]);
        int dn = n0 + n;
        if (win_remap) {
            if (dn < 1024) { const int hc = dn & 127, i = hc & 63; dn = (dn & ~127) + 8 * (i >> 2) + ((hc >> 6) << 2) + (i & 3); }
            else if (dn >= 4096 && dn < 6144) { const int cc = dn - 4096; dn = cc < 1024 ? 4096 + (cc >> 7) * 256 + (cc & 127) : 4096 + ((cc - 1024) >> 7) * 256 + 128 + ((cc - 1024) & 127); } }
        *(v4u*)(WT + (size_t)dn * K + k0 + 8 * c) = o; }
    asm volatile("s_waitcnt lgkmcnt(0)" ::: "memory");
}
__device__ __forceinline__ void cvt_f32_bf16(const Frame& F, const float* src, bf16* dst, size_t count) {
    const size_t n4 = count / 4, st = (size_t)F.NGT;
    size_t i = F.gt;
    for (; i + 3 * st < n4; i += 4 * st) { f32x4 v[4];
#pragma unroll
        for (int q = 0; q < 4; ++q) v[q] = ((const f32x4*)src)[i + q * st];
#pragma unroll
        for (int q = 0; q < 4; ++q) { v2u o; o.x = pk2(v[q][0], v[q][1]); o.y = pk2(v[q][2], v[q][3]); ((v2u*)dst)[i + q * st] = o; } }
    for (; i < n4; i += st) { const f32x4 v = ((const f32x4*)src)[i]; v2u o; o.x = pk2(v[0], v[1]); o.y = pk2(v[2], v[3]); ((v2u*)dst)[i] = o; }
}
__device__ __forceinline__ void rms_row_to_bf16(const float* xrow, const float* g, bf16* orow, int lane) {
    const f32x4* xr = (const f32x4*)xrow + lane; const f32x4* gr = (const f32x4*)g + lane;
    f32x4 v[4]; float s = 0.f;
#pragma unroll
    for (int j = 0; j < 4; ++j) { v[j] = xr[64 * j]; s += (v[j][0] * v[j][0] + v[j][1] * v[j][1]) + (v[j][2] * v[j][2] + v[j][3] * v[j][3]); }
    const float rs = 1.0f / sqrtf(wave_sum(s) * (1.f / D) + EPS);
    unsigned long long* o8 = (unsigned long long*)orow + lane;
#pragma unroll
    for (int j = 0; j < 4; ++j) { const f32x4 gg = gr[64 * j]; o8[64 * j] = (unsigned long long)pk2(v[j][0] * rs * gg[0], v[j][1] * rs * gg[1]) | ((unsigned long long)pk2(v[j][2] * rs * gg[2], v[j][3] * rs * gg[3]) << 32); }
}


__device__ __forceinline__ void quant_row_fp8(const float* srow, unsigned char* drow, float* inv_scale, int lane, const float* gcol = nullptr) {
    const f32x4* xr = (const f32x4*)srow + lane;
    f32x4 v[4]; float am = 0.f;
#pragma unroll
    for (int j = 0; j < 4; ++j) { v[j] = xr[64 * j]; if (gcol) v[j] = v[j] * ((const f32x4*)gcol + lane)[64 * j]; am = fmaxf(am, fmaxf(fmaxf(fabsf(v[j][0]), fabsf(v[j][1])), fmaxf(fabsf(v[j][2]), fabsf(v[j][3])))); }
    am = wave_max(am);
    int k = 0;
    if (am > 0.f) { k = (int)floorf(log2f(224.0f / am)); k = k < -100 ? -100 : (k > 100 ? 100 : k); }
    const float sc = ldexpf(1.0f, k), isc = ldexpf(1.0f, -k);
    v4u o;
    { int w = __builtin_amdgcn_cvt_pk_fp8_f32(v[0][0] * sc, v[0][1] * sc, 0, false); w = __builtin_amdgcn_cvt_pk_fp8_f32(v[0][2] * sc, v[0][3] * sc, w, true); o.x = (unsigned)w; }
    { int w = __builtin_amdgcn_cvt_pk_fp8_f32(v[1][0] * sc, v[1][1] * sc, 0, false); w = __builtin_amdgcn_cvt_pk_fp8_f32(v[1][2] * sc, v[1][3] * sc, w, true); o.y = (unsigned)w; }
    { int w = __builtin_amdgcn_cvt_pk_fp8_f32(v[2][0] * sc, v[2][1] * sc, 0, false); w = __builtin_amdgcn_cvt_pk_fp8_f32(v[2][2] * sc, v[2][3] * sc, w, true); o.z = (unsigned)w; }
    { int w = __builtin_amdgcn_cvt_pk_fp8_f32(v[3][0] * sc, v[3][1] * sc, 0, false); w = __builtin_amdgcn_cvt_pk_fp8_f32(v[3][2] * sc, v[3][3] * sc, w, true); o.w = (unsigned)w; }
    *((v4u*)drow + lane) = o;
    if (lane == 0) *inv_scale = isc;
}
__device__ __forceinline__ void quant_row_fp8_cp(const float* srow, unsigned char* tab, int e, float* inv_scale, int lane, const float* gcol = nullptr) {
    const f32x4* xr = (const f32x4*)(srow + 16 * lane);
    f32x4 v[4]; float am = 0.f;
#pragma unroll
    for (int q = 0; q < 4; ++q) { v[q] = xr[q]; if (gcol) v[q] = v[q] * ((const f32x4*)(gcol + 16 * lane))[q]; am = fmaxf(am, fmaxf(fmaxf(fabsf(v[q][0]), fabsf(v[q][1])), fmaxf(fabsf(v[q][2]), fabsf(v[q][3])))); }
    am = wave_max(am);
    int k = 0;
    if (am > 0.f) { k = (int)floorf(log2f(224.0f / am)); k = k < -100 ? -100 : (k > 100 ? 100 : k); }
    const float sc = ldexpf(1.0f, k), isc = ldexpf(1.0f, -k);
    v4u o;
    { int w = __builtin_amdgcn_cvt_pk_fp8_f32(v[0][0] * sc, v[0][1] * sc, 0, false); w = __builtin_amdgcn_cvt_pk_fp8_f32(v[0][2] * sc, v[0][3] * sc, w, true); o.x = (unsigned)w; }
    { int w = __builtin_amdgcn_cvt_pk_fp8_f32(v[1][0] * sc, v[1][1] * sc, 0, false); w = __builtin_amdgcn_cvt_pk_fp8_f32(v[1][2] * sc, v[1][3] * sc, w, true); o.y = (unsigned)w; }
    { int w = __builtin_amdgcn_cvt_pk_fp8_f32(v[2][0] * sc, v[2][1] * sc, 0, false); w = __builtin_amdgcn_cvt_pk_fp8_f32(v[2][2] * sc, v[2][3] * sc, w, true); o.z = (unsigned)w; }
    { int w = __builtin_amdgcn_cvt_pk_fp8_f32(v[3][0] * sc, v[3][1] * sc, 0, false); w = __builtin_amdgcn_cvt_pk_fp8_f32(v[3][2] * sc, v[3][3] * sc, w, true); o.w = (unsigned)w; }
    *(v4u*)(tab + ((size_t)(lane >> 3) * PNE_ROWS + e) * 128 + (lane & 7) * 16) = o;
    if (lane == 0) *inv_scale = isc;
}
__device__ __forceinline__ void quant_row_i8_cp_fin(f32x4 (&v)[4], unsigned char* tab, int e, float* inv_scale, int lane, const float* gcol) {
    float am = 0.f;
#pragma unroll
    for (int q = 0; q < 4; ++q) { if (gcol) v[q] = v[q] * ((const f32x4*)(gcol + 16 * lane))[q]; am = fmaxf(am, fmaxf(fmaxf(fabsf(v[q][0]), fabsf(v[q][1])), fmaxf(fabsf(v[q][2]), fabsf(v[q][3])))); }
    am = wave_max(am);
    const float sc = am > 0.f ? 127.0f / am : 0.f;
    unsigned w[4];
#pragma unroll
    for (int q = 0; q < 4; ++q) { const int q0 = (int)rintf(v[q][0] * sc), q1 = (int)rintf(v[q][1] * sc), q2 = (int)rintf(v[q][2] * sc), q3 = (int)rintf(v[q][3] * sc);
        w[q] = (unsigned)(q0 & 0xff) | ((unsigned)(q1 & 0xff) << 8) | ((unsigned)(q2 & 0xff) << 16) | ((unsigned)(q3 & 0xff) << 24); }
    *(v4u*)(tab + ((size_t)(lane >> 3) * PNE_ROWS + e) * 128 + (lane & 7) * 16) = (v4u){w[0], w[1], w[2], w[3]};
    if (lane == 0) *inv_scale = am * (1.0f / 127.0f);
}
typedef float f32x2 __attribute__((ext_vector_type(2)));
typedef unsigned v4u_raw __attribute__((__vector_size__(16)));
typedef unsigned v2u_raw __attribute__((__vector_size__(8)));
__device__ __forceinline__ void fp8x16_to_f32(const v4u w, float* f) {
    f32x2 t;
    t = __builtin_amdgcn_cvt_pk_f32_fp8((int)w.x, false); f[0] = t.x; f[1] = t.y; t = __builtin_amdgcn_cvt_pk_f32_fp8((int)w.x, true); f[2] = t.x; f[3] = t.y;
    t = __builtin_amdgcn_cvt_pk_f32_fp8((int)w.y, false); f[4] = t.x; f[5] = t.y; t = __builtin_amdgcn_cvt_pk_f32_fp8((int)w.y, true); f[6] = t.x; f[7] = t.y;
    t = __builtin_amdgcn_cvt_pk_f32_fp8((int)w.z, false); f[8] = t.x; f[9] = t.y; t = __builtin_amdgcn_cvt_pk_f32_fp8((int)w.z, true); f[10] = t.x; f[11] = t.y;
    t = __builtin_amdgcn_cvt_pk_f32_fp8((int)w.w, false); f[12] = t.x; f[13] = t.y; t = __builtin_amdgcn_cvt_pk_f32_fp8((int)w.w, true); f[14] = t.x; f[15] = t.y;
}

__device__ __forceinline__ float gelu_f(float v) {
    const float av = fabsf(v), t = __builtin_amdgcn_rcpf(av * 0.2316418882f + 1.0f);
    float q = t * 0.5307027145f + (-0.7265760135f); q = q * t + 0.7107068705f; q = q * t + (-0.142248368f); q = q * t + 0.127414796f; q = q * t;
    const float e = __builtin_amdgcn_exp2f((v * v) * (-0.72134752044f));
    const float m = v * (q * e);
    return v < 0.f ? m : v - m;
}
__device__ __forceinline__ float gamma_of(int h) { return 1.0f - exp2f(-5.0f - (float)h); }

__global__ void __launch_bounds__(NTHREADS, 2) mega(Args args) {
    extern __shared__ __attribute__((aligned(16))) unsigned char lds[];
    Frame F;
    F.lds = lds; F.tid = threadIdx.x; F.lane = F.tid & 63; F.wave = __builtin_amdgcn_readfirstlane(F.tid >> 6);
    F.G = gridDim.x; F.gw = blockIdx.x * NWAVES + F.wave; F.NGW = F.G * NWAVES; F.gt = blockIdx.x * NTHREADS + F.tid; F.NGT = F.G * NTHREADS;
    unsigned char* ws = args.ws;
    const float* x = args.in[0]; const float* p = args.in[1]; const float* g_mix = args.in[2]; const float* w_in = args.in[3];
    const float* conv_w = args.in[4]; const float* conv_b = args.in[5]; const float* w_ret_up = args.in[6]; const float* w_conv_up = args.in[7];
    const float* w_out = args.in[8]; const float* g_ffn = args.in[9]; const float* w_peer_q = args.in[10]; const float* peer_k1 = args.in[11];
    const float* peer_k2 = args.in[12]; const float* peer_u = args.in[13]; const float* peer_v = args.in[14]; const float* g_ple = args.in[15];
    const float* w_ple_proj = args.in[16]; const float* w_ple_gate = args.in[17]; const float* g_final = args.in[18];
    float* out = args.out;
    float* COS = (float*)(ws + WS_COS); float* SIN = (float*)(ws + WS_SIN);
    bf16* WIN = (bf16*)(ws + WS_WIN); bf16* WRU = (bf16*)(ws + WS_WRU); bf16* WCU = (bf16*)(ws + WS_WCU); bf16* WOUT = (bf16*)(ws + WS_WOUT);
    bf16* WPQ = (bf16*)(ws + WS_WPQ); bf16* WPP = (bf16*)(ws + WS_WPP); bf16* K1 = (bf16*)(ws + WS_K1); bf16* K2 = (bf16*)(ws + WS_K2); bf16* WPG = (bf16*)(ws + WS_WPG);
    unsigned char* U8 = ws + WS_UB; unsigned char* V8 = ws + WS_VB;
    float* SU = (float*)(ws + 128 * 1024); float* SV = (float*)(ws + 256 * 1024);
    float* SS2 = (float*)(ws + 80 * MiB);
    float* WSC = (float*)(ws + 82 * MiB);
    unsigned* WCNT = (unsigned*)(ws + 32 * 1024);
    float* PACT = (float*)(ws + WS_PREV);
    float* SS1 = (float*)(ws + WS_COS);
    float* SS3 = (float*)(ws + WS_IDX);
    bf16* XN = (bf16*)(ws + WS_XN); bf16* BIG = (bf16*)(ws + WS_BIG); bf16* PREV = (bf16*)(ws + WS_PREV); bf16* ARET = (bf16*)(ws + WS_ARET);
    int* IDX = (int*)(ws + WS_IDX); float* GATE = (float*)(ws + WS_GATE);
    bf16* CB = BIG;
    bf16* UU = BIG + (size_t)T * 1024;
    bf16* ACONV = CB;
    bf16* GATES = BIG + (size_t)T * 2048;
    bf16* M1 = UU;
    bf16* HB = XN;
    bf16* PB = (bf16*)(ws + 48 * MiB);
    bf16* QP = PREV;
    bf16* PLEB = BIG;
    bf16* H3B = BIG + (size_t)T * 1024;
    PG8_LAS unsigned char* ldsl = (PG8_LAS unsigned char*)lds;

    const int lo = args.ph_lo, hi = args.ph_hi;
#if MK_ONE_LAUNCH
    cg::grid_group grid = cg::this_grid();
    volatile LAS unsigned* lctl = (volatile LAS unsigned*)((LAS unsigned char*)lds + LDS_BYTES - 64);
    if (F.tid < 16) lctl[F.tid] = 0u;
    __syncthreads();
    const XcdBarrier xbar = xcd_barrier_post((unsigned*)(ws + WS_CTL), lctl);
#define SEAM(k) do { if ((k) + 1 < hi) { if ((k) == 0) grid.sync(); else xcd_barrier(xbar); } } while (0)
#else
#define SEAM(k) do { } while (0)
#endif
#define IN(k) (lo <= (k) && (k) < hi)

    if (IN(0)) {
        float* scr = (float*)(lds + F.wave * 16384);
        constexpr int I_IN = (D / 64) * (INW / 32), I_SQ = (D / 64) * (D / 32), I_PQ = (D / 64) * (2048 / 32), I_PP = (PLE / 64) * (D / 32);
        constexpr int NITEMS = I_IN + 4 * I_SQ + I_PQ + I_PP;
        for (int it = F.gw; it < NITEMS; it += F.NGW) {
            int r = it;
            if (r < I_IN) { p0_transpose_item(w_in, D, INW, WIN, scr, r, F.lane, nullptr, true); continue; } r -= I_IN;
            if (r < I_SQ) { p0_transpose_item(w_ret_up, D, D, WRU, scr, r, F.lane); continue; } r -= I_SQ;
            if (r < I_SQ) { p0_transpose_item(w_conv_up, D, D, WCU, scr, r, F.lane); continue; } r -= I_SQ;
            if (r < I_SQ) { p0_transpose_item(w_out, D, D, WOUT, scr, r, F.lane); continue; } r -= I_SQ;
            if (r < I_SQ) { p0_transpose_item(w_ple_gate, D, D, WPG, scr, r, F.lane, g_ple); continue; } r -= I_SQ;
            if (r < I_PQ) { p0_transpose_item(w_peer_q, D, 2048, WPQ, scr, r, F.lane, g_ffn); continue; } r -= I_PQ;
            p0_transpose_item(w_ple_proj, PLE, D, WPP, scr, r, F.lane);
        }
        cvt_f32_bf16(F, p, PB, (size_t)T * PLE);
        cvt_f32_bf16(F, peer_k1, K1, (size_t)PH * PNK * PHALF);
        cvt_f32_bf16(F, peer_k2, K2, (size_t)PH * PNK * PHALF);
        for (int r = F.gw; r < PNE; r += F.NGW) {
            f32x4 vu[4], vv[4];
#pragma unroll
            for (int q = 0; q < 4; ++q) { vu[q] = ((const f32x4*)(peer_u + (size_t)r * D + 16 * F.lane))[q]; vv[q] = ((const f32x4*)(peer_v + (size_t)r * D + 16 * F.lane))[q]; }
            quant_row_i8_cp_fin(vu, U8, r, SU + r, F.lane, g_ffn);
            quant_row_i8_cp_fin(vv, V8, r, SV + r, F.lane, nullptr);
        }
        for (int e = F.gt; e < SEQ * 64; e += F.NGT) { const int s = e >> 6, i = e & 63; const double inv = pow(10000.0, -(double)i / 64.0); const double ang = (double)s * inv; COS[e] = (float)cos(ang); SIN[e] = (float)sin(ang); }
        {
            const f32x4* gr = (const f32x4*)g_mix + F.lane; f32x4 gg[4];
#pragma unroll
            for (int j = 0; j < 4; ++j) gg[j] = gr[64 * j];
            for (int m = F.gw; m < T / 2; m += F.NGW) {
                const int ma = m, mb = m + T / 2;
                const f32x4* xa_ = (const f32x4*)(x + (size_t)ma * D) + F.lane; const f32x4* xb_ = (const f32x4*)(x + (size_t)mb * D) + F.lane;
                f32x4 va[4], vb[4]; float sa = 0.f, sb = 0.f;
#pragma unroll
                for (int j = 0; j < 4; ++j) { va[j] = xa_[64 * j]; vb[j] = xb_[64 * j]; }
#pragma unroll
                for (int j = 0; j < 4; ++j) { sa += (va[j][0] * va[j][0] + va[j][1] * va[j][1]) + (va[j][2] * va[j][2] + va[j][3] * va[j][3]); sb += (vb[j][0] * vb[j][0] + vb[j][1] * vb[j][1]) + (vb[j][2] * vb[j][2] + vb[j][3] * vb[j][3]); }
                const float ra = 1.0f / sqrtf(wave_sum(sa) * (1.f / D) + EPS), rb = 1.0f / sqrtf(wave_sum(sb) * (1.f / D) + EPS);
                unsigned long long* oa = (unsigned long long*)(XN + (size_t)ma * D) + F.lane; unsigned long long* ob = (unsigned long long*)(XN + (size_t)mb * D) + F.lane;
#pragma unroll
                for (int j = 0; j < 4; ++j) {
                    oa[64 * j] = (unsigned long long)pk2(va[j][0] * ra * gg[j][0], va[j][1] * ra * gg[j][1]) | ((unsigned long long)pk2(va[j][2] * ra * gg[j][2], va[j][3] * ra * gg[j][3]) << 32);
                    ob[64 * j] = (unsigned long long)pk2(vb[j][0] * rb * gg[j][0], vb[j][1] * rb * gg[j][1]) | ((unsigned long long)pk2(vb[j][2] * rb * gg[j][2], vb[j][3] * rb * gg[j][3]) << 32); }
            }
        }
        SEAM(0);
    }

    if (IN(1)) {
        pg8::Gemm g{XN, WIN, T, 3072, D, D, 0}; pg8::StaticOrder S; S.init(T, 3072, F.G, (int)blockIdx.x);
        pg8::EpiQKVG E{BIG, COS, SIN};
        pg8::gemm_phase<pg8::EpiQKVG, pg8::StaticOrder, true>(ldsl, g, S, E);
        SEAM(1);
    }

    if (IN(2)) {
        constexpr int KS = 160, VS = 288;
        bf16* kt = (bf16*)lds;
        bf16* vt = kt + 128 * KS;
        LAS const unsigned char* kt3 = (LAS const unsigned char*)lds; LAS const unsigned char* vt3 = kt3 + 128 * KS * 2;
        const int r32 = F.lane & 31, hg = F.lane >> 5, wm = F.wave >> 2, wn = F.wave & 3;
        const int tq = (F.lane & 15) >> 2, tp = F.lane & 3, tcs = (F.lane >> 4) & 1;
        v4u kreg[4], vreg[8];
#define R1_LOAD(uu) do { const int h_ = (uu) & 3, n_ = ((uu) >> 2) & 31, b_ = (uu) >> 7; const size_t t0_ = (size_t)b_ * SEQ + (size_t)n_ * RC; \
            _Pragma("unroll") for (int q = 0; q < 4; ++q) { const int c = F.tid + q * NTHREADS, j = c >> 4, c8 = c & 15; kreg[q] = *(const v4u*)(BIG + (t0_ + j) * 3072 + RQK + h_ * RDK + c8 * 8); } \
            _Pragma("unroll") for (int q = 0; q < 8; ++q) { const int c = F.tid + q * NTHREADS, j = c >> 5, c8 = c & 31; vreg[q] = *(const v4u*)(BIG + (t0_ + j) * 3072 + 2 * RQK + h_ * RDV + c8 * 8); } } while (0)
        if ((int)blockIdx.x < NUNITS_R) R1_LOAD((int)blockIdx.x);
        for (int u = blockIdx.x; u < NUNITS_R; u += F.G) {
            const int h = u & 3;
            const float lg = logf(gamma_of(h));
            __syncthreads();
#pragma unroll
            for (int q = 0; q < 4; ++q) { const int c = F.tid + q * NTHREADS, j = c >> 4, c8 = c & 15;
                float f[8]; unpack8(kreg[q], f);
                const float zeta = __expf(lg * (float)(RC - 1 - j));
                v4u z1; z1.x = pk2(f[0] * zeta, f[1] * zeta); z1.y = pk2(f[2] * zeta, f[3] * zeta); z1.z = pk2(f[4] * zeta, f[5] * zeta); z1.w = pk2(f[6] * zeta, f[7] * zeta);
                *(v4u*)(kt + j * KS + c8 * 8) = z1; }
#pragma unroll
            for (int q = 0; q < 8; ++q) { const int c = F.tid + q * NTHREADS, j = c >> 5, c8 = c & 31; *(v4u*)(vt + j * VS + c8 * 8) = vreg[q]; }
            __syncthreads();
            if (u + F.G < NUNITS_R) R1_LOAD(u + F.G);
            f32x16 acc[2][2];
#pragma unroll
            for (int bm = 0; bm < 2; ++bm)
#pragma unroll
                for (int bn = 0; bn < 2; ++bn)
#pragma unroll
                    for (int z = 0; z < 16; ++z) acc[bm][bn][z] = 0.f;
#pragma unroll
            for (int ks = 0; ks < 8; ++ks) {
                bf16x8v af[2], bfr[2];
#pragma unroll
                for (int q = 0; q < 2; ++q) {
                    LAS const unsigned char* ka = kt3 + ((16 * ks + 8 * hg + tq) * KS + 64 * wm + 32 * q + 16 * tcs + 4 * tp) * 2;
                    LAS const unsigned char* va = vt3 + ((16 * ks + 8 * hg + tq) * VS + 64 * wn + 32 * q + 16 * tcs + 4 * tp) * 2;
                    af[q] = cat8(ds_tr4(ka), ds_tr4(ka + 4 * KS * 2)); bfr[q] = cat8(ds_tr4(va), ds_tr4(va + 4 * VS * 2)); }
#pragma unroll
                for (int bm = 0; bm < 2; ++bm)
#pragma unroll
                    for (int bn = 0; bn < 2; ++bn) acc[bm][bn] = __builtin_amdgcn_mfma_f32_32x32x16_bf16(af[bm], bfr[bn], acc[bm][bn], 0, 0, 0);
            }
#pragma unroll
            for (int bm = 0; bm < 2; ++bm)
#pragma unroll
                for (int bn = 0; bn < 2; ++bn) { const int e = 64 * wn + 32 * bn + r32;
#pragma unroll
                    for (int g = 0; g < 4; ++g) { const int d0 = 64 * wm + 32 * bm + 8 * g + 4 * hg; v2u o; o.x = pk2(acc[bm][bn][4 * g], acc[bm][bn][4 * g + 1]); o.y = pk2(acc[bm][bn][4 * g + 2], acc[bm][bn][4 * g + 3]);
                        *(v2u*)(PREV + ((size_t)u * 256 + e) * 128 + d0) = o; } }
        }
#undef R1_LOAD
        SEAM(2);
    }

    if (IN(3)) {
        for (int c = F.gt; c < BATCH * RH * 128 * 32; c += F.NGT) {
            const int e8 = c & 31, d = (c >> 5) & 127, h = (c >> 12) & 3, b = c >> 14;
            const float cd = powf(gamma_of(h), (float)RC);
            float st[8];
#pragma unroll
            for (int q = 0; q < 8; ++q) st[q] = 0.f;
            for (int n = 0; n < NCH; ++n) {
                const int u = b * 128 + n * 4 + h; v4u* ptr = (v4u*)(PREV + ((size_t)u * 128 + d) * 256 + e8 * 8);
                const v4u w = *ptr; float f[8]; unpack8(w, f);
                v4u o; o.x = pk2(st[0], st[1]); o.y = pk2(st[2], st[3]); o.z = pk2(st[4], st[5]); o.w = pk2(st[6], st[7]); *ptr = o;
#pragma unroll
                for (int q = 0; q < 8; ++q) st[q] = st[q] * cd + f[q];
            }
        }
        SEAM(3);
    }

    if (IN(4)) {
        constexpr int LS = 136;
        bf16* ksN = (bf16*)lds;
        constexpr int VS = 288;
        bf16* vt = ksN + 128 * LS;
        LAS const unsigned char* vt3 = (LAS const unsigned char*)lds + 128 * LS * 2;
        float* stx = (float*)(vt + 128 * VS);
        const int tq = (F.lane & 15) >> 2, tp = F.lane & 3, tcs = (F.lane >> 4) & 1;
        const int r32 = F.lane & 31, hg = F.lane >> 5, iw = F.wave & 3, eh = F.wave >> 2;
        const int i = 32 * iw + r32;
        for (int u = blockIdx.x; u < NUNITS_R; u += F.G) {
            const int h = u & 3, n = (u >> 2) & 31, b = u >> 7; const size_t t0 = (size_t)b * SEQ + (size_t)n * RC;
            const float lg = logf(gamma_of(h));
            __syncthreads();
            bf16* pt = vt;
            for (int c = F.tid; c < 128 * 16; c += NTHREADS) { const int j = c >> 4, c8 = c & 15;
                *(v4u*)(ksN + j * LS + c8 * 8) = *(const v4u*)(BIG + (t0 + j) * 3072 + RQK + h * RDK + c8 * 8); }
            for (int c = F.tid; c < 256 * 16; c += NTHREADS) { const int e_ = c >> 4, c8 = c & 15;
                *(v4u*)(pt + e_ * LS + c8 * 8) = *(const v4u*)(PREV + ((size_t)u * 256 + e_) * 128 + c8 * 8); }
            bf16x8v qf[8];
            { const bf16* qrow = BIG + (t0 + i) * 3072 + h * RDK + 8 * hg;
#pragma unroll
              for (int ks = 0; ks < 8; ++ks) qf[ks] = *(const bf16x8v*)(qrow + 16 * ks); }
            v4u vst[8];
#pragma unroll
            for (int q = 0; q < 8; ++q) { const int c = F.tid + q * NTHREADS, j = c >> 5, c8 = c & 31; vst[q] = *(const v4u*)(BIG + (t0 + j) * 3072 + 2 * RQK + h * RDV + c8 * 8); }
            f32x16 acc[4];
#pragma unroll
            for (int eb = 0; eb < 4; ++eb)
#pragma unroll
                for (int z = 0; z < 16; ++z) acc[eb][z] = 0.f;
            __syncthreads();
            {
                const bf16* pp = pt + (128 * eh + r32) * LS + 8 * hg;
#pragma unroll
                for (int ks = 0; ks < 8; ++ks)
#pragma unroll
                    for (int eb = 0; eb < 4; ++eb) { const bf16x8v a = *(const bf16x8v*)(pp + (32 * eb) * LS + 16 * ks); acc[eb] = __builtin_amdgcn_mfma_f32_32x32x16_bf16(a, qf[ks], acc[eb], 0, 0, 0); }
                const float xi = __expf(lg * (float)(i + 1));
#pragma unroll
                for (int eb = 0; eb < 4; ++eb)
#pragma unroll
                    for (int z = 0; z < 16; ++z) acc[eb][z] *= xi;
            }
            __syncthreads();
#pragma unroll
            for (int q = 0; q < 8; ++q) { const int c = F.tid + q * NTHREADS, j = c >> 5, c8 = c & 31; *(v4u*)(vt + j * VS + c8 * 8) = vst[q]; }
            __syncthreads();
#pragma unroll 1
            for (int jb = 0; jb <= iw; ++jb) {
                f32x16 X;
#pragma unroll
                for (int z = 0; z < 16; ++z) X[z] = 0.f;
#pragma unroll
                for (int ks = 0; ks < 8; ++ks) { const bf16x8v a = *(const bf16x8v*)(ksN + (32 * jb + r32) * LS + 16 * ks + 8 * hg); X = __builtin_amdgcn_mfma_f32_32x32x16_bf16(a, qf[ks], X, 0, 0, 0); }
#pragma unroll
                for (int z = 0; z < 16; ++z) { const int j = 32 * jb + (z & 3) + 8 * (z >> 2) + 4 * hg; const int df = i - j; X[z] = df >= 0 ? X[z] * __expf(lg * (float)df) : 0.f; }
#pragma unroll
                for (int s2 = 0; s2 < 2; ++s2) {
                    v4u pw; pw.x = pk2(X[8 * s2 + 0], X[8 * s2 + 1]); pw.y = pk2(X[8 * s2 + 2], X[8 * s2 + 3]); pw.z = pk2(X[8 * s2 + 4], X[8 * s2 + 5]); pw.w = pk2(X[8 * s2 + 6], X[8 * s2 + 7]);
                    const bf16x8v pf = __builtin_bit_cast(bf16x8v, pw);
#pragma unroll
                    for (int eb = 0; eb < 4; ++eb) {
                        LAS const unsigned char* va = vt3 + ((32 * jb + 16 * s2 + 4 * hg + tq) * VS + 128 * eh + 32 * eb + 16 * tcs + 4 * tp) * 2;
                        acc[eb] = __builtin_amdgcn_mfma_f32_32x32x16_bf16(cat8(ds_tr4(va), ds_tr4(va + 8 * VS * 2)), pf, acc[eb], 0, 0, 0); }
                }
            }
            float s1 = 0.f, s2 = 0.f;
#pragma unroll
            for (int eb = 0; eb < 4; ++eb)
#pragma unroll
                for (int z = 0; z < 16; ++z) { const float v = acc[eb][z]; s1 += v; s2 += v * v; }
            { auto r1 = __builtin_amdgcn_permlane32_swap(__float_as_uint(s1), __float_as_uint(s1), false, false); s1 = __uint_as_float(r1[0]) + __uint_as_float(r1[1]);
              auto r2 = __builtin_amdgcn_permlane32_swap(__float_as_uint(s2), __float_as_uint(s2), false, false); s2 = __uint_as_float(r2[0]) + __uint_as_float(r2[1]); }
            if (hg == 0) { stx[(eh * 128 + i) * 2] = s1; stx[(eh * 128 + i) * 2 + 1] = s2; }
            __syncthreads();
            { const float o1 = stx[((eh ^ 1) * 128 + i) * 2], o2 = stx[((eh ^ 1) * 128 + i) * 2 + 1]; s1 += o1; s2 += o2; }
            const float mu = s1 * (1.f / 256.f); const float var = fmaxf(s2 * (1.f / 256.f) - mu * mu, 0.f); const float rstd = 1.0f / sqrtf(var + EPS);
            {
                constexpr int YS = 264;
                bf16* ys = vt;
#pragma unroll
                for (int eb = 0; eb < 4; ++eb)
#pragma unroll
                    for (int g = 0; g < 4; ++g) { const int ec = 128 * eh + 32 * eb + 8 * g + 4 * hg;
                        v2u o; o.x = pk2((acc[eb][4 * g] - mu) * rstd, (acc[eb][4 * g + 1] - mu) * rstd); o.y = pk2((acc[eb][4 * g + 2] - mu) * rstd, (acc[eb][4 * g + 3] - mu) * rstd);
                        *(v2u*)(ys + i * YS + ec) = o; }
                __syncthreads();
#pragma unroll
                for (int q = 0; q < 8; ++q) { const int c = F.tid + q * NTHREADS, tkn = c >> 5, c8 = c & 31;
                    float yf[8], gf[8]; unpack8(*(const v4u*)(ys + tkn * YS + c8 * 8), yf); unpack8(*(const v4u*)(BIG + (t0 + tkn) * 3072 + 2 * RQK + RV + h * RDV + c8 * 8), gf);
                    float o[8];
#pragma unroll
                    for (int z = 0; z < 8; ++z) o[z] = yf[z] * gf[z] / (1.0f + __expf(-gf[z]));
                    v4u w; w.x = pk2(o[0], o[1]); w.y = pk2(o[2], o[3]); w.z = pk2(o[4], o[5]); w.w = pk2(o[6], o[7]);
                    *(v4u*)(ARET + (t0 + tkn) * 1024 + h * RDV + c8 * 8) = w; }
            }
        }
        SEAM(4);
    }

    if (IN(5)) {
        pg8::Gemm g{XN, WIN + (size_t)3072 * D, T, 5120, D, D, 0}; pg8::StaticOrder S; S.init(T, 5120, F.G, (int)blockIdx.x);
        pg8::EpiConvGates E{CB, UU, GATES};
        pg8::gemm_phase<pg8::EpiConvGates, pg8::StaticOrder, true>(ldsl, g, S, E);
        SEAM(5);
    }

    if (IN(6)) {
        for (int it = F.gt; it < (T / 8) * 128; it += F.NGT) {
            const int c8 = it & 127, t0 = (it >> 7) * 8, s0 = t0 & (SEQ - 1); const int col = c8 * 8;
            v4u uw[10], cw[8];
#pragma unroll
            for (int r = 0; r < 8; ++r) { uw[r + 2] = *(const v4u*)(UU + (size_t)(t0 + r) * 1024 + col); cw[r] = *(const v4u*)(CB + (size_t)(t0 + r) * 1024 + col); }
            if (s0 != 0) { uw[0] = *(const v4u*)(UU + (size_t)(t0 - 2) * 1024 + col); uw[1] = *(const v4u*)(UU + (size_t)(t0 - 1) * 1024 + col); }
            else { uw[0] = (v4u){0u, 0u, 0u, 0u}; uw[1] = (v4u){0u, 0u, 0u, 0u}; }
            float w0[8], w1[8], w2[8], bs[8];
            *(f32x4*)w0 = *(const f32x4*)(conv_w + col); *(f32x4*)(w0 + 4) = *(const f32x4*)(conv_w + col + 4);
            *(f32x4*)w1 = *(const f32x4*)(conv_w + 1024 + col); *(f32x4*)(w1 + 4) = *(const f32x4*)(conv_w + 1024 + col + 4);
            *(f32x4*)w2 = *(const f32x4*)(conv_w + 2048 + col); *(f32x4*)(w2 + 4) = *(const f32x4*)(conv_w + 2048 + col + 4);
            *(f32x4*)bs = *(const f32x4*)(conv_b + col); *(f32x4*)(bs + 4) = *(const f32x4*)(conv_b + col + 4);
            float ua[8], ub[8], uc[8];
            unpack8(uw[0], ua); unpack8(uw[1], ub);
#pragma unroll
            for (int r = 0; r < 8; ++r) {
                float cb[8], o[8]; unpack8(uw[r + 2], uc); unpack8(cw[r], cb);
#pragma unroll
                for (int z = 0; z < 8; ++z) { o[z] = cb[z] * (w0[z] * ua[z] + w1[z] * ub[z] + w2[z] * uc[z] + bs[z]); ua[z] = ub[z]; ub[z] = uc[z]; }
                v4u w; w.x = pk2(o[0], o[1]); w.y = pk2(o[2], o[3]); w.z = pk2(o[4], o[5]); w.w = pk2(o[6], o[7]);
                *(v4u*)(ACONV + (size_t)(t0 + r) * 1024 + col) = w;
            }
        }
        SEAM(6);
    }


    if (IN(8)) {
        pg8::StaticOrder S; S.init(T, D, F.G, (int)blockIdx.x);
        { pg8::Gemm g{ARET, WRU, T, D, D, D, 0}; pg8::EpiGate<false> E{M1, D, GATES, 2048, 0};
          pg8::gemm_phase<pg8::EpiGate<false>, pg8::StaticOrder, true>(ldsl, g, S, E); }
        asm volatile("s_waitcnt vmcnt(0)" ::: "memory"); __syncthreads();
        { pg8::Gemm g{ACONV, WCU, T, D, D, D, 0}; pg8::EpiGate<true> E{M1, D, GATES, 2048, 1024};
          pg8::gemm_phase<pg8::EpiGate<true>, pg8::StaticOrder, true>(ldsl, g, S, E); }
        SEAM(8);
    }

    if (IN(9)) {
        pg8::Gemm g{M1, WOUT, T, D, D, D, 0}; pg8::StaticOrder S; S.init(T, D, F.G, (int)blockIdx.x);
        pg8::EpiResBf16SS E{x, HB, SS1, D};
        pg8::gemm_phase<pg8::EpiResBf16SS, pg8::StaticOrder, true>(ldsl, g, S, E);
        SEAM(9);
    }


    if (IN(11)) {
        { pg8::Gemm g{HB, WPQ, T, 2048, D, D, 0}; pg8::StaticOrder S; S.init(T, 2048, F.G, (int)blockIdx.x);
          pg8::EpiBf16 E{QP, 2048};
          pg8::gemm_phase<pg8::EpiBf16, pg8::StaticOrder, true>(ldsl, g, S, E); }
        { pg8::Gemm g{PB, WPP, T, D, PLE, PLE, 0}; pg8::StaticOrder S; S.init(T, D, F.G, (int)blockIdx.x);
          pg8::EpiBf16 E{PLEB, D};
          pg8::gemm_phase<pg8::EpiBf16, pg8::StaticOrder, true>(ldsl, g, S, E); }
        SEAM(11);
    }

    if (IN(12)) {
        constexpr int LS = 136;
        bf16* k1s = (bf16*)lds; bf16* k2s = k1s + 128 * LS;
        const int h = blockIdx.x & 7;
        __syncthreads();
        for (int c = F.tid; c < 128 * 16; c += NTHREADS) { const int j = c >> 4, c8 = c & 15;
            *(v4u*)(k1s + j * LS + c8 * 8) = *(const v4u*)(K1 + ((size_t)h * 128 + j) * 128 + c8 * 8);
            *(v4u*)(k2s + j * LS + c8 * 8) = *(const v4u*)(K2 + ((size_t)h * 128 + j) * 128 + c8 * 8); }
        __syncthreads();
        const int r32 = F.lane & 31, hg = F.lane >> 5;
        const int nwv = (F.G >> 3) * NWAVES;
        for (int tt = (blockIdx.x >> 3) * NWAVES + F.wave; tt < T / 32; tt += nwv) {
            const int t0 = tt * 32;
            unsigned V1[16], V2[16];
            peer_half_topk(QP + (size_t)(t0 + r32) * 2048 + h * 256 + 8 * hg, k1s + r32 * 136 + 8 * hg, hg, V1);
            __builtin_amdgcn_sched_barrier(0);
            peer_half_topk(QP + (size_t)(t0 + r32) * 2048 + h * 256 + 128 + 8 * hg, k2s + r32 * 136 + 8 * hg, hg, V2);
            __builtin_amdgcn_sched_barrier(0);
            float v1[16], v2[16];
#pragma unroll
            for (int z = 0; z < 16; ++z) { v1[z] = ord_val(V1[z] & ~0x7Fu); v2[z] = ord_val(V2[z] & ~0x7Fu); }
#define CKEY(a, b) ((ord_key(v1[a] + v2[b]) & ~0xFFu) | (unsigned)(255 - ((a) * 16 + (b))))
            unsigned g0[16], g1[16], g2[16], g3[16];
#pragma unroll
            for (int b = 0; b < 16; ++b) g0[b] = CKEY(0, b);
#pragma unroll
            for (int b = 0; b < 8; ++b) g1[b] = CKEY(1, b);
#pragma unroll
            for (int b = 0; b < 5; ++b) g1[8 + b] = CKEY(2, b);
#pragma unroll
            for (int b = 0; b < 3; ++b) g1[13 + b] = CKEY(3, b);
            g2[0] = CKEY(3, 3);
#pragma unroll
            for (int b = 0; b < 3; ++b) g2[1 + b] = CKEY(4, b);
#pragma unroll
            for (int b = 0; b < 2; ++b) { g2[4 + b] = CKEY(5, b); g2[6 + b] = CKEY(6, b); g2[8 + b] = CKEY(7, b); }
#pragma unroll
            for (int a = 8; a < 14; ++a) g2[10 + (a - 8)] = CKEY(a, 0);
            { const unsigned c14 = CKEY(14, 0), c15 = CKEY(15, 0); g3[0] = max(c14, c15); g3[1] = min(c14, c15); }
#pragma unroll
            for (int z = 2; z < 16; ++z) g3[z] = 0u;
#undef CKEY
            sort16_desc(g1); sort16_desc(g2); merge16_desc(g1, g2); merge16_desc(g1, g3); merge16_desc(g0, g1);
            float ts[16], ex[16]; float den = 0.f;
            float rs1;
            { const f32x4* sp = (const f32x4*)(SS1 + (size_t)(t0 + r32) * 16); const f32x4 s0 = sp[0], s1 = sp[1], s2 = sp[2], s3 = sp[3];
              const float ssum = ((s0[0] + s0[1]) + (s0[2] + s0[3])) + ((s1[0] + s1[1]) + (s1[2] + s1[3])) + ((s2[0] + s2[1]) + (s2[2] + s2[3])) + ((s3[0] + s3[1]) + (s3[2] + s3[3]));
              rs1 = 1.0f / sqrtf(ssum * (1.f / D) + EPS); }
#pragma unroll
            for (int z = 0; z < 16; ++z) ts[z] = ord_val(g0[z] & ~0xFFu) * rs1;
#pragma unroll
            for (int z = 0; z < 16; ++z) { ex[z] = __expf(ts[z] - ts[0]); den += ex[z]; }
            const float inv = 1.0f / den;
            int oi[8]; float og[8];
#pragma unroll
            for (int rr = 0; rr < 8; ++rr) {
                unsigned klo = g0[rr], khi = g0[8 + rr]; float elo = ex[rr], ehi = ex[8 + rr];
                asm volatile("" : "+v"(klo), "+v"(khi), "+v"(elo), "+v"(ehi));
                const unsigned key = hg ? khi : klo; const int c = 255 - (int)(key & 0xFFu); const int a = c >> 4, b = c & 15;
                unsigned ka = V1[0], kb2 = V2[0];
#pragma unroll
                for (int z = 1; z < 16; ++z) { ka = (a == z) ? V1[z] : ka; kb2 = (b == z) ? V2[z] : kb2; }
                oi[rr] = (127 - (int)(ka & 0x7Fu)) * PNK + (127 - (int)(kb2 & 0x7Fu));
                og[rr] = (hg ? ehi : elo) * inv;
            }
            int* ip = IDX + (size_t)(t0 + r32) * NSEL + h * PTOPK + 8 * hg; float* gp = GATE + (size_t)(t0 + r32) * NSEL + h * PTOPK + 8 * hg;
            *(v4u*)ip = (v4u){(unsigned)oi[0], (unsigned)oi[1], (unsigned)oi[2], (unsigned)oi[3]}; *(v4u*)(ip + 4) = (v4u){(unsigned)oi[4], (unsigned)oi[5], (unsigned)oi[6], (unsigned)oi[7]};
            *(f32x4*)gp = (f32x4){og[0], og[1], og[2], og[3]}; *(f32x4*)(gp + 4) = (f32x4){og[4], og[5], og[6], og[7]};
        }
        SEAM(12);
    }

    if (IN(13)) {
        volatile int* item_w = (volatile int*)(lds + 1024);
        const int s8 = F.lane & 7, r8 = F.lane >> 3; const int xcc = (int)(xb_xcc_id() & 7u);
        for (;;) {
            __syncthreads();
            if (F.tid == 0) { int it = -1;
                for (int k = 0; k < 8 && it < 0; ++k) { const int jj = (xcc + k) & 7; const unsigned cc = __hip_atomic_fetch_add(WCNT + jj, 1u, __ATOMIC_RELAXED, __HIP_MEMORY_SCOPE_AGENT); if (cc < (unsigned)(T / 64)) it = (jj << 16) | (int)cc; }
                item_w[0] = it; }
            __syncthreads();
            const int item = item_w[0];
            if (item < 0) break;
            const int j = item >> 16, ch = item & 0xffff;
            const unsigned char* tabj = U8 + (size_t)j * PNE_ROWS * 128 + s8 * 16;
            const int tb = ch * 64 + F.wave * 8;
            int ida[8], idb[8]; v4u xa[8], xb[8];
#pragma unroll
            for (int tt = 0; tt < 8; ++tt) { ida[tt] = IDX[(size_t)(tb + tt) * NSEL + F.lane]; idb[tt] = IDX[(size_t)(tb + tt) * NSEL + 64 + F.lane];
                const bf16* xp = HB + (size_t)(tb + tt) * D + 128 * j + 16 * s8; xa[tt] = *(const v4u*)xp; xb[tt] = *(const v4u*)(xp + 8); }
            v4u rowsA[8], rowsB[8];
#define P13_ROWS(buf, tt, hh) do { _Pragma("unroll") for (int g = 0; g < 8; ++g) { const int id = __shfl((hh) ? idb[tt] : ida[tt], 8 * g + r8); buf[g] = *(const v4u*)(tabj + (size_t)id * 128); } } while (0)
#define P13_DOT(buf, hh, xq, sx, pp) do { \
                _Pragma("unroll") for (int g = 0; g < 8; ++g) { int d_ = __builtin_amdgcn_sdot4((int)buf[g].x, xq[0], 0, false); d_ = __builtin_amdgcn_sdot4((int)buf[g].y, xq[1], d_, false); \
                    d_ = __builtin_amdgcn_sdot4((int)buf[g].z, xq[2], d_, false); d_ = __builtin_amdgcn_sdot4((int)buf[g].w, xq[3], d_, false); \
                    pp[8 * (hh) + g] = (float)d_ * sx; } } while (0)
            const bool b4_ = (s8 & 4) != 0, b2_ = (s8 & 2) != 0, b1_ = (s8 & 1) != 0;
            P13_ROWS(rowsA, 0, 0);
#pragma unroll
            for (int tt = 0; tt < 8; ++tt) {
                float xf[16]; unpack8(xa[tt], xf); unpack8(xb[tt], xf + 8); float pp[16];
                P13_ROWS(rowsB, tt, 1);
                float am = 0.f;
#pragma unroll
                for (int z = 0; z < 16; ++z) am = fmaxf(am, fabsf(xf[z]));
                am = fmaxf(am, __shfl_xor(am, 1)); am = fmaxf(am, __shfl_xor(am, 2)); am = fmaxf(am, __shfl_xor(am, 4));
                const float qs = am > 0.f ? 127.0f / am : 0.f, sx = am * (1.0f / 127.0f);
                int xq[4];
#pragma unroll
                for (int q = 0; q < 4; ++q) { const int q0 = (int)rintf(xf[4 * q] * qs), q1 = (int)rintf(xf[4 * q + 1] * qs), q2 = (int)rintf(xf[4 * q + 2] * qs), q3 = (int)rintf(xf[4 * q + 3] * qs);
                    xq[q] = (int)((unsigned)(q0 & 0xff) | ((unsigned)(q1 & 0xff) << 8) | ((unsigned)(q2 & 0xff) << 16) | ((unsigned)(q3 & 0xff) << 24)); }
                P13_DOT(rowsA, 0, xq, sx, pp); __builtin_amdgcn_sched_barrier(0);
                if (tt < 7) P13_ROWS(rowsA, tt + 1, 0);
                P13_DOT(rowsB, 1, xq, sx, pp);
                float a8[8], a4[4], a2[2];
#pragma unroll
                for (int g = 0; g < 8; ++g) { const float keep = b4_ ? pp[g + 8] : pp[g], give = b4_ ? pp[g] : pp[g + 8]; a8[g] = keep + __shfl_xor(give, 4); }
#pragma unroll
                for (int g = 0; g < 4; ++g) { const float keep = b2_ ? a8[g + 4] : a8[g], give = b2_ ? a8[g] : a8[g + 4]; a4[g] = keep + __shfl_xor(give, 2); }
#pragma unroll
                for (int g = 0; g < 2; ++g) { const float keep = b1_ ? a4[g + 2] : a4[g], give = b1_ ? a4[g] : a4[g + 2]; a2[g] = keep + __shfl_xor(give, 1); }
                float* pa = PACT + ((size_t)j * T + (tb + tt)) * NSEL + 16 * s8 + r8; pa[0] = a2[0]; pa[8] = a2[1];
                __builtin_amdgcn_sched_barrier(0);
            }
#undef P13_ROWS
#undef P13_DOT
        }
        SEAM(13);
    }

    if (IN(14)) {
        for (int t = F.gw; t < T; t += F.NGW) {
            float ssum = 0.f;
            if (F.lane < 16) ssum = SS1[(size_t)t * 16 + F.lane];
            ssum = wave_sum(ssum);
            const float rs1 = 1.0f / sqrtf(ssum * (1.f / D) + EPS);
            float a0 = 0.f, a1 = 0.f;
#pragma unroll
            for (int j = 0; j < 8; ++j) { const float* pa = PACT + ((size_t)j * T + t) * NSEL + F.lane; a0 += pa[0]; a1 += pa[64]; }
            const int id0 = IDX[(size_t)t * NSEL + F.lane], id1 = IDX[(size_t)t * NSEL + 64 + F.lane];
            float* gp = GATE + (size_t)t * NSEL + F.lane;
            const float g0 = gp[0], g1 = gp[64];
            const float w0 = g0 * gelu_f(a0 * rs1 * SU[id0]) * SV[id0], w1 = g1 * gelu_f(a1 * rs1 * SU[id1]) * SV[id1];
            const float am = wave_max(fmaxf(fabsf(w0), fabsf(w1))); const float qs = am > 0.f ? 127.0f / am : 0.f;
            ((int*)gp)[0] = (int)rintf(w0 * qs) & 0xff; ((int*)gp)[64] = (int)rintf(w1 * qs) & 0xff;
            if (F.lane == 0) WSC[t] = am * (1.0f / 127.0f);
        }
        SEAM(14);
    }

    if (IN(7)) {
        volatile int* item_w = (volatile int*)(lds + 1024);
        const int s8 = F.lane & 7, r8 = F.lane >> 3; const int xcc = (int)(xb_xcc_id() & 7u);
        for (;;) {
            __syncthreads();
            if (F.tid == 0) { int it = -1;
                for (int k = 0; k < 8 && it < 0; ++k) { const int jj = (xcc + k) & 7; const unsigned cc = __hip_atomic_fetch_add(WCNT + 8 + jj, 1u, __ATOMIC_RELAXED, __HIP_MEMORY_SCOPE_AGENT); if (cc < (unsigned)(T / 64)) it = (jj << 16) | (int)cc; }
                item_w[0] = it; }
            __syncthreads();
            const int item = item_w[0];
            if (item < 0) break;
            const int j = item >> 16, ch = item & 0xffff;
            const unsigned char* tabj = V8 + (size_t)j * PNE_ROWS * 128 + s8 * 16;
            const int tb = ch * 64 + F.wave * 8;
            unsigned ka[8], kb[8]; float wsc[8];
#pragma unroll
            for (int tt = 0; tt < 8; ++tt) { const unsigned i0 = (unsigned)IDX[(size_t)(tb + tt) * NSEL + F.lane], i1 = (unsigned)IDX[(size_t)(tb + tt) * NSEL + 64 + F.lane];
                const unsigned q0 = ((const unsigned*)GATE)[(size_t)(tb + tt) * NSEL + F.lane], q1 = ((const unsigned*)GATE)[(size_t)(tb + tt) * NSEL + 64 + F.lane];
                ka[tt] = (i0 << 16) | q0; kb[tt] = (i1 << 16) | q1; wsc[tt] = WSC[tb + tt]; }
            v4u rowsA[8], rowsB[8]; unsigned kA[8], kB[8];
#define P7_ROWS(buf, kk, tt, hh) do { _Pragma("unroll") for (int g = 0; g < 8; ++g) { kk[g] = __shfl((hh) ? kb[tt] : ka[tt], 8 * g + r8); buf[g] = *(const v4u*)(tabj + (size_t)(kk[g] >> 16) * 128); } } while (0)
#define P7_ACC4(r0, r1, r2, r3, k0, k1, k2, k3) do { \
                const unsigned w01_ = __builtin_amdgcn_perm(k1, k0, 0x0c0c0400u), w23_ = __builtin_amdgcn_perm(k3, k2, 0x0c0c0400u); const int w4_ = (int)__builtin_amdgcn_perm(w23_, w01_, 0x05040100u); \
                _Pragma("unroll") for (int c4 = 0; c4 < 4; ++c4) { const unsigned a_ = r0[c4], b_ = r1[c4], c_ = r2[c4], d_ = r3[c4]; \
                    const unsigned t0_ = __builtin_amdgcn_perm(b_, a_, 0x05010400u), t1_ = __builtin_amdgcn_perm(b_, a_, 0x07030602u), t2_ = __builtin_amdgcn_perm(d_, c_, 0x05010400u), t3_ = __builtin_amdgcn_perm(d_, c_, 0x07030602u); \
                    acci[4 * c4 + 0] = __builtin_amdgcn_sdot4((int)__builtin_amdgcn_perm(t2_, t0_, 0x05040100u), w4_, acci[4 * c4 + 0], false); \
                    acci[4 * c4 + 1] = __builtin_amdgcn_sdot4((int)__builtin_amdgcn_perm(t2_, t0_, 0x07060302u), w4_, acci[4 * c4 + 1], false); \
                    acci[4 * c4 + 2] = __builtin_amdgcn_sdot4((int)__builtin_amdgcn_perm(t3_, t1_, 0x05040100u), w4_, acci[4 * c4 + 2], false); \
                    acci[4 * c4 + 3] = __builtin_amdgcn_sdot4((int)__builtin_amdgcn_perm(t3_, t1_, 0x07060302u), w4_, acci[4 * c4 + 3], false); } } while (0)
#define P7_ACC(buf, kk) do { P7_ACC4(buf[0], buf[1], buf[2], buf[3], kk[0], kk[1], kk[2], kk[3]); P7_ACC4(buf[4], buf[5], buf[6], buf[7], kk[4], kk[5], kk[6], kk[7]); } while (0)
#define P7_FIN(tt) do { \
                float acc[16]; \
                _Pragma("unroll") for (int z = 0; z < 16; ++z) acc[z] = (float)acci[z] * wsc[tt]; \
                float a8[8], a4[4], a2[2]; \
                _Pragma("unroll") for (int z = 0; z < 8; ++z) { auto rr = __builtin_amdgcn_permlane32_swap(__float_as_uint(acc[z]), __float_as_uint(acc[z + 8]), false, false); a8[z] = __uint_as_float(rr[0]) + __uint_as_float(rr[1]); } \
                _Pragma("unroll") for (int z = 0; z < 4; ++z) { const float keep = c16_ ? a8[z + 4] : a8[z], give = c16_ ? a8[z] : a8[z + 4]; a4[z] = keep + __shfl_xor(give, 16); } \
                _Pragma("unroll") for (int z = 0; z < 2; ++z) { const float keep = c8_ ? a4[z + 2] : a4[z], give = c8_ ? a4[z] : a4[z + 2]; a2[z] = keep + __shfl_xor(give, 8); } \
                unsigned* hp = (unsigned*)(HB + (size_t)(tb + (tt)) * D + 128 * j + 16 * s8 + 2 * r8); \
                const unsigned hw = *hp; const float h0 = bflo(hw) + a2[0], h1 = bfhi(hw) + a2[1]; \
                *hp = pk2(h0, h1); \
                const float ssq = wave_sum(h0 * h0 + h1 * h1); \
                if (F.lane == 0) SS2[(size_t)(tb + (tt)) * 8 + j] = ssq; } while (0)
            const bool c16_ = (F.lane & 16) != 0, c8_ = (F.lane & 8) != 0;
            P7_ROWS(rowsA, kA, 0, 0);
#pragma unroll
            for (int tt = 0; tt < 8; ++tt) {
                int acci[16];
#pragma unroll
                for (int z = 0; z < 16; ++z) acci[z] = 0;
                P7_ROWS(rowsB, kB, tt, 1); P7_ACC(rowsA, kA); __builtin_amdgcn_sched_barrier(0);
                if (tt < 7) P7_ROWS(rowsA, kA, tt + 1, 0);
                P7_ACC(rowsB, kB); P7_FIN(tt); __builtin_amdgcn_sched_barrier(0);
            }
#undef P7_ACC4
#undef P7_FIN
#undef P7_ROWS
#undef P7_ACC
        }
        SEAM(7);
    }


    if (IN(15)) {
        pg8::Gemm g{HB, WPG, T, D, D, D, 0}; pg8::StaticOrder S; S.init(T, D, F.G, (int)blockIdx.x);
        pg8::EpiPleBf16SS E{HB, PLEB, H3B, SS2, SS3, D};
        pg8::gemm_phase<pg8::EpiPleBf16SS, pg8::StaticOrder, true>(ldsl, g, S, E);
        SEAM(15);
    }

    if (IN(16)) {
        const f32x4* gr = (const f32x4*)g_final + F.lane;
        f32x4 gg[4];
#pragma unroll
        for (int j = 0; j < 4; ++j) gg[j] = gr[64 * j];
        for (int m = F.gw; m < T / 2; m += F.NGW) {
            const int ma = m, mb = m + T / 2;
            float sa = 0.f, sb = 0.f;
            if (F.lane < 16) { sa = SS3[(size_t)ma * 16 + F.lane]; sb = SS3[(size_t)mb * 16 + F.lane]; }
            const v2u* ha = (const v2u*)(H3B + (size_t)ma * D) + F.lane; const v2u* hb = (const v2u*)(H3B + (size_t)mb * D) + F.lane;
            v2u wa[4], wb[4];
#pragma unroll
            for (int j = 0; j < 4; ++j) { wa[j] = ha[64 * j]; wb[j] = hb[64 * j]; }
            sa = wave_sum(sa); sb = wave_sum(sb);
            const float ra = 1.0f / sqrtf(sa * (1.f / D) + EPS), rb = 1.0f / sqrtf(sb * (1.f / D) + EPS);
            f32x4* oa = (f32x4*)(out + (size_t)ma * D) + F.lane; f32x4* ob = (f32x4*)(out + (size_t)mb * D) + F.lane;
#pragma unroll
            for (int j = 0; j < 4; ++j) {
                oa[64 * j] = (f32x4){bflo(wa[j].x) * ra * gg[j][0], bfhi(wa[j].x) * ra * gg[j][1], bflo(wa[j].y) * ra * gg[j][2], bfhi(wa[j].y) * ra * gg[j][3]};
                ob[64 * j] = (f32x4){bflo(wb[j].x) * rb * gg[j][0], bfhi(wb[j].x) * rb * gg[j][1], bflo(wb[j].y) * rb * gg[j][2], bfhi(wb[j].y) * rb * gg[j][3]}; }
        }
    }
#undef IN
#undef SEAM
}

constexpr int N_PHASES = 17;

extern "C" void kernel_launch(void* const* d_in, const int* in_sizes, int n_in, void* d_out, int out_size, void* d_ws, size_t ws_size, hipStream_t stream) {
    static int grid = 0;
    if (grid == 0) {
        if (n_in != 19 || out_size != T * D || ws_size < WS_END) { fprintf(stderr, "kernel_launch: unexpected shapes: n_in %d out %d ws %zu\n", n_in, out_size, ws_size); grid = -1; return; }
        int dev = 0, cus = 0, per_cu = 0;
        hipGetDevice(&dev); hipDeviceGetAttribute(&cus, hipDeviceAttributeMultiprocessorCount, dev);
        if (hipFuncSetAttribute((const void*)mega, hipFuncAttributeMaxDynamicSharedMemorySize, LDS_BYTES) != hipSuccess) { fprintf(stderr, "kernel_launch: hipFuncSetAttribute failed\n"); grid = -1; return; }
        if (hipOccupancyMaxActiveBlocksPerMultiprocessor(&per_cu, (const void*)mega, NTHREADS, LDS_BYTES) != hipSuccess || per_cu < 1) { fprintf(stderr, "kernel_launch: occupancy query says %d\n", per_cu); per_cu = 1; }
        (void)hipGetLastError();
        grid = cus;
        if (grid % 8 != 0) fprintf(stderr, "kernel_launch: grid %d not a multiple of 8\n", grid);
    }
    if (grid < 0) return;
    Args a{};
    for (int i = 0; i < 19; ++i) a.in[i] = (const float*)d_in[i];
    a.out = (float*)d_out; a.ws = (unsigned char*)d_ws;
#if MK_ONE_LAUNCH
    a.ph_lo = 0; a.ph_hi = N_PHASES;
    if (hipMemsetAsync((char*)d_ws + WS_CTL, 0, CTL_ZERO_BYTES, stream) != hipSuccess) { fprintf(stderr, "kernel_launch: memset failed\n"); return; }
    void* kargs[] = {&a};
    hipError_t e = hipLaunchCooperativeKernel((const void*)mega, dim3(grid), dim3(NTHREADS), kargs, LDS_BYTES, stream);
    if (e != hipSuccess) fprintf(stderr, "cooperative launch failed: %s (grid %d)\n", hipGetErrorString(e), grid);
#else
    for (int ph = 0; ph < N_PHASES; ++ph) {
        a.ph_lo = ph; a.ph_hi = ph + 1;
        hipLaunchKernelGGL(mega, dim3(grid), dim3(NTHREADS), LDS_BYTES, stream, a);
    }
#endif
}
```

```cpp
#include <hip/hip_runtime.h>
#include <hip/hip_cooperative_groups.h>
#include <cstdio>
#include <cstdint>
#include <cmath>
namespace cg = cooperative_groups;

#ifndef MK_ONE_LAUNCH
#define MK_ONE_LAUNCH 1
#endif

namespace pg8 {
#define PG8_LAS __attribute__((address_space(3)))
typedef unsigned short bf16_t;
typedef short bf16x8 __attribute__((ext_vector_type(8)));
typedef float f32x4 __attribute__((ext_vector_type(4)));
typedef unsigned u32x4 __attribute__((ext_vector_type(4)));
typedef unsigned u32x2 __attribute__((ext_vector_type(2)));
constexpr int BM = 256, BK = 64, HALF = 128, HTB = HALF * BK * 2, STAGE_BYTES = 8 * HTB, NXCD = 8, WGM = 8;

__host__ __device__ __forceinline__ int lds_byte(int r, int c) { const int st = (r >> 4) * 2 + (c >> 5), rr = r & 15, cc = c & 31, ob = rr * 64 + cc * 2; return st * 1024 + (ob ^ (((ob >> 9) & 1) << 5)); }
__host__ __device__ __forceinline__ void stage_rc(int b, int& R, int& C) { const int st = b / 1024, sb = b % 1024, swz = sb ^ (((sb >> 9) & 1) << 5); R = (st >> 1) * 16 + swz / 64; C = (st & 1) * 32 + (swz % 64) / 2; }
__host__ __device__ __forceinline__ int perm32(int rho) { const int n = rho >> 4, i = rho & 15; return 8 * (i >> 2) + 4 * n + (i & 3); }

struct Unit { int pm, pn; };
struct Gemm { const bf16_t* A; const bf16_t* Bt; int M, N, K, lda, a_pn_cols; };

struct StaticOrder {
    int nM, nN, nwg, G, c;
    __host__ __device__ void init(int M, int N, int G_, int c_) { nM = M / BM; nN = N / BM; nwg = nM * nN; G = G_; c = c_; }
    __host__ __device__ bool next(int i, Unit& u) const {
        const long L = (long)i * G + c; if (L >= nwg) return false;
        int wgid = (int)L; { const int q = nwg / NXCD, r = nwg % NXCD, xcd = wgid % NXCD, off = wgid / NXCD; wgid = (xcd < r ? xcd * (q + 1) : r * (q + 1) + (xcd - r) * q) + off; }
        const int nig = WGM * nN, gid = wgid / nig, fm = gid * WGM, gsz = (nM - fm) < WGM ? (nM - fm) : WGM;
        u.pm = fm + ((wgid % nig) % gsz); u.pn = (wgid % nig) / gsz; return true;
    }
    __device__ __forceinline__ void a_ready(const Unit&) const {}
    __device__ __forceinline__ void done(const Unit&) const {}
};

__device__ __forceinline__ unsigned cvt_pk_bf16(float lo, float hi) { unsigned r; asm volatile("v_cvt_pk_bf16_f32 %0, %1, %2" : "=v"(r) : "v"(lo), "v"(hi)); return r; }
__device__ __forceinline__ float bf_lo(unsigned w) { return __uint_as_float(w << 16); }
__device__ __forceinline__ float bf_hi(unsigned w) { return __uint_as_float(w & 0xffff0000u); }
__device__ __forceinline__ float sigmoidf_(float x) { return 1.0f / (1.0f + __expf(-x)); }

struct EpiBf16 {
    static constexpr bool PERM = true, AFTER_DRAIN = false;
    bf16_t* O; int ldc;
    __device__ __forceinline__ void operator()(const f32x4 (&acc)[2][2][4][2], const Unit& u, int wr, int wc, int fr, int fq) const {
        const int row0 = u.pm * BM + wr * 64 + fr; const int col0 = u.pn * BM + wc * 32 + 8 * fq;
#pragma unroll
        for (int ai = 0; ai < 2; ++ai)
#pragma unroll
            for (int m = 0; m < 4; ++m) { bf16_t* rowp = O + (size_t)(row0 + ai * HALF + m * 16) * ldc + col0;
#pragma unroll
                for (int bj = 0; bj < 2; ++bj) { const f32x4 v0 = acc[ai][bj][m][0], v1 = acc[ai][bj][m][1];
                    u32x4 w; w.x = cvt_pk_bf16(v0[0], v0[1]); w.y = cvt_pk_bf16(v0[2], v0[3]); w.z = cvt_pk_bf16(v1[0], v1[1]); w.w = cvt_pk_bf16(v1[2], v1[3]);
                    *(u32x4*)(rowp + bj * HALF) = w; } }
    }
};
template <bool ACCUM> struct EpiGate {
    static constexpr bool PERM = true, AFTER_DRAIN = false;
    bf16_t* O; int ldc; const bf16_t* G; int ldg; int gcol;
    __device__ __forceinline__ void operator()(const f32x4 (&acc)[2][2][4][2], const Unit& u, int wr, int wc, int fr, int fq) const {
        const int row0 = u.pm * BM + wr * 64 + fr; const int col0 = u.pn * BM + wc * 32 + 8 * fq;
#pragma unroll
        for (int ai = 0; ai < 2; ++ai) {
            u32x4 gpre[4][2], opre[4][2];
#pragma unroll
            for (int m = 0; m < 4; ++m)
#pragma unroll
                for (int bj = 0; bj < 2; ++bj) { const size_t r = (size_t)(row0 + ai * HALF + m * 16); gpre[m][bj] = *(const u32x4*)(G + r * ldg + gcol + col0 + bj * HALF);
                    if (ACCUM) opre[m][bj] = *(const u32x4*)(O + r * ldc + col0 + bj * HALF); }
            asm volatile("" ::: "memory");
#pragma unroll
            for (int m = 0; m < 4; ++m) { const size_t r = (size_t)(row0 + ai * HALF + m * 16);
#pragma unroll
                for (int bj = 0; bj < 2; ++bj) { const f32x4 v0 = acc[ai][bj][m][0], v1 = acc[ai][bj][m][1];
                    const u32x4 g = gpre[m][bj];
                    float o[8];
                    o[0] = sigmoidf_(bf_lo(g.x)) * v0[0]; o[1] = sigmoidf_(bf_hi(g.x)) * v0[1]; o[2] = sigmoidf_(bf_lo(g.y)) * v0[2]; o[3] = sigmoidf_(bf_hi(g.y)) * v0[3];
                    o[4] = sigmoidf_(bf_lo(g.z)) * v1[0]; o[5] = sigmoidf_(bf_hi(g.z)) * v1[1]; o[6] = sigmoidf_(bf_lo(g.w)) * v1[2]; o[7] = sigmoidf_(bf_hi(g.w)) * v1[3];
                    bf16_t* op = O + r * ldc + col0 + bj * HALF;
                    if (ACCUM) { const u32x4 p = opre[m][bj];
                        o[0] += bf_lo(p.x); o[1] += bf_hi(p.x); o[2] += bf_lo(p.y); o[3] += bf_hi(p.y); o[4] += bf_lo(p.z); o[5] += bf_hi(p.z); o[6] += bf_lo(p.w); o[7] += bf_hi(p.w); }
                    u32x4 w; w.x = cvt_pk_bf16(o[0], o[1]); w.y = cvt_pk_bf16(o[2], o[3]); w.z = cvt_pk_bf16(o[4], o[5]); w.w = cvt_pk_bf16(o[6], o[7]);
                    *(u32x4*)op = w; } }
        }
    }
};
struct EpiResF32 {
    static constexpr bool PERM = false, AFTER_DRAIN = false;
    const float* base; float* out; int ldc;
    __device__ __forceinline__ void operator()(const f32x4 (&acc)[2][2][4][2], const Unit& u, int wr, int wc, int fr, int fq) const {
        const int row0 = u.pm * BM + wr * 64 + fr; const int col0 = u.pn * BM + wc * 32 + 4 * fq;
#pragma unroll
        for (int ai = 0; ai < 2; ++ai)
#pragma unroll
            for (int m = 0; m < 4; ++m) { const size_t off = (size_t)(row0 + ai * HALF + m * 16) * ldc + col0;
#pragma unroll
                for (int bj = 0; bj < 2; ++bj)
#pragma unroll
                    for (int n = 0; n < 2; ++n) { const f32x4 b = *(const f32x4*)(base + off + bj * HALF + n * 16); *(f32x4*)(out + off + bj * HALF + n * 16) = b + acc[ai][bj][m][n]; } }
    }
};
struct EpiQKVG {
    static constexpr bool PERM = true, AFTER_DRAIN = false;
    bf16_t* O; const float* COS; const float* SIN;
    __device__ __forceinline__ void operator()(const f32x4 (&acc)[2][2][4][2], const Unit& u, int wr, int wc, int fr, int fq) const {
        const int row0 = u.pm * BM + wr * 64 + fr; const int col0 = u.pn * BM + wc * 32 + 8 * fq;
        const bool rot = u.pn < 4; const float sc = (u.pn >= 2 && u.pn < 4) ? 0.08838834764831845f : 1.0f; const int i0 = 4 * (wc * 4 + fq);
#pragma unroll
        for (int ai = 0; ai < 2; ++ai)
#pragma unroll
            for (int m = 0; m < 4; ++m) { const int row = row0 + ai * HALF + m * 16; bf16_t* rowp = O + (size_t)row * 3072 + col0;
                f32x4 c = (f32x4){1.f, 1.f, 1.f, 1.f}, s = (f32x4){0.f, 0.f, 0.f, 0.f};
                if (rot) { const size_t ti = (size_t)(row & 4095) * 64 + i0; c = *(const f32x4*)(COS + ti) * sc; s = *(const f32x4*)(SIN + ti) * sc; }
#pragma unroll
                for (int bj = 0; bj < 2; ++bj) { f32x4 v0 = acc[ai][bj][m][0], v1 = acc[ai][bj][m][1];
                    if (rot) { const f32x4 r1 = v0 * c - v1 * s, r2 = v0 * s + v1 * c; v0 = r1; v1 = r2; }
                    u32x4 w; w.x = cvt_pk_bf16(v0[0], v0[1]); w.y = cvt_pk_bf16(v0[2], v0[3]); w.z = cvt_pk_bf16(v1[0], v1[1]); w.w = cvt_pk_bf16(v1[2], v1[3]);
                    *(u32x4*)(rowp + bj * HALF) = w; } }
    }
};
struct EpiConvGates {
    static constexpr bool PERM = true, AFTER_DRAIN = false;
    bf16_t* CB; bf16_t* UU; bf16_t* GT;
    __device__ __forceinline__ void operator()(const f32x4 (&acc)[2][2][4][2], const Unit& u, int wr, int wc, int fr, int fq) const {
        const int row0 = u.pm * BM + wr * 64 + fr;
        if (u.pn >= 4 && u.pn < 12) {
            const int col0 = (u.pn - 4) * 128 + wc * 32 + 8 * fq;
#pragma unroll
            for (int ai = 0; ai < 2; ++ai)
#pragma unroll
                for (int m = 0; m < 4; ++m) { const f32x4 v0 = acc[ai][0][m][0] * acc[ai][1][m][0], v1 = acc[ai][0][m][1] * acc[ai][1][m][1];
                    u32x4 w; w.x = cvt_pk_bf16(v0[0], v0[1]); w.y = cvt_pk_bf16(v0[2], v0[3]); w.z = cvt_pk_bf16(v1[0], v1[1]); w.w = cvt_pk_bf16(v1[2], v1[3]);
                    *(u32x4*)(UU + (size_t)(row0 + ai * HALF + m * 16) * 1024 + col0) = w; }
        } else {
            bf16_t* O = u.pn < 4 ? CB : GT; const int ldc = u.pn < 4 ? 1024 : 2048; const int col0 = (u.pn < 4 ? u.pn : u.pn - 12) * BM + wc * 32 + 8 * fq;
#pragma unroll
            for (int ai = 0; ai < 2; ++ai)
#pragma unroll
                for (int m = 0; m < 4; ++m) { bf16_t* rowp = O + (size_t)(row0 + ai * HALF + m * 16) * ldc + col0;
#pragma unroll
                    for (int bj = 0; bj < 2; ++bj) { const f32x4 v0 = acc[ai][bj][m][0], v1 = acc[ai][bj][m][1];
                        u32x4 w; w.x = cvt_pk_bf16(v0[0], v0[1]); w.y = cvt_pk_bf16(v0[2], v0[3]); w.z = cvt_pk_bf16(v1[0], v1[1]); w.w = cvt_pk_bf16(v1[2], v1[3]);
                        *(u32x4*)(rowp + bj * HALF) = w; } }
        }
    }
};
struct EpiResBf16SS {
    static constexpr bool PERM = true, AFTER_DRAIN = false;
    const float* base; bf16_t* O; float* SS; int ldc;
    __device__ __forceinline__ void operator()(const f32x4 (&acc)[2][2][4][2], const Unit& u, int wr, int wc, int fr, int fq) const {
        const int row0 = u.pm * BM + wr * 64 + fr; const int col0 = u.pn * BM + wc * 32 + 8 * fq;
#pragma unroll
        for (int ai = 0; ai < 2; ++ai) {
            f32x4 pre[4][2][2];
#pragma unroll
            for (int m = 0; m < 4; ++m)
#pragma unroll
                for (int bj = 0; bj < 2; ++bj) { const size_t o = (size_t)(row0 + ai * HALF + m * 16) * ldc + col0 + bj * HALF; pre[m][bj][0] = *(const f32x4*)(base + o); pre[m][bj][1] = *(const f32x4*)(base + o + 4); }
            asm volatile("" ::: "memory");
#pragma unroll
            for (int m = 0; m < 4; ++m) { const size_t r = (size_t)(row0 + ai * HALF + m * 16); float ssq = 0.f;
#pragma unroll
                for (int bj = 0; bj < 2; ++bj) { const size_t o = r * ldc + col0 + bj * HALF;
                    const f32x4 h0 = pre[m][bj][0] + acc[ai][bj][m][0], h1 = pre[m][bj][1] + acc[ai][bj][m][1];
                    ssq += (h0[0] * h0[0] + h0[1] * h0[1]) + (h0[2] * h0[2] + h0[3] * h0[3]) + (h1[0] * h1[0] + h1[1] * h1[1]) + (h1[2] * h1[2] + h1[3] * h1[3]);
                    u32x4 w; w.x = cvt_pk_bf16(h0[0], h0[1]); w.y = cvt_pk_bf16(h0[2], h0[3]); w.z = cvt_pk_bf16(h1[0], h1[1]); w.w = cvt_pk_bf16(h1[2], h1[3]);
                    *(u32x4*)(O + o) = w; }
                ssq += __shfl_xor(ssq, 16); ssq += __shfl_xor(ssq, 32);
                if (fq == 0) SS[r * 16 + u.pn * 4 + wc] = ssq; }
        }
    }
};
struct EpiPleBf16SS {
    static constexpr bool PERM = true, AFTER_DRAIN = false;
    const bf16_t* H; const bf16_t* P; bf16_t* O; const float* RS; float* SS; int ldc;
    __device__ __forceinline__ void operator()(const f32x4 (&acc)[2][2][4][2], const Unit& u, int wr, int wc, int fr, int fq) const {
        const int row0 = u.pm * BM + wr * 64 + fr; const int col0 = u.pn * BM + wc * 32 + 8 * fq;
#pragma unroll
        for (int ai = 0; ai < 2; ++ai) {
            float rsv[4];
#pragma unroll
            for (int m = 0; m < 4; ++m) { const size_t r = (size_t)(row0 + ai * HALF + m * 16); rsv[m] = RS[r]; }
            asm volatile("" : "+v"(rsv[0]), "+v"(rsv[1]), "+v"(rsv[2]), "+v"(rsv[3]) :: "memory");
            u32x4 hpre[4][2], ppre[4][2];
#pragma unroll
            for (int m = 0; m < 4; ++m) { const size_t r = (size_t)(row0 + ai * HALF + m * 16);
#pragma unroll
                for (int bj = 0; bj < 2; ++bj) { const size_t o = r * ldc + col0 + bj * HALF; hpre[m][bj] = *(const u32x4*)(H + o); ppre[m][bj] = *(const u32x4*)(P + o); } }
            asm volatile("" ::: "memory");
#pragma unroll
            for (int m = 0; m < 4; ++m) { const size_t r = (size_t)(row0 + ai * HALF + m * 16); float ssq = 0.f; const float rs = rsv[m];
#pragma unroll
                for (int bj = 0; bj < 2; ++bj) { const size_t o = r * ldc + col0 + bj * HALF;
                    const u32x4 hw = hpre[m][bj], pw = ppre[m][bj]; const f32x4 a0 = acc[ai][bj][m][0], a1 = acc[ai][bj][m][1];
                    float h[8];
                    h[0] = bf_lo(hw.x) + sigmoidf_(rs * a0[0]) * bf_lo(pw.x); h[1] = bf_hi(hw.x) + sigmoidf_(rs * a0[1]) * bf_hi(pw.x);
                    h[2] = bf_lo(hw.y) + sigmoidf_(rs * a0[2]) * bf_lo(pw.y); h[3] = bf_hi(hw.y) + sigmoidf_(rs * a0[3]) * bf_hi(pw.y);
                    h[4] = bf_lo(hw.z) + sigmoidf_(rs * a1[0]) * bf_lo(pw.z); h[5] = bf_hi(hw.z) + sigmoidf_(rs * a1[1]) * bf_hi(pw.z);
                    h[6] = bf_lo(hw.w) + sigmoidf_(rs * a1[2]) * bf_lo(pw.w); h[7] = bf_hi(hw.w) + sigmoidf_(rs * a1[3]) * bf_hi(pw.w);
#pragma unroll
                    for (int z = 0; z < 8; ++z) ssq += h[z] * h[z];
                    u32x4 w; w.x = cvt_pk_bf16(h[0], h[1]); w.y = cvt_pk_bf16(h[2], h[3]); w.z = cvt_pk_bf16(h[4], h[5]); w.w = cvt_pk_bf16(h[6], h[7]);
                    *(u32x4*)(O + o) = w; }
                ssq += __shfl_xor(ssq, 16); ssq += __shfl_xor(ssq, 32);
                if (fq == 0) SS[r * 16 + u.pn * 4 + wc] = ssq; }
        }
    }
};
struct EpiPle {
    static constexpr bool PERM = false, AFTER_DRAIN = false;
    const float* base; float* out; const bf16_t* P; int ldc;
    __device__ __forceinline__ void operator()(const f32x4 (&acc)[2][2][4][2], const Unit& u, int wr, int wc, int fr, int fq) const {
        const int row0 = u.pm * BM + wr * 64 + fr; const int col0 = u.pn * BM + wc * 32 + 4 * fq;
#pragma unroll
        for (int ai = 0; ai < 2; ++ai)
#pragma unroll
            for (int m = 0; m < 4; ++m) { const size_t off = (size_t)(row0 + ai * HALF + m * 16) * ldc + col0;
#pragma unroll
                for (int bj = 0; bj < 2; ++bj)
#pragma unroll
                    for (int n = 0; n < 2; ++n) { const size_t o = off + bj * HALF + n * 16; const f32x4 b = *(const f32x4*)(base + o); const u32x2 p = *(const u32x2*)(P + o); const f32x4 a = acc[ai][bj][m][n];
                        f32x4 r; r[0] = b[0] + sigmoidf_(a[0]) * bf_lo(p.x); r[1] = b[1] + sigmoidf_(a[1]) * bf_hi(p.x); r[2] = b[2] + sigmoidf_(a[2]) * bf_lo(p.y); r[3] = b[3] + sigmoidf_(a[3]) * bf_hi(p.y);
                        *(f32x4*)(out + o) = r; } }
    }
};

template <class Epi, class Sched, bool ALIGN_EPI>
__device__ __forceinline__ void gemm_phase(PG8_LAS unsigned char* lds, const Gemm g, const Sched& S, const Epi& E) {
    const int tid = threadIdx.x, wid = __builtin_amdgcn_readfirstlane(tid >> 6), lane = tid & 63, wr = wid >> 2, wc = wid & 3, fr = lane & 15, fq = lane >> 4;
    const int K = g.K, nt = K / BK, lda = g.lda;
    unsigned voffA[2], voffB[2];
#pragma unroll
    for (int i = 0; i < 2; ++i) { int R, C; stage_rc(tid * 16 + i * 8192, R, C); const int Rb = Epi::PERM ? ((R & ~31) + perm32(R & 31)) : R;
        voffA[i] = (unsigned)(R * lda + C) * 2u; voffB[i] = (unsigned)(Rb * K + C) * 2u; }
    const size_t kstep = (size_t)(BK * 2);
    const size_t hstepA = (size_t)HALF * lda * 2, hstepB = (size_t)HALF * K * 2;
    const size_t tstepA = 2 * hstepA, tstepB = 2 * hstepB;
    const size_t pnstepA = (size_t)g.a_pn_cols * 2;
    const unsigned ldsw = (unsigned)wid * 1024u;
    const int aoff = lds_byte(wr * 64 + fr, fq * 8), boff = lds_byte(wc * 32 + fr, fq * 8);
#define PG8_SA(b, h) (((b) * 2 + (h)) * HTB)
#define PG8_SB(b, h) ((4 + (b) * 2 + (h)) * HTB)
#define PG8_STAGE(bufoff, gbase, voff) do { _Pragma("unroll") for (int _i = 0; _i < 2; ++_i) \
        __builtin_amdgcn_global_load_lds((const unsigned*)((const char*)(gbase) + (voff)[_i]), (PG8_LAS unsigned*)(lds + (bufoff) + ldsw + _i * 8192), 16, 0, 0); } while (0)
#define PG8_LDA(dst, b, h) do { _Pragma("unroll") for (int m = 0; m < 4; ++m) _Pragma("unroll") for (int k = 0; k < 2; ++k) dst[m][k] = *(const PG8_LAS bf16x8*)(lds + PG8_SA(b, h) + aoff + m * 2048 + k * 1024); } while (0)
#define PG8_LDB(dst, b, h) do { _Pragma("unroll") for (int n = 0; n < 2; ++n) _Pragma("unroll") for (int k = 0; k < 2; ++k) dst[n][k] = *(const PG8_LAS bf16x8*)(lds + PG8_SB(b, h) + boff + n * 2048 + k * 1024); } while (0)
#define PG8_MMA(ai, bj, At, Bt) do { __builtin_amdgcn_s_setprio(1); _Pragma("unroll") for (int m = 0; m < 4; ++m) _Pragma("unroll") for (int n = 0; n < 2; ++n) _Pragma("unroll") for (int k = 0; k < 2; ++k) \
        acc[ai][bj][m][n] = __builtin_amdgcn_mfma_f32_16x16x32_bf16(Bt[n][k], At[m][k], acc[ai][bj][m][n], 0, 0, 0); __builtin_amdgcn_s_setprio(0); } while (0)
#define PG8_WAIT_V(n) asm volatile("s_waitcnt vmcnt(" #n ")" ::: "memory")
#define PG8_WAIT_L(n) asm volatile("s_waitcnt lgkmcnt(" #n ")" ::: "memory")
#define PG8_BAR __builtin_amdgcn_s_barrier()
#define PG8_SCHED __builtin_amdgcn_sched_barrier(0)
    Unit cur, nxt; int ui = 0;
    if (!S.next(0, cur)) return;
    f32x4 acc[2][2][4][2];
#pragma unroll
    for (int a = 0; a < 2; ++a)
#pragma unroll
        for (int b = 0; b < 2; ++b)
#pragma unroll
            for (int m = 0; m < 4; ++m)
#pragma unroll
                for (int n = 0; n < 2; ++n) acc[a][b][m][n] = (f32x4){0.f, 0.f, 0.f, 0.f};
    bf16x8 At[4][2], B0[2][2], B1[2][2];
    const char* cA = (const char*)g.A + (size_t)cur.pm * tstepA + (size_t)cur.pn * pnstepA; const char* cB = (const char*)g.Bt + (size_t)cur.pn * tstepB;
    S.a_ready(cur);
    PG8_STAGE(PG8_SB(0, 0), cB, voffB); PG8_STAGE(PG8_SB(0, 1), cB + hstepB, voffB); PG8_STAGE(PG8_SA(0, 0), cA, voffA); PG8_STAGE(PG8_SA(0, 1), cA + hstepA, voffA);
    if (wr == 1) PG8_BAR;
    PG8_WAIT_V(2); PG8_BAR;
    PG8_STAGE(PG8_SB(1, 0), cB + kstep, voffB); PG8_STAGE(PG8_SA(1, 0), cA + kstep, voffA); PG8_STAGE(PG8_SB(1, 1), cB + hstepB + kstep, voffB);
    PG8_WAIT_V(6); PG8_BAR;
    for (;;) {
        const bool has_next = S.next(ui + 1, nxt);
        const char* nA = has_next ? (const char*)g.A + (size_t)nxt.pm * tstepA + (size_t)nxt.pn * pnstepA : cA; const char* nB = has_next ? (const char*)g.Bt + (size_t)nxt.pn * tstepB : cB;
        for (int t = 0; t < nt; t += 2) {
            const bool last = (t == nt - 2);
            const char* a1 = cA + (size_t)(t + 1) * kstep;
            const char* a2 = last ? nA : cA + (size_t)(t + 2) * kstep; const char* b2 = last ? nB : cB + (size_t)(t + 2) * kstep;
            const char* a3 = a2 + kstep; const char* b3 = b2 + kstep;
            if (last && has_next) S.a_ready(nxt);
            PG8_LDB(B0, 0, 0); PG8_LDB(B1, 0, 1); PG8_SCHED; PG8_LDA(At, 0, 0); PG8_STAGE(PG8_SA(1, 1), a1 + hstepA, voffA);
            PG8_WAIT_V(8); PG8_WAIT_L(0); PG8_BAR; PG8_MMA(0, 0, At, B0); PG8_MMA(0, 1, At, B1); PG8_BAR; PG8_SCHED;
            PG8_LDA(At, 0, 1); PG8_STAGE(PG8_SB(0, 0), b2, voffB); PG8_STAGE(PG8_SB(0, 1), b2 + hstepB, voffB); PG8_STAGE(PG8_SA(0, 0), a2, voffA);
            PG8_WAIT_V(8); PG8_WAIT_L(0); PG8_BAR; PG8_MMA(1, 0, At, B0); PG8_MMA(1, 1, At, B1); PG8_BAR; PG8_SCHED;
            PG8_LDB(B0, 1, 0); PG8_LDB(B1, 1, 1); PG8_SCHED; PG8_LDA(At, 1, 0); PG8_STAGE(PG8_SA(0, 1), a2 + hstepA, voffA);
            PG8_WAIT_V(8); PG8_WAIT_L(0); PG8_BAR; PG8_MMA(0, 0, At, B0); PG8_MMA(0, 1, At, B1); PG8_BAR; PG8_SCHED;
            PG8_LDA(At, 1, 1); PG8_STAGE(PG8_SB(1, 0), b3, voffB); PG8_STAGE(PG8_SB(1, 1), b3 + hstepB, voffB); PG8_STAGE(PG8_SA(1, 0), a3, voffA);
            PG8_WAIT_V(8); PG8_WAIT_L(0); PG8_BAR; PG8_MMA(1, 0, At, B0); PG8_MMA(1, 1, At, B1); PG8_BAR; PG8_SCHED;
        }
        if constexpr (ALIGN_EPI) { if (wr == 0) PG8_BAR; }
        E(acc, cur, wr, wc, fr, fq); S.done(cur);
        if (!has_next) break;
#pragma unroll
        for (int a = 0; a < 2; ++a)
#pragma unroll
            for (int b = 0; b < 2; ++b)
#pragma unroll
                for (int m = 0; m < 4; ++m)
#pragma unroll
                    for (int n = 0; n < 2; ++n) acc[a][b][m][n] = (f32x4){0.f, 0.f, 0.f, 0.f};
        cur = nxt; cA = nA; cB = nB; ++ui;
        if constexpr (ALIGN_EPI) { if (wr == 1) PG8_BAR; }
    }
    PG8_WAIT_V(0);
    if constexpr (!ALIGN_EPI) { if (wr == 0) PG8_BAR; }
    PG8_BAR;
#undef PG8_SA
#undef PG8_SB
#undef PG8_STAGE
#undef PG8_LDA
#undef PG8_LDB
#undef PG8_MMA
#undef PG8_WAIT_V
#undef PG8_WAIT_L
#undef PG8_BAR
#undef PG8_SCHED
}
}

constexpr int NWAVES = 8, NTHREADS = NWAVES * 64;
constexpr int BATCH = 8, SEQ = 4096, D = 1024, T = BATCH * SEQ;
constexpr int RH = 4, RDK = 128, RDV = 256, RC = 128, NCH = SEQ / RC;
constexpr int RQK = RH * RDK, RV = RH * RDV;
constexpr int INW = 8192;
constexpr int PH = 8, PNK = 128, PNE = PNK * PNK, PQD = 256, PHALF = 128, PTOPK = 16, NSEL = PH * PTOPK;
constexpr int PLE = 256;
constexpr float EPS = 1e-6f;
constexpr int NUNITS_R = BATCH * NCH * RH;

constexpr size_t MiB = 1u << 20;
constexpr size_t WS_CTL = 0, CTL_ZERO_BYTES = 64 * 1024;
constexpr size_t WS_COS = 1 * MiB, WS_SIN = 2 * MiB;
constexpr size_t WS_WIN = 3 * MiB;
constexpr size_t WS_WRU = 19 * MiB, WS_WCU = 21 * MiB, WS_WOUT = 23 * MiB;
constexpr size_t WS_WPQ = 25 * MiB;
constexpr size_t WS_WPP = 29 * MiB;
constexpr size_t WS_K1 = 29 * MiB + 512 * 1024, WS_K2 = 29 * MiB + 768 * 1024;
constexpr size_t WS_WPG = 30 * MiB;
constexpr size_t WS_UB = 32 * MiB, WS_VB = 64 * MiB;
constexpr size_t WS_XN = 96 * MiB;
constexpr size_t WS_BIG = 160 * MiB;
constexpr size_t WS_PREV = 352 * MiB;
constexpr size_t WS_ARET = 416 * MiB;
constexpr size_t WS_IDX = 480 * MiB, WS_GATE = 496 * MiB;
constexpr size_t WS_END = 512 * MiB;

constexpr int LDS_BYTES = 160 * 1024;

constexpr int PNE_ROWS = 16384;
typedef unsigned short bf16;
typedef unsigned v4u __attribute__((ext_vector_type(4)));
typedef unsigned v2u __attribute__((ext_vector_type(2)));
typedef float f32x4 __attribute__((ext_vector_type(4)));
#define LAS __attribute__((address_space(3)))

__device__ __forceinline__ unsigned f2bf(float f) { unsigned u = __float_as_uint(f); return (u + 0x7fffu + ((u >> 16) & 1u)) >> 16; }
__device__ __forceinline__ unsigned pk2(float lo, float hi) { return f2bf(lo) | (f2bf(hi) << 16); }
__device__ __forceinline__ float bflo(unsigned w) { return __uint_as_float(w << 16); }
__device__ __forceinline__ float bfhi(unsigned w) { return __uint_as_float(w & 0xffff0000u); }
__device__ __forceinline__ float bf2f(bf16 h) { return __uint_as_float(((unsigned)h) << 16); }
__device__ __forceinline__ float wave_sum(float v) {
#pragma unroll
    for (int o = 1; o < 64; o <<= 1) v += __shfl_xor(v, o);
    return v;
}
__device__ __forceinline__ float wave_max(float v) {
#pragma unroll
    for (int o = 1; o < 64; o <<= 1) v = fmaxf(v, __shfl_xor(v, o));
    return v;
}
__device__ __forceinline__ void unpack8(const v4u w, float* f) { f[0] = bflo(w.x); f[1] = bfhi(w.x); f[2] = bflo(w.y); f[3] = bfhi(w.y); f[4] = bflo(w.z); f[5] = bfhi(w.z); f[6] = bflo(w.w); f[7] = bfhi(w.w); }


typedef float f32x16 __attribute__((ext_vector_type(16)));
typedef short bf16x8v __attribute__((ext_vector_type(8)));
__device__ __forceinline__ unsigned ord_key(float f) { const unsigned u = __float_as_uint(f); return u ^ ((unsigned)((int)u >> 31) | 0x80000000u); }
__device__ __forceinline__ float ord_val(unsigned k) { return __uint_as_float(k ^ (~(unsigned)((int)k >> 31) | 0x80000000u)); }
__device__ __forceinline__ void sort16_desc(unsigned (&x)[16]) {
#pragma unroll
    for (int ks = 1; ks <= 4; ++ks) {
#pragma unroll
        for (int js = ks - 1; js >= 0; --js) {
#pragma unroll
            for (int i = 0; i < 16; ++i) { const int k = 1 << ks, j = 1 << js, l = i ^ j;
                if (l > i) { const unsigned hi = max(x[i], x[l]), lo = min(x[i], x[l]); if ((i & k) == 0) { x[i] = hi; x[l] = lo; } else { x[i] = lo; x[l] = hi; } } }
        }
    }
}
__device__ __forceinline__ void merge16_desc(unsigned (&a)[16], const unsigned (&b)[16]) {
#pragma unroll
    for (int i = 0; i < 16; ++i) a[i] = max(a[i], b[15 - i]);
#pragma unroll
    for (int js = 3; js >= 0; --js) {
#pragma unroll
        for (int i = 0; i < 16; ++i) { const int j = 1 << js, l = i ^ j;
            if (l > i) { const unsigned hi = max(a[i], a[l]), lo = min(a[i], a[l]); a[i] = hi; a[l] = lo; } }
    }
}

__device__ __forceinline__ void peer_half_topk(const bf16* qrow, const bf16* kb, int hg, unsigned (&V)[16]) {
    constexpr int LS = 136;
    bf16x8v qf[8];
#pragma unroll
    for (int ks = 0; ks < 8; ++ks) qf[ks] = *(const bf16x8v*)(qrow + 16 * ks);
    f32x16 acc[4];
#pragma unroll
    for (int b = 0; b < 4; ++b)
#pragma unroll
        for (int z = 0; z < 16; ++z) acc[b][z] = 0.f;
#pragma unroll
    for (int ks = 0; ks < 8; ++ks)
#pragma unroll
        for (int b = 0; b < 4; ++b) { const bf16x8v a = *(const bf16x8v*)(kb + b * 32 * LS + 16 * ks); acc[b] = __builtin_amdgcn_mfma_f32_32x32x16_bf16(a, qf[ks], acc[b], 0, 0, 0); }
    unsigned x0[16], x1[16], x2[16], x3[16];
#pragma unroll
    for (int z = 0; z < 16; ++z) { const int nb = (z & 3) + 8 * (z >> 2) + 4 * hg;
        x0[z] = (ord_key(acc[0][z]) & ~0x7Fu) | (unsigned)(127 - nb);
        x1[z] = (ord_key(acc[1][z]) & ~0x7Fu) | (unsigned)(127 - (32 + nb));
        x2[z] = (ord_key(acc[2][z]) & ~0x7Fu) | (unsigned)(127 - (64 + nb));
        x3[z] = (ord_key(acc[3][z]) & ~0x7Fu) | (unsigned)(127 - (96 + nb)); }
    sort16_desc(x0); sort16_desc(x1); merge16_desc(x0, x1);
    sort16_desc(x2); sort16_desc(x3); merge16_desc(x2, x3);
    merge16_desc(x0, x2);
    unsigned pz[16];
#pragma unroll
    for (int z = 0; z < 16; ++z) { auto rr = __builtin_amdgcn_permlane32_swap(x0[z], x0[z], false, false); pz[z] = hg ? rr[0] : rr[1]; }
    merge16_desc(x0, pz);
#pragma unroll
    for (int z = 0; z < 16; ++z) V[z] = x0[z];
}

typedef short v4i16_t __attribute__((ext_vector_type(4)));
__device__ __forceinline__ v4i16_t ds_tr4(LAS const unsigned char* p) { return __builtin_amdgcn_ds_read_tr16_b64_v4i16((LAS v4i16_t*)p); }
__device__ __forceinline__ bf16x8v cat8(v4i16_t a, v4i16_t b) { return __builtin_shufflevector(a, b, 0, 1, 2, 3, 4, 5, 6, 7); }

__device__ __forceinline__ void sort128_asc(unsigned& k0, unsigned& k1, int lane) {
#pragma unroll
    for (int ks = 1; ks <= 7; ++ks) {
#pragma unroll
        for (int js = ks - 1; js >= 0; --js) {
            const int K = 1 << ks, J = 1 << js;
            if (J == 64) { const unsigned lo = min(k0, k1), hi = max(k0, k1); k0 = lo; k1 = hi; }
            else {
                const bool lower = (lane & J) == 0;
                const bool up0 = (K <= 32) ? ((lane & K) == 0) : true;
                const bool up1 = (K <= 32) ? ((lane & K) == 0) : (K == 128);
                const unsigned o0 = __shfl_xor(k0, J), o1 = __shfl_xor(k1, J);
                k0 = (lower == up0) ? min(k0, o0) : max(k0, o0);
                k1 = (lower == up1) ? min(k1, o1) : max(k1, o1);
            }
        }
    }
}

#define XB_TMO      128
#define XB_XCNT(j)  (256  + 64 * (j))
#define XB_XSUB(j)  (1280 + 64 * (j))
#define XB_XGEN(j)  (2304 + 64 * (j))
#define XB_TOP      3328
#define XB_TOPGEN   3392
#define XCD_BAR_WORDS 3456
#define XB_SPIN_CAP (1u << 20)
__device__ __forceinline__ unsigned xb_ld(unsigned* p)              { return __hip_atomic_load(p, __ATOMIC_RELAXED, __HIP_MEMORY_SCOPE_AGENT); }
__device__ __forceinline__ unsigned xb_add(unsigned* p, unsigned v) { return __hip_atomic_fetch_add(p, v, __ATOMIC_RELAXED, __HIP_MEMORY_SCOPE_AGENT); }
__device__ __forceinline__ unsigned xb_xcc_id() { return (unsigned)__builtin_amdgcn_s_getreg((3 << 11) | 20) & 0xFu; }
#define XB_SPIN(cond, bar) do { unsigned _sp = 0; while (cond) { __builtin_amdgcn_s_sleep(1); \
    if ((++_sp & 255u) == 0u) { if (xb_ld(&(bar)[XB_TMO])) break; if (_sp > XB_SPIN_CAP) { atomicAdd(&(bar)[XB_TMO], 1u); break; } } } } while (0)
struct XcdBarrier { unsigned* bar; unsigned x; volatile LAS unsigned* st; };
__device__ __forceinline__ XcdBarrier xcd_barrier_post(unsigned* bar, volatile LAS unsigned* st) {
    XcdBarrier b; b.bar = bar; b.x = xb_xcc_id(); b.st = st;
    if (threadIdx.x == 0) (void)xb_add(&bar[XB_XCNT(b.x)], 1u);
    return b;
}
__device__ __forceinline__ void xcd_barrier_complete(unsigned* bar, unsigned x, unsigned& nloc, unsigned& nx) {
    const unsigned G = gridDim.x * gridDim.y * gridDim.z;
    unsigned sum, cnt, mine, sp = 0u;
    for (;;) {
        sum = 0u; cnt = 0u; mine = 0u;
#pragma unroll
        for (unsigned j = 0; j < 16; ++j) { const unsigned c = xb_ld(&bar[XB_XCNT(j)]); sum += c; cnt += (c > 0u) ? 1u : 0u; mine = (j == x) ? c : mine; }
        if (sum == G) break;
        __builtin_amdgcn_s_sleep(1);
        if ((++sp & 255u) == 0u) { if (xb_ld(&bar[XB_TMO])) break; if (sp > XB_SPIN_CAP) { atomicAdd(&bar[XB_TMO], 1u); break; } }
    }
    nloc = mine > 0u ? mine : 1u; nx = cnt > 0u ? cnt : 1u;
}
__device__ __forceinline__ void xcd_barrier(const XcdBarrier& b) {
    asm volatile("s_waitcnt vmcnt(0)" ::: "memory");
    __syncthreads();
    if (threadIdx.x == 0) {
        unsigned* bar = b.bar;
        __builtin_amdgcn_s_waitcnt(0);
        unsigned nloc = b.st[0], nx = b.st[1];
        if (nloc == 0u) { xcd_barrier_complete(bar, b.x, nloc, nx); b.st[0] = nloc; b.st[1] = nx; }
        const unsigned old = xb_add(&bar[XB_XSUB(b.x)], 1u);
        const unsigned gen = old / nloc;
        if (old + 1u == (gen + 1u) * nloc) {
            __builtin_amdgcn_fence(__ATOMIC_RELEASE, "agent");
            asm volatile("s_waitcnt vmcnt(0)" ::: "memory");
            const unsigned og = xb_add(&bar[XB_TOP], 1u);
            const unsigned tg = og / nx;
            if (og + 1u == (tg + 1u) * nx) xb_add(&bar[XB_TOPGEN], 1u);
            else XB_SPIN(xb_ld(&bar[XB_TOPGEN]) == tg, bar);
            __builtin_amdgcn_fence(__ATOMIC_ACQUIRE, "agent");
            xb_add(&bar[XB_XGEN(b.x)], 1u);
            asm volatile("s_waitcnt vmcnt(0)" ::: "memory");
        } else {
            XB_SPIN(xb_ld(&bar[XB_XGEN(b.x)]) == gen, bar);
            __builtin_amdgcn_fence(__ATOMIC_ACQUIRE, "agent");
            asm volatile("s_waitcnt vmcnt(0)" ::: "memory");
        }
    }
    __syncthreads();
}

struct Args {
    const float* in[19]; float* out; unsigned char* ws; int ph_lo, ph_hi;
};

struct Frame {
    unsigned char* lds;
    int tid, lane, wave, G, gw, NGW, gt, NGT;
};

__device__ __forceinline__ void p0_transpose_item(const float* W, int K, int N, bf16* WT, float* scr, int item, int lane, const float* gk = nullptr, bool win_remap = false) {
    const int nblk = N / 32, kb = item / nblk, nb = item % nblk, k0 = 64 * kb, n0 = 32 * nb;

#pragma unroll 8
    for (int i = 0; i < 32; ++i) { const int kk = 2 * i + (lane >> 5); scr[kk * 33 + (lane & 31)] = W[(size_t)(k0 + kk) * N + n0 + (lane & 31)] * (gk ? gk[k0 + kk] : 1.0f); }
    asm volatile("s_waitcnt lgkmcnt(0)" ::: "memory");
    const int c = lane & 7;
#pragma unroll
    for (int j = 0; j < 4; ++j) { const int n = (lane >> 3) + 8 * j; const float* s = scr + (8 * c) * 33 + n;
        v4u o; o.x = pk2(s[0 * 33], s[1 * 33]); o.y = pk2(s[2 * 33], s[3 * 33]); o.z = pk2(s[4 * 33], s[5 * 33]); o.w = pk2(s[6 * 33], s[7 * 33]);
        int dn = n0 + n;
        if (win_remap) {
            if (dn < 1024) { const int hc = dn & 127, i = hc & 63; dn = (dn & ~127) + 8 * (i >> 2) + ((hc >> 6) << 2) + (i & 3); }
            else if (dn >= 4096 && dn < 6144) { const int cc = dn - 4096; dn = cc < 1024 ? 4096 + (cc >> 7) * 256 + (cc & 127) : 4096 + ((cc - 1024) >> 7) * 256 + 128 + ((cc - 1024) & 127); } }
        *(v4u*)(WT + (size_t)dn * K + k0 + 8 * c) = o; }
    asm volatile("s_waitcnt lgkmcnt(0)" ::: "memory");
}
__device__ __forceinline__ void cvt_f32_bf16(const Frame& F, const float* src, bf16* dst, size_t count) {
    const size_t n4 = count / 4, st = (size_t)F.NGT;
    size_t i = F.gt;
    for (; i + 3 * st < n4; i += 4 * st) { f32x4 v[4];
#pragma unroll
        for (int q = 0; q < 4; ++q) v[q] = ((const f32x4*)src)[i + q * st];
#pragma unroll
        for (int q = 0; q < 4; ++q) { v2u o; o.x = pk2(v[q][0], v[q][1]); o.y = pk2(v[q][2], v[q][3]); ((v2u*)dst)[i + q * st] = o; } }
    for (; i < n4; i += st) { const f32x4 v = ((const f32x4*)src)[i]; v2u o; o.x = pk2(v[0], v[1]); o.y = pk2(v[2], v[3]); ((v2u*)dst)[i] = o; }
}
__device__ __forceinline__ void rms_row_to_bf16(const float* xrow, const float* g, bf16* orow, int lane) {
    const f32x4* xr = (const f32x4*)xrow + lane; const f32x4* gr = (const f32x4*)g + lane;
    f32x4 v[4]; float s = 0.f;
#pragma unroll
    for (int j = 0; j < 4; ++j) { v[j] = xr[64 * j]; s += (v[j][0] * v[j][0] + v[j][1] * v[j][1]) + (v[j][2] * v[j][2] + v[j][3] * v[j][3]); }
    const float rs = 1.0f / sqrtf(wave_sum(s) * (1.f / D) + EPS);
    unsigned long long* o8 = (unsigned long long*)orow + lane;
#pragma unroll
    for (int j = 0; j < 4; ++j) { const f32x4 gg = gr[64 * j]; o8[64 * j] = (unsigned long long)pk2(v[j][0] * rs * gg[0], v[j][1] * rs * gg[1]) | ((unsigned long long)pk2(v[j][2] * rs * gg[2], v[j][3] * rs * gg[3]) << 32); }
}


__device__ __forceinline__ void quant_row_fp8(const float* srow, unsigned char* drow, float* inv_scale, int lane, const float* gcol = nullptr) {
    const f32x4* xr = (const f32x4*)srow + lane;
    f32x4 v[4]; float am = 0.f;
#pragma unroll
    for (int j = 0; j < 4; ++j) { v[j] = xr[64 * j]; if (gcol) v[j] = v[j] * ((const f32x4*)gcol + lane)[64 * j]; am = fmaxf(am, fmaxf(fmaxf(fabsf(v[j][0]), fabsf(v[j][1])), fmaxf(fabsf(v[j][2]), fabsf(v[j][3])))); }
    am = wave_max(am);
    int k = 0;
    if (am > 0.f) { k = (int)floorf(log2f(224.0f / am)); k = k < -100 ? -100 : (k > 100 ? 100 : k); }
    const float sc = ldexpf(1.0f, k), isc = ldexpf(1.0f, -k);
    v4u o;
    { int w = __builtin_amdgcn_cvt_pk_fp8_f32(v[0][0] * sc, v[0][1] * sc, 0, false); w = __builtin_amdgcn_cvt_pk_fp8_f32(v[0][2] * sc, v[0][3] * sc, w, true); o.x = (unsigned)w; }
    { int w = __builtin_amdgcn_cvt_pk_fp8_f32(v[1][0] * sc, v[1][1] * sc, 0, false); w = __builtin_amdgcn_cvt_pk_fp8_f32(v[1][2] * sc, v[1][3] * sc, w, true); o.y = (unsigned)w; }
    { int w = __builtin_amdgcn_cvt_pk_fp8_f32(v[2][0] * sc, v[2][1] * sc, 0, false); w = __builtin_amdgcn_cvt_pk_fp8_f32(v[2][2] * sc, v[2][3] * sc, w, true); o.z = (unsigned)w; }
    { int w = __builtin_amdgcn_cvt_pk_fp8_f32(v[3][0] * sc, v[3][1] * sc, 0, false); w = __builtin_amdgcn_cvt_pk_fp8_f32(v[3][2] * sc, v[3][3] * sc, w, true); o.w = (unsigned)w; }
    *((v4u*)drow + lane) = o;
    if (lane == 0) *inv_scale = isc;
}
__device__ __forceinline__ void quant_row_fp8_cp(const float* srow, unsigned char* tab, int e, float* inv_scale, int lane, const float* gcol = nullptr) {
    const f32x4* xr = (const f32x4*)(srow + 16 * lane);
    f32x4 v[4]; float am = 0.f;
#pragma unroll
    for (int q = 0; q < 4; ++q) { v[q] = xr[q]; if (gcol) v[q] = v[q] * ((const f32x4*)(gcol + 16 * lane))[q]; am = fmaxf(am, fmaxf(fmaxf(fabsf(v[q][0]), fabsf(v[q][1])), fmaxf(fabsf(v[q][2]), fabsf(v[q][3])))); }
    am = wave_max(am);
    int k = 0;
    if (am > 0.f) { k = (int)floorf(log2f(224.0f / am)); k = k < -100 ? -100 : (k > 100 ? 100 : k); }
    const float sc = ldexpf(1.0f, k), isc = ldexpf(1.0f, -k);
    v4u o;
    { int w = __builtin_amdgcn_cvt_pk_fp8_f32(v[0][0] * sc, v[0][1] * sc, 0, false); w = __builtin_amdgcn_cvt_pk_fp8_f32(v[0][2] * sc, v[0][3] * sc, w, true); o.x = (unsigned)w; }
    { int w = __builtin_amdgcn_cvt_pk_fp8_f32(v[1][0] * sc, v[1][1] * sc, 0, false); w = __builtin_amdgcn_cvt_pk_fp8_f32(v[1][2] * sc, v[1][3] * sc, w, true); o.y = (unsigned)w; }
    { int w = __builtin_amdgcn_cvt_pk_fp8_f32(v[2][0] * sc, v[2][1] * sc, 0, false); w = __builtin_amdgcn_cvt_pk_fp8_f32(v[2][2] * sc, v[2][3] * sc, w, true); o.z = (unsigned)w; }
    { int w = __builtin_amdgcn_cvt_pk_fp8_f32(v[3][0] * sc, v[3][1] * sc, 0, false); w = __builtin_amdgcn_cvt_pk_fp8_f32(v[3][2] * sc, v[3][3] * sc, w, true); o.w = (unsigned)w; }
    *(v4u*)(tab + ((size_t)(lane >> 3) * PNE_ROWS + e) * 128 + (lane & 7) * 16) = o;
    if (lane == 0) *inv_scale = isc;
}
__device__ __forceinline__ void quant_row_i8_cp_fin(f32x4 (&v)[4], unsigned char* tab, int e, float* inv_scale, int lane, const float* gcol) {
    float am = 0.f;
#pragma unroll
    for (int q = 0; q < 4; ++q) { if (gcol) v[q] = v[q] * ((const f32x4*)(gcol + 16 * lane))[q]; am = fmaxf(am, fmaxf(fmaxf(fabsf(v[q][0]), fabsf(v[q][1])), fmaxf(fabsf(v[q][2]), fabsf(v[q][3])))); }
    am = wave_max(am);
    const float sc = am > 0.f ? 127.0f / am : 0.f;
    unsigned w[4];
#pragma unroll
    for (int q = 0; q < 4; ++q) { const int q0 = (int)rintf(v[q][0] * sc), q1 = (int)rintf(v[q][1] * sc), q2 = (int)rintf(v[q][2] * sc), q3 = (int)rintf(v[q][3] * sc);
        w[q] = (unsigned)(q0 & 0xff) | ((unsigned)(q1 & 0xff) << 8) | ((unsigned)(q2 & 0xff) << 16) | ((unsigned)(q3 & 0xff) << 24); }
    *(v4u*)(tab + ((size_t)(lane >> 3) * PNE_ROWS + e) * 128 + (lane & 7) * 16) = (v4u){w[0], w[1], w[2], w[3]};
    if (lane == 0) *inv_scale = am * (1.0f / 127.0f);
}
__device__ __forceinline__ void quant_row_i8_slices(f32x4 (&v)[4], unsigned char* tab, int e, float* inv_scale, int lane) {
    float am = 0.f;
#pragma unroll
    for (int q = 0; q < 4; ++q) am = fmaxf(am, fmaxf(fmaxf(fabsf(v[q][0]), fabsf(v[q][1])), fmaxf(fabsf(v[q][2]), fabsf(v[q][3]))));
    am = wave_max(am);
    const float sc = am > 0.f ? 127.0f / am : 0.f;
    unsigned w[4];
#pragma unroll
    for (int q = 0; q < 4; ++q) { const int q0 = (int)rintf(v[q][0] * sc), q1 = (int)rintf(v[q][1] * sc), q2 = (int)rintf(v[q][2] * sc), q3 = (int)rintf(v[q][3] * sc);
        w[q] = (unsigned)(q0 & 0xff) | ((unsigned)(q1 & 0xff) << 8) | ((unsigned)(q2 & 0xff) << 16) | ((unsigned)(q3 & 0xff) << 24); }
    *(v2u*)(tab + ((size_t)(2 * lane) * PNE_ROWS + e) * 8) = (v2u){w[0], w[1]};
    *(v2u*)(tab + ((size_t)(2 * lane + 1) * PNE_ROWS + e) * 8) = (v2u){w[2], w[3]};
    if (lane == 0) *inv_scale = am * (1.0f / 127.0f);
}
typedef float f32x2 __attribute__((ext_vector_type(2)));
typedef unsigned v4u_raw __attribute__((__vector_size__(16)));
typedef unsigned v2u_raw __attribute__((__vector_size__(8)));
__device__ __forceinline__ void fp8x16_to_f32(const v4u w, float* f) {
    f32x2 t;
    t = __builtin_amdgcn_cvt_pk_f32_fp8((int)w.x, false); f[0] = t.x; f[1] = t.y; t = __builtin_amdgcn_cvt_pk_f32_fp8((int)w.x, true); f[2] = t.x; f[3] = t.y;
    t = __builtin_amdgcn_cvt_pk_f32_fp8((int)w.y, false); f[4] = t.x; f[5] = t.y; t = __builtin_amdgcn_cvt_pk_f32_fp8((int)w.y, true); f[6] = t.x; f[7] = t.y;
    t = __builtin_amdgcn_cvt_pk_f32_fp8((int)w.z, false); f[8] = t.x; f[9] = t.y; t = __builtin_amdgcn_cvt_pk_f32_fp8((int)w.z, true); f[10] = t.x; f[11] = t.y;
    t = __builtin_amdgcn_cvt_pk_f32_fp8((int)w.w, false); f[12] = t.x; f[13] = t.y; t = __builtin_amdgcn_cvt_pk_f32_fp8((int)w.w, true); f[14] = t.x; f[15] = t.y;
}

__device__ __forceinline__ float gelu_f(float v) {
    const float av = fabsf(v), t = __builtin_amdgcn_rcpf(av * 0.2316418882f + 1.0f);
    float q = t * 0.5307027145f + (-0.7265760135f); q = q * t + 0.7107068705f; q = q * t + (-0.142248368f); q = q * t + 0.127414796f; q = q * t;
    const float e = __builtin_amdgcn_exp2f((v * v) * (-0.72134752044f));
    const float m = v * (q * e);
    return v < 0.f ? m : v - m;
}
__device__ __forceinline__ float gamma_of(int h) { return 1.0f - exp2f(-5.0f - (float)h); }

__global__ void __launch_bounds__(NTHREADS, 2) mega(Args args) {
    extern __shared__ __attribute__((aligned(16))) unsigned char lds[];
    Frame F;
    F.lds = lds; F.tid = threadIdx.x; F.lane = F.tid & 63; F.wave = __builtin_amdgcn_readfirstlane(F.tid >> 6);
    F.G = gridDim.x; F.gw = blockIdx.x * NWAVES + F.wave; F.NGW = F.G * NWAVES; F.gt = blockIdx.x * NTHREADS + F.tid; F.NGT = F.G * NTHREADS;
    unsigned char* ws = args.ws;
    const float* x = args.in[0]; const float* p = args.in[1]; const float* g_mix = args.in[2]; const float* w_in = args.in[3];
    const float* conv_w = args.in[4]; const float* conv_b = args.in[5]; const float* w_ret_up = args.in[6]; const float* w_conv_up = args.in[7];
    const float* w_out = args.in[8]; const float* g_ffn = args.in[9]; const float* w_peer_q = args.in[10]; const float* peer_k1 = args.in[11];
    const float* peer_k2 = args.in[12]; const float* peer_u = args.in[13]; const float* peer_v = args.in[14]; const float* g_ple = args.in[15];
    const float* w_ple_proj = args.in[16]; const float* w_ple_gate = args.in[17]; const float* g_final = args.in[18];
    float* out = args.out;
    float* COS = (float*)(ws + WS_COS); float* SIN = (float*)(ws + WS_SIN);
    bf16* WIN = (bf16*)(ws + WS_WIN); bf16* WRU = (bf16*)(ws + WS_WRU); bf16* WCU = (bf16*)(ws + WS_WCU); bf16* WOUT = (bf16*)(ws + WS_WOUT);
    bf16* WPQ = (bf16*)(ws + WS_WPQ); bf16* WPP = (bf16*)(ws + WS_WPP); bf16* K1 = (bf16*)(ws + WS_K1); bf16* K2 = (bf16*)(ws + WS_K2); bf16* WPG = (bf16*)(ws + WS_WPG);
    unsigned char* U8 = ws + WS_UB; unsigned char* V8 = ws + WS_VB;
    float* SU = (float*)(ws + 128 * 1024); float* SV = (float*)(ws + 256 * 1024);
    float* SS2 = (float*)(ws + 80 * MiB);
    float* RS2 = (float*)(ws + 512 * 1024);
    unsigned* KK = (unsigned*)(ws + WS_BIG + 64 * MiB);
    float* SSP = (float*)(ws + WS_BIG + 80 * MiB);
    float* WSC = (float*)(ws + 82 * MiB);
    unsigned* WCNT = (unsigned*)(ws + 32 * 1024);
    float* PACT = (float*)(ws + WS_PREV);
    float* SS1 = (float*)(ws + WS_COS);
    float* SS3 = (float*)(ws + WS_IDX);
    bf16* XN = (bf16*)(ws + WS_XN); bf16* BIG = (bf16*)(ws + WS_BIG); bf16* PREV = (bf16*)(ws + WS_PREV); bf16* ARET = (bf16*)(ws + WS_ARET);
    int* IDX = (int*)(ws + WS_IDX); float* GATE = (float*)(ws + WS_GATE);
    bf16* CB = BIG;
    bf16* UU = BIG + (size_t)T * 1024;
    bf16* ACONV = CB;
    bf16* GATES = BIG + (size_t)T * 2048;
    bf16* M1 = UU;
    bf16* HB = XN;
    bf16* PB = (bf16*)(ws + 48 * MiB);
    bf16* QP = PREV;
    bf16* PLEB = BIG;
    bf16* H3B = BIG + (size_t)T * 1024;
    PG8_LAS unsigned char* ldsl = (PG8_LAS unsigned char*)lds;

    const int lo = args.ph_lo, hi = args.ph_hi;
#if MK_ONE_LAUNCH
    cg::grid_group grid = cg::this_grid();
    volatile LAS unsigned* lctl = (volatile LAS unsigned*)((LAS unsigned char*)lds + LDS_BYTES - 64);
    if (F.tid < 16) lctl[F.tid] = 0u;
    __syncthreads();
    const XcdBarrier xbar = xcd_barrier_post((unsigned*)(ws + WS_CTL), lctl);
#define SEAM(k) do { if ((k) + 1 < hi) { if ((k) == 0) grid.sync(); else xcd_barrier(xbar); } } while (0)
#else
#define SEAM(k) do { } while (0)
#endif
#define IN(k) (lo <= (k) && (k) < hi)

    if (IN(0)) {
        float* scr = (float*)(lds + F.wave * 16384);
        constexpr int I_IN = (D / 64) * (INW / 32), I_SQ = (D / 64) * (D / 32), I_PQ = (D / 64) * (2048 / 32), I_PP = (PLE / 64) * (D / 32);
        constexpr int NITEMS = I_IN + 4 * I_SQ + I_PQ + I_PP;
        for (int it = F.gw; it < NITEMS; it += F.NGW) {
            int r = it;
            if (r < I_IN) { p0_transpose_item(w_in, D, INW, WIN, scr, r, F.lane, nullptr, true); continue; } r -= I_IN;
            if (r < I_SQ) { p0_transpose_item(w_ret_up, D, D, WRU, scr, r, F.lane); continue; } r -= I_SQ;
            if (r < I_SQ) { p0_transpose_item(w_conv_up, D, D, WCU, scr, r, F.lane); continue; } r -= I_SQ;
            if (r < I_SQ) { p0_transpose_item(w_out, D, D, WOUT, scr, r, F.lane); continue; } r -= I_SQ;
            if (r < I_SQ) { p0_transpose_item(w_ple_gate, D, D, WPG, scr, r, F.lane, g_ple); continue; } r -= I_SQ;
            if (r < I_PQ) { p0_transpose_item(w_peer_q, D, 2048, WPQ, scr, r, F.lane, g_ffn); continue; } r -= I_PQ;
            p0_transpose_item(w_ple_proj, PLE, D, WPP, scr, r, F.lane);
        }
        cvt_f32_bf16(F, p, PB, (size_t)T * PLE);
        cvt_f32_bf16(F, peer_k1, K1, (size_t)PH * PNK * PHALF);
        cvt_f32_bf16(F, peer_k2, K2, (size_t)PH * PNK * PHALF);
        for (int r = F.gw; r < PNE; r += F.NGW) {
            f32x4 vu[4], vv[4];
#pragma unroll
            for (int q = 0; q < 4; ++q) { vu[q] = ((const f32x4*)(peer_u + (size_t)r * D + 16 * F.lane))[q]; vv[q] = ((const f32x4*)(peer_v + (size_t)r * D + 16 * F.lane))[q]; }
            quant_row_i8_cp_fin(vu, U8, r, SU + r, F.lane, g_ffn);
            quant_row_i8_slices(vv, V8, r, SV + r, F.lane);
        }
        for (int e = F.gt; e < SEQ * 64; e += F.NGT) { const int s = e >> 6, i = e & 63; const double inv = pow(10000.0, -(double)i / 64.0); const double ang = (double)s * inv; COS[e] = (float)cos(ang); SIN[e] = (float)sin(ang); }
        {
            const f32x4* gr = (const f32x4*)g_mix + F.lane; f32x4 gg[4];
#pragma unroll
            for (int j = 0; j < 4; ++j) gg[j] = gr[64 * j];
            for (int m = F.gw; m < T / 2; m += F.NGW) {
                const int ma = m, mb = m + T / 2;
                const f32x4* xa_ = (const f32x4*)(x + (size_t)ma * D) + F.lane; const f32x4* xb_ = (const f32x4*)(x + (size_t)mb * D) + F.lane;
                f32x4 va[4], vb[4]; float sa = 0.f, sb = 0.f;
#pragma unroll
                for (int j = 0; j < 4; ++j) { va[j] = xa_[64 * j]; vb[j] = xb_[64 * j]; }
#pragma unroll
                for (int j = 0; j < 4; ++j) { sa += (va[j][0] * va[j][0] + va[j][1] * va[j][1]) + (va[j][2] * va[j][2] + va[j][3] * va[j][3]); sb += (vb[j][0] * vb[j][0] + vb[j][1] * vb[j][1]) + (vb[j][2] * vb[j][2] + vb[j][3] * vb[j][3]); }
                const float ra = 1.0f / sqrtf(wave_sum(sa) * (1.f / D) + EPS), rb = 1.0f / sqrtf(wave_sum(sb) * (1.f / D) + EPS);
                unsigned long long* oa = (unsigned long long*)(XN + (size_t)ma * D) + F.lane; unsigned long long* ob = (unsigned long long*)(XN + (size_t)mb * D) + F.lane;
#pragma unroll
                for (int j = 0; j < 4; ++j) {
                    oa[64 * j] = (unsigned long long)pk2(va[j][0] * ra * gg[j][0], va[j][1] * ra * gg[j][1]) | ((unsigned long long)pk2(va[j][2] * ra * gg[j][2], va[j][3] * ra * gg[j][3]) << 32);
                    ob[64 * j] = (unsigned long long)pk2(vb[j][0] * rb * gg[j][0], vb[j][1] * rb * gg[j][1]) | ((unsigned long long)pk2(vb[j][2] * rb * gg[j][2], vb[j][3] * rb * gg[j][3]) << 32); }
            }
        }
        SEAM(0);
    }

    if (IN(1)) {
        pg8::Gemm g{XN, WIN, T, 3072, D, D, 0}; pg8::StaticOrder S; S.init(T, 3072, F.G, (int)blockIdx.x);
        pg8::EpiQKVG E{BIG, COS, SIN};
        pg8::gemm_phase<pg8::EpiQKVG, pg8::StaticOrder, true>(ldsl, g, S, E);
        SEAM(1);
    }

    if (IN(2)) {
        constexpr int KS = 160, VS = 288;
        bf16* kt = (bf16*)lds;
        bf16* vt = kt + 128 * KS;
        LAS const unsigned char* kt3 = (LAS const unsigned char*)lds; LAS const unsigned char* vt3 = kt3 + 128 * KS * 2;
        const int r32 = F.lane & 31, hg = F.lane >> 5, wm = F.wave >> 2, wn = F.wave & 3;
        const int tq = (F.lane & 15) >> 2, tp = F.lane & 3, tcs = (F.lane >> 4) & 1;
        for (int u = blockIdx.x; u < NUNITS_R; u += F.G) {
            const int h = u & 3, n = (u >> 2) & 31, b = u >> 7; const size_t t0 = (size_t)b * SEQ + (size_t)n * RC;
            const float lg = logf(gamma_of(h));
            __syncthreads();
            for (int c = F.tid; c < 128 * 16; c += NTHREADS) { const int j = c >> 4, c8 = c & 15;
                float f[8]; unpack8(*(const v4u*)(BIG + (t0 + j) * 3072 + RQK + h * RDK + c8 * 8), f);
                const float zeta = __expf(lg * (float)(RC - 1 - j));
                v4u z1; z1.x = pk2(f[0] * zeta, f[1] * zeta); z1.y = pk2(f[2] * zeta, f[3] * zeta); z1.z = pk2(f[4] * zeta, f[5] * zeta); z1.w = pk2(f[6] * zeta, f[7] * zeta);
                *(v4u*)(kt + j * KS + c8 * 8) = z1; }
            for (int c = F.tid; c < 128 * 32; c += NTHREADS) { const int j = c >> 5, c8 = c & 31;
                *(v4u*)(vt + j * VS + c8 * 8) = *(const v4u*)(BIG + (t0 + j) * 3072 + 2 * RQK + h * RDV + c8 * 8); }
            __syncthreads();
            f32x16 acc[2][2];
#pragma unroll
            for (int bm = 0; bm < 2; ++bm)
#pragma unroll
                for (int bn = 0; bn < 2; ++bn)
#pragma unroll
                    for (int z = 0; z < 16; ++z) acc[bm][bn][z] = 0.f;
#pragma unroll
            for (int ks = 0; ks < 8; ++ks) {
                bf16x8v af[2], bfr[2];
#pragma unroll
                for (int q = 0; q < 2; ++q) {
                    LAS const unsigned char* ka = kt3 + ((16 * ks + 8 * hg + tq) * KS + 64 * wm + 32 * q + 16 * tcs + 4 * tp) * 2;
                    LAS const unsigned char* va = vt3 + ((16 * ks + 8 * hg + tq) * VS + 64 * wn + 32 * q + 16 * tcs + 4 * tp) * 2;
                    af[q] = cat8(ds_tr4(ka), ds_tr4(ka + 4 * KS * 2)); bfr[q] = cat8(ds_tr4(va), ds_tr4(va + 4 * VS * 2)); }
#pragma unroll
                for (int bm = 0; bm < 2; ++bm)
#pragma unroll
                    for (int bn = 0; bn < 2; ++bn) acc[bm][bn] = __builtin_amdgcn_mfma_f32_32x32x16_bf16(af[bm], bfr[bn], acc[bm][bn], 0, 0, 0);
            }
#pragma unroll
            for (int bm = 0; bm < 2; ++bm)
#pragma unroll
                for (int bn = 0; bn < 2; ++bn) { const int e = 64 * wn + 32 * bn + r32;
#pragma unroll
                    for (int g = 0; g < 4; ++g) { const int d0 = 64 * wm + 32 * bm + 8 * g + 4 * hg; v2u o; o.x = pk2(acc[bm][bn][4 * g], acc[bm][bn][4 * g + 1]); o.y = pk2(acc[bm][bn][4 * g + 2], acc[bm][bn][4 * g + 3]);
                        *(v2u*)(PREV + ((size_t)u * 256 + e) * 128 + d0) = o; } }
        }
        SEAM(2);
    }

    if (IN(3)) {
        for (int c = F.gt; c < BATCH * RH * 128 * 32; c += F.NGT) {
            const int e8 = c & 31, d = (c >> 5) & 127, h = (c >> 12) & 3, b = c >> 14;
            const float cd = powf(gamma_of(h), (float)RC);
            float st[8];
#pragma unroll
            for (int q = 0; q < 8; ++q) st[q] = 0.f;
            for (int n = 0; n < NCH; ++n) {
                const int u = b * 128 + n * 4 + h; v4u* ptr = (v4u*)(PREV + ((size_t)u * 128 + d) * 256 + e8 * 8);
                const v4u w = *ptr; float f[8]; unpack8(w, f);
                v4u o; o.x = pk2(st[0], st[1]); o.y = pk2(st[2], st[3]); o.z = pk2(st[4], st[5]); o.w = pk2(st[6], st[7]); *ptr = o;
#pragma unroll
                for (int q = 0; q < 8; ++q) st[q] = st[q] * cd + f[q];
            }
        }
        SEAM(3);
    }

    if (IN(4)) {
        constexpr int LS = 136;
        bf16* ksN = (bf16*)lds;
        constexpr int VS = 288;
        bf16* vt = ksN + 128 * LS;
        LAS const unsigned char* vt3 = (LAS const unsigned char*)lds + 128 * LS * 2;
        float* stx = (float*)(vt + 128 * VS);
        const int tq = (F.lane & 15) >> 2, tp = F.lane & 3, tcs = (F.lane >> 4) & 1;
        const int r32 = F.lane & 31, hg = F.lane >> 5, iw = F.wave & 3, eh = F.wave >> 2;
        const int i = 32 * iw + r32;
        for (int u = blockIdx.x; u < NUNITS_R; u += F.G) {
            const int h = u & 3, n = (u >> 2) & 31, b = u >> 7; const size_t t0 = (size_t)b * SEQ + (size_t)n * RC;
            const float lg = logf(gamma_of(h));
            __syncthreads();
            bf16* pt = vt;
            for (int c = F.tid; c < 128 * 16; c += NTHREADS) { const int j = c >> 4, c8 = c & 15;
                *(v4u*)(ksN + j * LS + c8 * 8) = *(const v4u*)(BIG + (t0 + j) * 3072 + RQK + h * RDK + c8 * 8); }
            for (int c = F.tid; c < 256 * 16; c += NTHREADS) { const int e_ = c >> 4, c8 = c & 15;
                *(v4u*)(pt + e_ * LS + c8 * 8) = *(const v4u*)(PREV + ((size_t)u * 256 + e_) * 128 + c8 * 8); }
            bf16x8v qf[8];
            { const bf16* qrow = BIG + (t0 + i) * 3072 + h * RDK + 8 * hg;
#pragma unroll
              for (int ks = 0; ks < 8; ++ks) qf[ks] = *(const bf16x8v*)(qrow + 16 * ks); }
            v4u vst[8];
#pragma unroll
            for (int q = 0; q < 8; ++q) { const int c = F.tid + q * NTHREADS, j = c >> 5, c8 = c & 31; vst[q] = *(const v4u*)(BIG + (t0 + j) * 3072 + 2 * RQK + h * RDV + c8 * 8); }
            f32x16 acc[4];
#pragma unroll
            for (int eb = 0; eb < 4; ++eb)
#pragma unroll
                for (int z = 0; z < 16; ++z) acc[eb][z] = 0.f;
            __syncthreads();
            {
                const bf16* pp = pt + (128 * eh + r32) * LS + 8 * hg;
#pragma unroll
                for (int ks = 0; ks < 8; ++ks)
#pragma unroll
                    for (int eb = 0; eb < 4; ++eb) { const bf16x8v a = *(const bf16x8v*)(pp + (32 * eb) * LS + 16 * ks); acc[eb] = __builtin_amdgcn_mfma_f32_32x32x16_bf16(a, qf[ks], acc[eb], 0, 0, 0); }
                const float xi = __expf(lg * (float)(i + 1));
#pragma unroll
                for (int eb = 0; eb < 4; ++eb)
#pragma unroll
                    for (int z = 0; z < 16; ++z) acc[eb][z] *= xi;
            }
            __syncthreads();
#pragma unroll
            for (int q = 0; q < 8; ++q) { const int c = F.tid + q * NTHREADS, j = c >> 5, c8 = c & 31; *(v4u*)(vt + j * VS + c8 * 8) = vst[q]; }
            __syncthreads();
#pragma unroll 1
            for (int jb = 0; jb <= iw; ++jb) {
                f32x16 X;
#pragma unroll
                for (int z = 0; z < 16; ++z) X[z] = 0.f;
#pragma unroll
                for (int ks = 0; ks < 8; ++ks) { const bf16x8v a = *(const bf16x8v*)(ksN + (32 * jb + r32) * LS + 16 * ks + 8 * hg); X = __builtin_amdgcn_mfma_f32_32x32x16_bf16(a, qf[ks], X, 0, 0, 0); }
#pragma unroll
                for (int z = 0; z < 16; ++z) { const int j = 32 * jb + (z & 3) + 8 * (z >> 2) + 4 * hg; const int df = i - j; X[z] = df >= 0 ? X[z] * __expf(lg * (float)df) : 0.f; }
#pragma unroll
                for (int s2 = 0; s2 < 2; ++s2) {
                    v4u pw; pw.x = pk2(X[8 * s2 + 0], X[8 * s2 + 1]); pw.y = pk2(X[8 * s2 + 2], X[8 * s2 + 3]); pw.z = pk2(X[8 * s2 + 4], X[8 * s2 + 5]); pw.w = pk2(X[8 * s2 + 6], X[8 * s2 + 7]);
                    const bf16x8v pf = __builtin_bit_cast(bf16x8v, pw);
#pragma unroll
                    for (int eb = 0; eb < 4; ++eb) {
                        LAS const unsigned char* va = vt3 + ((32 * jb + 16 * s2 + 4 * hg + tq) * VS + 128 * eh + 32 * eb + 16 * tcs + 4 * tp) * 2;
                        acc[eb] = __builtin_amdgcn_mfma_f32_32x32x16_bf16(cat8(ds_tr4(va), ds_tr4(va + 8 * VS * 2)), pf, acc[eb], 0, 0, 0); }
                }
            }
            float s1 = 0.f, s2 = 0.f;
#pragma unroll
            for (int eb = 0; eb < 4; ++eb)
#pragma unroll
                for (int z = 0; z < 16; ++z) { const float v = acc[eb][z]; s1 += v; s2 += v * v; }
            { auto r1 = __builtin_amdgcn_permlane32_swap(__float_as_uint(s1), __float_as_uint(s1), false, false); s1 = __uint_as_float(r1[0]) + __uint_as_float(r1[1]);
              auto r2 = __builtin_amdgcn_permlane32_swap(__float_as_uint(s2), __float_as_uint(s2), false, false); s2 = __uint_as_float(r2[0]) + __uint_as_float(r2[1]); }
            if (hg == 0) { stx[(eh * 128 + i) * 2] = s1; stx[(eh * 128 + i) * 2 + 1] = s2; }
            __syncthreads();
            { const float o1 = stx[((eh ^ 1) * 128 + i) * 2], o2 = stx[((eh ^ 1) * 128 + i) * 2 + 1]; s1 += o1; s2 += o2; }
            const float mu = s1 * (1.f / 256.f); const float var = fmaxf(s2 * (1.f / 256.f) - mu * mu, 0.f); const float rstd = 1.0f / sqrtf(var + EPS);
            {
                constexpr int YS = 264;
                bf16* ys = vt;
#pragma unroll
                for (int eb = 0; eb < 4; ++eb)
#pragma unroll
                    for (int g = 0; g < 4; ++g) { const int ec = 128 * eh + 32 * eb + 8 * g + 4 * hg;
                        v2u o; o.x = pk2((acc[eb][4 * g] - mu) * rstd, (acc[eb][4 * g + 1] - mu) * rstd); o.y = pk2((acc[eb][4 * g + 2] - mu) * rstd, (acc[eb][4 * g + 3] - mu) * rstd);
                        *(v2u*)(ys + i * YS + ec) = o; }
                __syncthreads();
#pragma unroll
                for (int q = 0; q < 8; ++q) { const int c = F.tid + q * NTHREADS, tkn = c >> 5, c8 = c & 31;
                    float yf[8], gf[8]; unpack8(*(const v4u*)(ys + tkn * YS + c8 * 8), yf); unpack8(*(const v4u*)(BIG + (t0 + tkn) * 3072 + 2 * RQK + RV + h * RDV + c8 * 8), gf);
                    float o[8];
#pragma unroll
                    for (int z = 0; z < 8; ++z) o[z] = yf[z] * gf[z] / (1.0f + __expf(-gf[z]));
                    v4u w; w.x = pk2(o[0], o[1]); w.y = pk2(o[2], o[3]); w.z = pk2(o[4], o[5]); w.w = pk2(o[6], o[7]);
                    *(v4u*)(ARET + (t0 + tkn) * 1024 + h * RDV + c8 * 8) = w; }
            }
        }
        SEAM(4);
    }

    if (IN(5)) {
        pg8::Gemm g{XN, WIN + (size_t)3072 * D, T, 5120, D, D, 0}; pg8::StaticOrder S; S.init(T, 5120, F.G, (int)blockIdx.x);
        pg8::EpiConvGates E{CB, UU, GATES};
        pg8::gemm_phase<pg8::EpiConvGates, pg8::StaticOrder, true>(ldsl, g, S, E);
        SEAM(5);
    }

    if (IN(6)) {
        for (int it = F.gt; it < (T / 8) * 128; it += F.NGT) {
            const int c8 = it & 127, t0 = (it >> 7) * 8, s0 = t0 & (SEQ - 1); const int col = c8 * 8;
            v4u uw[10], cw[8];
#pragma unroll
            for (int r = 0; r < 8; ++r) { uw[r + 2] = *(const v4u*)(UU + (size_t)(t0 + r) * 1024 + col); cw[r] = *(const v4u*)(CB + (size_t)(t0 + r) * 1024 + col); }
            if (s0 != 0) { uw[0] = *(const v4u*)(UU + (size_t)(t0 - 2) * 1024 + col); uw[1] = *(const v4u*)(UU + (size_t)(t0 - 1) * 1024 + col); }
            else { uw[0] = (v4u){0u, 0u, 0u, 0u}; uw[1] = (v4u){0u, 0u, 0u, 0u}; }
            float w0[8], w1[8], w2[8], bs[8];
            *(f32x4*)w0 = *(const f32x4*)(conv_w + col); *(f32x4*)(w0 + 4) = *(const f32x4*)(conv_w + col + 4);
            *(f32x4*)w1 = *(const f32x4*)(conv_w + 1024 + col); *(f32x4*)(w1 + 4) = *(const f32x4*)(conv_w + 1024 + col + 4);
            *(f32x4*)w2 = *(const f32x4*)(conv_w + 2048 + col); *(f32x4*)(w2 + 4) = *(const f32x4*)(conv_w + 2048 + col + 4);
            *(f32x4*)bs = *(const f32x4*)(conv_b + col); *(f32x4*)(bs + 4) = *(const f32x4*)(conv_b + col + 4);
            float ua[8], ub[8], uc[8];
            unpack8(uw[0], ua); unpack8(uw[1], ub);
#pragma unroll
            for (int r = 0; r < 8; ++r) {
                float cb[8], o[8]; unpack8(uw[r + 2], uc); unpack8(cw[r], cb);
#pragma unroll
                for (int z = 0; z < 8; ++z) { o[z] = cb[z] * (w0[z] * ua[z] + w1[z] * ub[z] + w2[z] * uc[z] + bs[z]); ua[z] = ub[z]; ub[z] = uc[z]; }
                v4u w; w.x = pk2(o[0], o[1]); w.y = pk2(o[2], o[3]); w.z = pk2(o[4], o[5]); w.w = pk2(o[6], o[7]);
                *(v4u*)(ACONV + (size_t)(t0 + r) * 1024 + col) = w;
            }
        }
        SEAM(6);
    }


    if (IN(8)) {
        pg8::StaticOrder S; S.init(T, D, F.G, (int)blockIdx.x);
        { pg8::Gemm g{ARET, WRU, T, D, D, D, 0}; pg8::EpiGate<false> E{M1, D, GATES, 2048, 0};
          pg8::gemm_phase<pg8::EpiGate<false>, pg8::StaticOrder, true>(ldsl, g, S, E); }
        asm volatile("s_waitcnt vmcnt(0)" ::: "memory"); __syncthreads();
        { pg8::Gemm g{ACONV, WCU, T, D, D, D, 0}; pg8::EpiGate<true> E{M1, D, GATES, 2048, 1024};
          pg8::gemm_phase<pg8::EpiGate<true>, pg8::StaticOrder, true>(ldsl, g, S, E); }
        SEAM(8);
    }

    if (IN(9)) {
        pg8::Gemm g{M1, WOUT, T, D, D, D, 0}; pg8::StaticOrder S; S.init(T, D, F.G, (int)blockIdx.x);
        pg8::EpiResBf16SS E{x, HB, SS1, D};
        pg8::gemm_phase<pg8::EpiResBf16SS, pg8::StaticOrder, true>(ldsl, g, S, E);
        SEAM(9);
    }


    if (IN(11)) {
        { pg8::Gemm g{HB, WPQ, T, 2048, D, D, 0}; pg8::StaticOrder S; S.init(T, 2048, F.G, (int)blockIdx.x);
          pg8::EpiBf16 E{QP, 2048};
          pg8::gemm_phase<pg8::EpiBf16, pg8::StaticOrder, true>(ldsl, g, S, E); }
        { pg8::Gemm g{PB, WPP, T, D, PLE, PLE, 0}; pg8::StaticOrder S; S.init(T, D, F.G, (int)blockIdx.x);
          pg8::EpiBf16 E{PLEB, D};
          pg8::gemm_phase<pg8::EpiBf16, pg8::StaticOrder, true>(ldsl, g, S, E); }
        SEAM(11);
    }

    if (IN(12)) {
        constexpr int LS = 136;
        bf16* k1s = (bf16*)lds; bf16* k2s = k1s + 128 * LS;
        const int h = blockIdx.x & 7;
        __syncthreads();
        for (int c = F.tid; c < 128 * 16; c += NTHREADS) { const int j = c >> 4, c8 = c & 15;
            *(v4u*)(k1s + j * LS + c8 * 8) = *(const v4u*)(K1 + ((size_t)h * 128 + j) * 128 + c8 * 8);
            *(v4u*)(k2s + j * LS + c8 * 8) = *(const v4u*)(K2 + ((size_t)h * 128 + j) * 128 + c8 * 8); }
        __syncthreads();
        const int r32 = F.lane & 31, hg = F.lane >> 5;
        const int nwv = (F.G >> 3) * NWAVES;
        for (int tt = (blockIdx.x >> 3) * NWAVES + F.wave; tt < T / 32; tt += nwv) {
            const int t0 = tt * 32;
            unsigned V1[16], V2[16];
            peer_half_topk(QP + (size_t)(t0 + r32) * 2048 + h * 256 + 8 * hg, k1s + r32 * 136 + 8 * hg, hg, V1);
            __builtin_amdgcn_sched_barrier(0);
            peer_half_topk(QP + (size_t)(t0 + r32) * 2048 + h * 256 + 128 + 8 * hg, k2s + r32 * 136 + 8 * hg, hg, V2);
            __builtin_amdgcn_sched_barrier(0);
            float v1[16], v2[16];
#pragma unroll
            for (int z = 0; z < 16; ++z) { v1[z] = ord_val(V1[z] & ~0x7Fu); v2[z] = ord_val(V2[z] & ~0x7Fu); }
#define CKEY(a, b) ((ord_key(v1[a] + v2[b]) & ~0xFFu) | (unsigned)(255 - ((a) * 16 + (b))))
            unsigned g0[16], g1[16], g2[16], g3[16];
#pragma unroll
            for (int b = 0; b < 16; ++b) g0[b] = CKEY(0, b);
#pragma unroll
            for (int b = 0; b < 8; ++b) g1[b] = CKEY(1, b);
#pragma unroll
            for (int b = 0; b < 5; ++b) g1[8 + b] = CKEY(2, b);
#pragma unroll
            for (int b = 0; b < 3; ++b) g1[13 + b] = CKEY(3, b);
            g2[0] = CKEY(3, 3);
#pragma unroll
            for (int b = 0; b < 3; ++b) g2[1 + b] = CKEY(4, b);
#pragma unroll
            for (int b = 0; b < 2; ++b) { g2[4 + b] = CKEY(5, b); g2[6 + b] = CKEY(6, b); g2[8 + b] = CKEY(7, b); }
#pragma unroll
            for (int a = 8; a < 14; ++a) g2[10 + (a - 8)] = CKEY(a, 0);
            { const unsigned c14 = CKEY(14, 0), c15 = CKEY(15, 0); g3[0] = max(c14, c15); g3[1] = min(c14, c15); }
#pragma unroll
            for (int z = 2; z < 16; ++z) g3[z] = 0u;
#undef CKEY
            sort16_desc(g1); sort16_desc(g2); merge16_desc(g1, g2); merge16_desc(g1, g3); merge16_desc(g0, g1);
            float ts[16], ex[16]; float den = 0.f;
            float rs1;
            { const f32x4* sp = (const f32x4*)(SS1 + (size_t)(t0 + r32) * 16); const f32x4 s0 = sp[0], s1 = sp[1], s2 = sp[2], s3 = sp[3];
              const float ssum = ((s0[0] + s0[1]) + (s0[2] + s0[3])) + ((s1[0] + s1[1]) + (s1[2] + s1[3])) + ((s2[0] + s2[1]) + (s2[2] + s2[3])) + ((s3[0] + s3[1]) + (s3[2] + s3[3]));
              rs1 = 1.0f / sqrtf(ssum * (1.f / D) + EPS); }
#pragma unroll
            for (int z = 0; z < 16; ++z) ts[z] = ord_val(g0[z] & ~0xFFu) * rs1;
#pragma unroll
            for (int z = 0; z < 16; ++z) { ex[z] = __expf(ts[z] - ts[0]); den += ex[z]; }
            const float inv = 1.0f / den;
            int oi[8]; float og[8];
#pragma unroll
            for (int rr = 0; rr < 8; ++rr) {
                unsigned klo = g0[rr], khi = g0[8 + rr]; float elo = ex[rr], ehi = ex[8 + rr];
                asm volatile("" : "+v"(klo), "+v"(khi), "+v"(elo), "+v"(ehi));
                const unsigned key = hg ? khi : klo; const int c = 255 - (int)(key & 0xFFu); const int a = c >> 4, b = c & 15;
                unsigned ka = V1[0], kb2 = V2[0];
#pragma unroll
                for (int z = 1; z < 16; ++z) { ka = (a == z) ? V1[z] : ka; kb2 = (b == z) ? V2[z] : kb2; }
                oi[rr] = (127 - (int)(ka & 0x7Fu)) * PNK + (127 - (int)(kb2 & 0x7Fu));
                og[rr] = (hg ? ehi : elo) * inv;
            }
            int* ip = IDX + (size_t)(t0 + r32) * NSEL + h * PTOPK + 8 * hg; float* gp = GATE + (size_t)(t0 + r32) * NSEL + h * PTOPK + 8 * hg;
            *(v4u*)ip = (v4u){(unsigned)oi[0], (unsigned)oi[1], (unsigned)oi[2], (unsigned)oi[3]}; *(v4u*)(ip + 4) = (v4u){(unsigned)oi[4], (unsigned)oi[5], (unsigned)oi[6], (unsigned)oi[7]};
            *(f32x4*)gp = (f32x4){og[0], og[1], og[2], og[3]}; *(f32x4*)(gp + 4) = (f32x4){og[4], og[5], og[6], og[7]};
        }
        SEAM(12);
    }

    if (IN(13)) {
        volatile int* item_w = (volatile int*)(lds + 1024);
        const int s8 = F.lane & 7, r8 = F.lane >> 3; const int xcc = (int)(xb_xcc_id() & 7u);
        for (;;) {
            __syncthreads();
            if (F.tid == 0) { int it = -1;
                for (int k = 0; k < 8 && it < 0; ++k) { const int jj = (xcc + k) & 7; const unsigned cc = __hip_atomic_fetch_add(WCNT + jj, 1u, __ATOMIC_RELAXED, __HIP_MEMORY_SCOPE_AGENT); if (cc < (unsigned)(T / 64)) it = (jj << 16) | (int)cc; }
                item_w[0] = it; }
            __syncthreads();
            const int item = item_w[0];
            if (item < 0) break;
            const int j = item >> 16, ch = item & 0xffff;
            const unsigned char* tabj = U8 + (size_t)j * PNE_ROWS * 128 + s8 * 16;
            const int tb = ch * 64 + F.wave * 8;
            int ida[8], idb[8]; v4u xa[8], xb[8];
#pragma unroll
            for (int tt = 0; tt < 8; ++tt) { ida[tt] = IDX[(size_t)(tb + tt) * NSEL + F.lane]; idb[tt] = IDX[(size_t)(tb + tt) * NSEL + 64 + F.lane];
                const bf16* xp = HB + (size_t)(tb + tt) * D + 128 * j + 16 * s8; xa[tt] = *(const v4u*)xp; xb[tt] = *(const v4u*)(xp + 8); }
            v4u rowsA[8], rowsB[8];
#define P13_ROWS(buf, tt, hh) do { _Pragma("unroll") for (int g = 0; g < 8; ++g) { const int id = __shfl((hh) ? idb[tt] : ida[tt], 8 * g + r8); buf[g] = *(const v4u*)(tabj + (size_t)id * 128); } } while (0)
#define P13_DOT(buf, hh, xq, sx, pp) do { \
                _Pragma("unroll") for (int g = 0; g < 8; ++g) { int d_ = __builtin_amdgcn_sdot4((int)buf[g].x, xq[0], 0, false); d_ = __builtin_amdgcn_sdot4((int)buf[g].y, xq[1], d_, false); \
                    d_ = __builtin_amdgcn_sdot4((int)buf[g].z, xq[2], d_, false); d_ = __builtin_amdgcn_sdot4((int)buf[g].w, xq[3], d_, false); \
                    pp[8 * (hh) + g] = (float)d_ * sx; } } while (0)
            const bool b4_ = (s8 & 4) != 0, b2_ = (s8 & 2) != 0, b1_ = (s8 & 1) != 0;
            P13_ROWS(rowsA, 0, 0);
#pragma unroll
            for (int tt = 0; tt < 8; ++tt) {
                float xf[16]; unpack8(xa[tt], xf); unpack8(xb[tt], xf + 8); float pp[16];
                P13_ROWS(rowsB, tt, 1);
                float am = 0.f;
#pragma unroll
                for (int z = 0; z < 16; ++z) am = fmaxf(am, fabsf(xf[z]));
                am = fmaxf(am, __shfl_xor(am, 1)); am = fmaxf(am, __shfl_xor(am, 2)); am = fmaxf(am, __shfl_xor(am, 4));
                const float qs = am > 0.f ? 127.0f / am : 0.f, sx = am * (1.0f / 127.0f);
                int xq[4];
#pragma unroll
                for (int q = 0; q < 4; ++q) { const int q0 = (int)rintf(xf[4 * q] * qs), q1 = (int)rintf(xf[4 * q + 1] * qs), q2 = (int)rintf(xf[4 * q + 2] * qs), q3 = (int)rintf(xf[4 * q + 3] * qs);
                    xq[q] = (int)((unsigned)(q0 & 0xff) | ((unsigned)(q1 & 0xff) << 8) | ((unsigned)(q2 & 0xff) << 16) | ((unsigned)(q3 & 0xff) << 24)); }
                P13_DOT(rowsA, 0, xq, sx, pp); __builtin_amdgcn_sched_barrier(0);
                if (tt < 7) P13_ROWS(rowsA, tt + 1, 0);
                P13_DOT(rowsB, 1, xq, sx, pp);
                float a8[8], a4[4], a2[2];
#pragma unroll
                for (int g = 0; g < 8; ++g) { const float keep = b4_ ? pp[g + 8] : pp[g], give = b4_ ? pp[g] : pp[g + 8]; a8[g] = keep + __shfl_xor(give, 4); }
#pragma unroll
                for (int g = 0; g < 4; ++g) { const float keep = b2_ ? a8[g + 4] : a8[g], give = b2_ ? a8[g] : a8[g + 4]; a4[g] = keep + __shfl_xor(give, 2); }
#pragma unroll
                for (int g = 0; g < 2; ++g) { const float keep = b1_ ? a4[g + 2] : a4[g], give = b1_ ? a4[g] : a4[g + 2]; a2[g] = keep + __shfl_xor(give, 1); }
                float* pa = PACT + ((size_t)j * T + (tb + tt)) * NSEL + 16 * s8 + r8; pa[0] = a2[0]; pa[8] = a2[1];
                __builtin_amdgcn_sched_barrier(0);
            }
#undef P13_ROWS
#undef P13_DOT
        }
        SEAM(13);
    }

    if (IN(14)) {
        unsigned* tl = (unsigned*)lds;
        for (int ch = blockIdx.x; ch < T / 64; ch += F.G) {
            __syncthreads();
#pragma unroll 1
            for (int tt = 0; tt < 8; ++tt) {
                const int tloc = F.wave * 8 + tt, t = ch * 64 + tloc;
                float ssum = 0.f;
                if (F.lane < 16) ssum = SS1[(size_t)t * 16 + F.lane];
                ssum = wave_sum(ssum);
                const float rs1 = 1.0f / sqrtf(ssum * (1.f / D) + EPS);
                float a0 = 0.f, a1 = 0.f;
#pragma unroll
                for (int j = 0; j < 8; ++j) { const float* pa = PACT + ((size_t)j * T + t) * NSEL + F.lane; a0 += pa[0]; a1 += pa[64]; }
                const int id0 = IDX[(size_t)t * NSEL + F.lane], id1 = IDX[(size_t)t * NSEL + 64 + F.lane];
                const float g0 = GATE[(size_t)t * NSEL + F.lane], g1 = GATE[(size_t)t * NSEL + 64 + F.lane];
                const float w0 = g0 * gelu_f(a0 * rs1 * SU[id0]) * SV[id0], w1 = g1 * gelu_f(a1 * rs1 * SU[id1]) * SV[id1];
                const float am = wave_max(fmaxf(fabsf(w0), fabsf(w1))); const float qs = am > 0.f ? 127.0f / am : 0.f;
                tl[F.lane * 65 + tloc] = ((unsigned)id0 << 11) | ((unsigned)((int)rintf(w0 * qs)) & 0xffu);
                tl[(64 + F.lane) * 65 + tloc] = ((unsigned)id1 << 11) | ((unsigned)((int)rintf(w1 * qs)) & 0xffu);
                if (F.lane == 0) WSC[t] = am * (1.0f / 127.0f);
            }
            __syncthreads();
#pragma unroll
            for (int q = 0; q < 16; ++q) { const int c = F.tid + q * NTHREADS, e_ = c >> 6, tl_ = c & 63; KK[(size_t)e_ * T + ch * 64 + tl_] = tl[e_ * 65 + tl_]; }
        }
        SEAM(14);
    }

    if (IN(7)) {
        LAS const unsigned char* vl3 = (LAS const unsigned char*)lds;
        const __amdgpu_buffer_rsrc_t rsK = __builtin_amdgcn_make_buffer_rsrc((void*)KK, 0, NSEL * T * 4, 0x00020000);
        for (int work = blockIdx.x; work < 256; work += F.G) {
            const int sl = work >> 1, tbase = (work & 1) * (T / 2);
            __syncthreads();
            for (int c = F.tid; c < PNE_ROWS * 8 / 16; c += NTHREADS) *((v4u*)lds + c) = *((const v4u*)(V8 + (size_t)sl * PNE_ROWS * 8) + c);
            __syncthreads();
#pragma unroll 1
            for (int grp = F.wave; grp < T / 2 / 64; grp += NWAVES) {
                const int t = tbase + grp * 64 + F.lane;
                const int kvo = t * 4;
                int acci[8];
#pragma unroll
                for (int z = 0; z < 8; ++z) acci[z] = 0;
                unsigned kc[2][32];
#pragma unroll
                for (int q = 0; q < 32; ++q) kc[0][q] = __builtin_amdgcn_raw_buffer_load_b32(rsK, kvo, q * (T * 4), 0);
#pragma unroll
                for (int ck = 0; ck < 4; ++ck) {
                    if (ck < 3) {
#pragma unroll
                        for (int q = 0; q < 32; ++q) kc[(ck + 1) & 1][q] = __builtin_amdgcn_raw_buffer_load_b32(rsK, kvo, (32 * (ck + 1) + q) * (T * 4), 0);
                    }
#pragma unroll
                    for (int e8 = 0; e8 < 4; ++e8) {
                        v2u vr[8];
#pragma unroll
                        for (int q = 0; q < 8; ++q) vr[q] = *(const LAS v2u*)(vl3 + (kc[ck & 1][8 * e8 + q] >> 8));
#pragma unroll
                        for (int g4 = 0; g4 < 2; ++g4) {
                            const unsigned k0 = kc[ck & 1][8 * e8 + 4 * g4], k1 = kc[ck & 1][8 * e8 + 4 * g4 + 1], k2 = kc[ck & 1][8 * e8 + 4 * g4 + 2], k3 = kc[ck & 1][8 * e8 + 4 * g4 + 3];
                            const unsigned w01_ = __builtin_amdgcn_perm(k1, k0, 0x0c0c0400u), w23_ = __builtin_amdgcn_perm(k3, k2, 0x0c0c0400u); const int w4_ = (int)__builtin_amdgcn_perm(w23_, w01_, 0x05040100u);
#pragma unroll
                            for (int c4 = 0; c4 < 2; ++c4) { const unsigned a_ = vr[4 * g4][c4], b_ = vr[4 * g4 + 1][c4], c_ = vr[4 * g4 + 2][c4], d_ = vr[4 * g4 + 3][c4];
                                const unsigned t0_ = __builtin_amdgcn_perm(b_, a_, 0x05010400u), t1_ = __builtin_amdgcn_perm(b_, a_, 0x07030602u), t2_ = __builtin_amdgcn_perm(d_, c_, 0x05010400u), t3_ = __builtin_amdgcn_perm(d_, c_, 0x07030602u);
                                acci[4 * c4 + 0] = __builtin_amdgcn_sdot4((int)__builtin_amdgcn_perm(t2_, t0_, 0x05040100u), w4_, acci[4 * c4 + 0], false);
                                acci[4 * c4 + 1] = __builtin_amdgcn_sdot4((int)__builtin_amdgcn_perm(t2_, t0_, 0x07060302u), w4_, acci[4 * c4 + 1], false);
                                acci[4 * c4 + 2] = __builtin_amdgcn_sdot4((int)__builtin_amdgcn_perm(t3_, t1_, 0x05040100u), w4_, acci[4 * c4 + 2], false);
                                acci[4 * c4 + 3] = __builtin_amdgcn_sdot4((int)__builtin_amdgcn_perm(t3_, t1_, 0x07060302u), w4_, acci[4 * c4 + 3], false); }
                        }
                    }
                }
                const float wsc = WSC[t];
                v4u* hp = (v4u*)(HB + (size_t)t * D + 8 * sl);
                float hf[8]; unpack8(*hp, hf);
                float ssq = 0.f;
#pragma unroll
                for (int z = 0; z < 8; ++z) { hf[z] += (float)acci[z] * wsc; ssq += hf[z] * hf[z]; }
                v4u o; o.x = pk2(hf[0], hf[1]); o.y = pk2(hf[2], hf[3]); o.z = pk2(hf[4], hf[5]); o.w = pk2(hf[6], hf[7]);
                *hp = o;
                SSP[(size_t)sl * T + t] = ssq;
            }
        }
        SEAM(7);
    }

    if (IN(10)) {
        for (int t = F.gt; t < T; t += F.NGT) { float s_ = 0.f;
#pragma unroll 16
            for (int sl = 0; sl < 128; ++sl) s_ += SSP[(size_t)sl * T + t];
            RS2[t] = 1.0f / sqrtf(s_ * (1.f / D) + EPS); }
        SEAM(10);
    }


    if (IN(15)) {
        pg8::Gemm g{HB, WPG, T, D, D, D, 0}; pg8::StaticOrder S; S.init(T, D, F.G, (int)blockIdx.x);
        pg8::EpiPleBf16SS E{HB, PLEB, H3B, RS2, SS3, D};
        pg8::gemm_phase<pg8::EpiPleBf16SS, pg8::StaticOrder, true>(ldsl, g, S, E);
        SEAM(15);
    }

    if (IN(16)) {
        const f32x4* gr = (const f32x4*)g_final + F.lane;
        f32x4 gg[4];
#pragma unroll
        for (int j = 0; j < 4; ++j) gg[j] = gr[64 * j];
        for (int m = F.gw; m < T / 2; m += F.NGW) {
            const int ma = m, mb = m + T / 2;
            float sa = 0.f, sb = 0.f;
            if (F.lane < 16) { sa = SS3[(size_t)ma * 16 + F.lane]; sb = SS3[(size_t)mb * 16 + F.lane]; }
            const v2u* ha = (const v2u*)(H3B + (size_t)ma * D) + F.lane; const v2u* hb = (const v2u*)(H3B + (size_t)mb * D) + F.lane;
            v2u wa[4], wb[4];
#pragma unroll
            for (int j = 0; j < 4; ++j) { wa[j] = ha[64 * j]; wb[j] = hb[64 * j]; }
            sa = wave_sum(sa); sb = wave_sum(sb);
            const float ra = 1.0f / sqrtf(sa * (1.f / D) + EPS), rb = 1.0f / sqrtf(sb * (1.f / D) + EPS);
            f32x4* oa = (f32x4*)(out + (size_t)ma * D) + F.lane; f32x4* ob = (f32x4*)(out + (size_t)mb * D) + F.lane;
#pragma unroll
            for (int j = 0; j < 4; ++j) {
                oa[64 * j] = (f32x4){bflo(wa[j].x) * ra * gg[j][0], bfhi(wa[j].x) * ra * gg[j][1], bflo(wa[j].y) * ra * gg[j][2], bfhi(wa[j].y) * ra * gg[j][3]};
                ob[64 * j] = (f32x4){bflo(wb[j].x) * rb * gg[j][0], bfhi(wb[j].x) * rb * gg[j][1], bflo(wb[j].y) * rb * gg[j][2], bfhi(wb[j].y) * rb * gg[j][3]}; }
        }
    }
#undef IN
#undef SEAM
}

constexpr int N_PHASES = 17;

extern "C" void kernel_launch(void* const* d_in, const int* in_sizes, int n_in, void* d_out, int out_size, void* d_ws, size_t ws_size, hipStream_t stream) {
    static int grid = 0;
    if (grid == 0) {
        if (n_in != 19 || out_size != T * D || ws_size < WS_END) { fprintf(stderr, "kernel_launch: unexpected shapes: n_in %d out %d ws %zu\n", n_in, out_size, ws_size); grid = -1; return; }
        int dev = 0, cus = 0, per_cu = 0;
        hipGetDevice(&dev); hipDeviceGetAttribute(&cus, hipDeviceAttributeMultiprocessorCount, dev);
        if (hipFuncSetAttribute((const void*)mega, hipFuncAttributeMaxDynamicSharedMemorySize, LDS_BYTES) != hipSuccess) { fprintf(stderr, "kernel_launch: hipFuncSetAttribute failed\n"); grid = -1; return; }
        if (hipOccupancyMaxActiveBlocksPerMultiprocessor(&per_cu, (const void*)mega, NTHREADS, LDS_BYTES) != hipSuccess || per_cu < 1) { fprintf(stderr, "kernel_launch: occupancy query says %d\n", per_cu); per_cu = 1; }
        (void)hipGetLastError();
        grid = cus;
        if (grid % 8 != 0) fprintf(stderr, "kernel_launch: grid %d not a multiple of 8\n", grid);
    }
    if (grid < 0) return;
    Args a{};
    for (int i = 0; i < 19; ++i) a.in[i] = (const float*)d_in[i];
    a.out = (float*)d_out; a.ws = (unsigned char*)d_ws;
#if MK_ONE_LAUNCH
    a.ph_lo = 0; a.ph_hi = N_PHASES;
    if (hipMemsetAsync((char*)d_ws + WS_CTL, 0, CTL_ZERO_BYTES, stream) != hipSuccess) { fprintf(stderr, "kernel_launch: memset failed\n"); return; }
    void* kargs[] = {&a};
    hipError_t e = hipLaunchCooperativeKernel((const void*)mega, dim3(grid), dim3(NTHREADS), kargs, LDS_BYTES, stream);
    if (e != hipSuccess) fprintf(stderr, "cooperative launch failed: %s (grid %d)\n", hipGetErrorString(e), grid);
#else
    for (int ph = 0; ph < N_PHASES; ++ph) {
        a.ph_lo = ph; a.ph_hi = ph + 1;
        hipLaunchKernelGGL(mega, dim3(grid), dim3(NTHREADS), LDS_BYTES, stream, a);
    }
#endif
}
```

```cpp
#include <hip/hip_runtime.h>
#include <hip/hip_cooperative_groups.h>
#include <cstdio>
#include <cstdint>
#include <cmath>
namespace cg = cooperative_groups;

#ifndef MK_ONE_LAUNCH
#define MK_ONE_LAUNCH 1
#endif

namespace pg8 {
#define PG8_LAS __attribute__((address_space(3)))
typedef unsigned short bf16_t;
typedef short bf16x8 __attribute__((ext_vector_type(8)));
typedef float f32x4 __attribute__((ext_vector_type(4)));
typedef unsigned u32x4 __attribute__((ext_vector_type(4)));
typedef unsigned u32x2 __attribute__((ext_vector_type(2)));
constexpr int BM = 256, BK = 64, HALF = 128, HTB = HALF * BK * 2, STAGE_BYTES = 8 * HTB, NXCD = 8, WGM = 8;

__host__ __device__ __forceinline__ int lds_byte(int r, int c) { const int st = (r >> 4) * 2 + (c >> 5), rr = r & 15, cc = c & 31, ob = rr * 64 + cc * 2; return st * 1024 + (ob ^ (((ob >> 9) & 1) << 5)); }
__host__ __device__ __forceinline__ void stage_rc(int b, int& R, int& C) { const int st = b / 1024, sb = b % 1024, swz = sb ^ (((sb >> 9) & 1) << 5); R = (st >> 1) * 16 + swz / 64; C = (st & 1) * 32 + (swz % 64) / 2; }
__host__ __device__ __forceinline__ int perm32(int rho) { const int n = rho >> 4, i = rho & 15; return 8 * (i >> 2) + 4 * n + (i & 3); }

struct Unit { int pm, pn; };
struct Gemm { const bf16_t* A; const bf16_t* Bt; int M, N, K, lda, a_pn_cols; };

struct StaticOrder {
    int nM, nN, nwg, G, c;
    __host__ __device__ void init(int M, int N, int G_, int c_) { nM = M / BM; nN = N / BM; nwg = nM * nN; G = G_; c = c_; }
    __host__ __device__ bool next(int i, Unit& u) const {
        const long L = (long)i * G + c; if (L >= nwg) return false;
        int wgid = (int)L; { const int q = nwg / NXCD, r = nwg % NXCD, xcd = wgid % NXCD, off = wgid / NXCD; wgid = (xcd < r ? xcd * (q + 1) : r * (q + 1) + (xcd - r) * q) + off; }
        const int nig = WGM * nN, gid = wgid / nig, fm = gid * WGM, gsz = (nM - fm) < WGM ? (nM - fm) : WGM;
        u.pm = fm + ((wgid % nig) % gsz); u.pn = (wgid % nig) / gsz; return true;
    }
    __device__ __forceinline__ void a_ready(const Unit&) const {}
    __device__ __forceinline__ void done(const Unit&) const {}
};

__device__ __forceinline__ unsigned cvt_pk_bf16(float lo, float hi) { unsigned r; asm volatile("v_cvt_pk_bf16_f32 %0, %1, %2" : "=v"(r) : "v"(lo), "v"(hi)); return r; }
__device__ __forceinline__ float bf_lo(unsigned w) { return __uint_as_float(w << 16); }
__device__ __forceinline__ float bf_hi(unsigned w) { return __uint_as_float(w & 0xffff0000u); }
__device__ __forceinline__ float sigmoidf_(float x) { return 1.0f / (1.0f + __expf(-x)); }

struct EpiBf16 {
    static constexpr bool PERM = true, AFTER_DRAIN = false;
    bf16_t* O; int ldc;
    __device__ __forceinline__ void operator()(const f32x4 (&acc)[2][2][4][2], const Unit& u, int wr, int wc, int fr, int fq) const {
        const int row0 = u.pm * BM + wr * 64 + fr; const int col0 = u.pn * BM + wc * 32 + 8 * fq;
#pragma unroll
        for (int ai = 0; ai < 2; ++ai)
#pragma unroll
            for (int m = 0; m < 4; ++m) { bf16_t* rowp = O + (size_t)(row0 + ai * HALF + m * 16) * ldc + col0;
#pragma unroll
                for (int bj = 0; bj < 2; ++bj) { const f32x4 v0 = acc[ai][bj][m][0], v1 = acc[ai][bj][m][1];
                    u32x4 w; w.x = cvt_pk_bf16(v0[0], v0[1]); w.y = cvt_pk_bf16(v0[2], v0[3]); w.z = cvt_pk_bf16(v1[0], v1[1]); w.w = cvt_pk_bf16(v1[2], v1[3]);
                    *(u32x4*)(rowp + bj * HALF) = w; } }
    }
};
template <bool ACCUM> struct EpiGate {
    static constexpr bool PERM = true, AFTER_DRAIN = false;
    bf16_t* O; int ldc; const bf16_t* G; int ldg; int gcol;
    __device__ __forceinline__ void operator()(const f32x4 (&acc)[2][2][4][2], const Unit& u, int wr, int wc, int fr, int fq) const {
        const int row0 = u.pm * BM + wr * 64 + fr; const int col0 = u.pn * BM + wc * 32 + 8 * fq;
#pragma unroll
        for (int ai = 0; ai < 2; ++ai) {
            u32x2 gpre[4][2]; u32x4 opre[4][2];
#pragma unroll
            for (int m = 0; m < 4; ++m)
#pragma unroll
                for (int bj = 0; bj < 2; ++bj) { const size_t r = (size_t)(row0 + ai * HALF + m * 16); gpre[m][bj] = *(const u32x2*)((const unsigned char*)G + r * ldg + gcol + col0 + bj * HALF);
                    if (ACCUM) opre[m][bj] = *(const u32x4*)(O + r * ldc + col0 + bj * HALF); }
            asm volatile("" ::: "memory");
#pragma unroll
            for (int m = 0; m < 4; ++m) { const size_t r = (size_t)(row0 + ai * HALF + m * 16);
#pragma unroll
                for (int bj = 0; bj < 2; ++bj) { const f32x4 v0 = acc[ai][bj][m][0], v1 = acc[ai][bj][m][1];
                    const u32x2 g = gpre[m][bj]; constexpr float k255 = 1.0f / 255.0f;
                    float o[8];
                    o[0] = (float)(g.x & 0xffu) * k255 * v0[0]; o[1] = (float)((g.x >> 8) & 0xffu) * k255 * v0[1]; o[2] = (float)((g.x >> 16) & 0xffu) * k255 * v0[2]; o[3] = (float)(g.x >> 24) * k255 * v0[3];
                    o[4] = (float)(g.y & 0xffu) * k255 * v1[0]; o[5] = (float)((g.y >> 8) & 0xffu) * k255 * v1[1]; o[6] = (float)((g.y >> 16) & 0xffu) * k255 * v1[2]; o[7] = (float)(g.y >> 24) * k255 * v1[3];
                    bf16_t* op = O + r * ldc + col0 + bj * HALF;
                    if (ACCUM) { const u32x4 p = opre[m][bj];
                        o[0] += bf_lo(p.x); o[1] += bf_hi(p.x); o[2] += bf_lo(p.y); o[3] += bf_hi(p.y); o[4] += bf_lo(p.z); o[5] += bf_hi(p.z); o[6] += bf_lo(p.w); o[7] += bf_hi(p.w); }
                    u32x4 w; w.x = cvt_pk_bf16(o[0], o[1]); w.y = cvt_pk_bf16(o[2], o[3]); w.z = cvt_pk_bf16(o[4], o[5]); w.w = cvt_pk_bf16(o[6], o[7]);
                    *(u32x4*)op = w; } }
        }
    }
};
struct EpiResF32 {
    static constexpr bool PERM = false, AFTER_DRAIN = false;
    const float* base; float* out; int ldc;
    __device__ __forceinline__ void operator()(const f32x4 (&acc)[2][2][4][2], const Unit& u, int wr, int wc, int fr, int fq) const {
        const int row0 = u.pm * BM + wr * 64 + fr; const int col0 = u.pn * BM + wc * 32 + 4 * fq;
#pragma unroll
        for (int ai = 0; ai < 2; ++ai)
#pragma unroll
            for (int m = 0; m < 4; ++m) { const size_t off = (size_t)(row0 + ai * HALF + m * 16) * ldc + col0;
#pragma unroll
                for (int bj = 0; bj < 2; ++bj)
#pragma unroll
                    for (int n = 0; n < 2; ++n) { const f32x4 b = *(const f32x4*)(base + off + bj * HALF + n * 16); *(f32x4*)(out + off + bj * HALF + n * 16) = b + acc[ai][bj][m][n]; } }
    }
};
struct EpiQKVG {
    static constexpr bool PERM = true, AFTER_DRAIN = false;
    bf16_t* O; const float* COS; const float* SIN;
    __device__ __forceinline__ void operator()(const f32x4 (&acc)[2][2][4][2], const Unit& u, int wr, int wc, int fr, int fq) const {
        const int row0 = u.pm * BM + wr * 64 + fr; const int col0 = u.pn * BM + wc * 32 + 8 * fq;
        const bool rot = u.pn < 4; const float sc = (u.pn >= 2 && u.pn < 4) ? 0.08838834764831845f : 1.0f; const int i0 = 4 * (wc * 4 + fq);
#pragma unroll
        for (int ai = 0; ai < 2; ++ai)
#pragma unroll
            for (int m = 0; m < 4; ++m) { const int row = row0 + ai * HALF + m * 16; bf16_t* rowp = O + (size_t)row * 3072 + col0;
                f32x4 c = (f32x4){1.f, 1.f, 1.f, 1.f}, s = (f32x4){0.f, 0.f, 0.f, 0.f};
                if (rot) { const size_t ti = (size_t)(row & 4095) * 64 + i0; c = *(const f32x4*)(COS + ti) * sc; s = *(const f32x4*)(SIN + ti) * sc; }
#pragma unroll
                for (int bj = 0; bj < 2; ++bj) { f32x4 v0 = acc[ai][bj][m][0], v1 = acc[ai][bj][m][1];
                    if (rot) { const f32x4 r1 = v0 * c - v1 * s, r2 = v0 * s + v1 * c; v0 = r1; v1 = r2; }
                    u32x4 w; w.x = cvt_pk_bf16(v0[0], v0[1]); w.y = cvt_pk_bf16(v0[2], v0[3]); w.z = cvt_pk_bf16(v1[0], v1[1]); w.w = cvt_pk_bf16(v1[2], v1[3]);
                    *(u32x4*)(rowp + bj * HALF) = w; } }
    }
};
struct EpiConvGates {
    static constexpr bool PERM = true, AFTER_DRAIN = false;
    bf16_t* CB; bf16_t* UU; bf16_t* GT;
    __device__ __forceinline__ void operator()(const f32x4 (&acc)[2][2][4][2], const Unit& u, int wr, int wc, int fr, int fq) const {
        const int row0 = u.pm * BM + wr * 64 + fr;
        if (u.pn >= 4 && u.pn < 12) {
            const int col0 = (u.pn - 4) * 128 + wc * 32 + 8 * fq;
#pragma unroll
            for (int ai = 0; ai < 2; ++ai)
#pragma unroll
                for (int m = 0; m < 4; ++m) { const f32x4 v0 = acc[ai][0][m][0] * acc[ai][1][m][0], v1 = acc[ai][0][m][1] * acc[ai][1][m][1];
                    u32x4 w; w.x = cvt_pk_bf16(v0[0], v0[1]); w.y = cvt_pk_bf16(v0[2], v0[3]); w.z = cvt_pk_bf16(v1[0], v1[1]); w.w = cvt_pk_bf16(v1[2], v1[3]);
                    *(u32x4*)(UU + (size_t)(row0 + ai * HALF + m * 16) * 1024 + col0) = w; }
        } else if (u.pn >= 12) {
            unsigned char* G8 = (unsigned char*)GT; const int col0 = (u.pn - 12) * BM + wc * 32 + 8 * fq;
#pragma unroll
            for (int ai = 0; ai < 2; ++ai)
#pragma unroll
                for (int m = 0; m < 4; ++m) { unsigned char* rowp = G8 + (size_t)(row0 + ai * HALF + m * 16) * 2048 + col0;
#pragma unroll
                    for (int bj = 0; bj < 2; ++bj) { const f32x4 v0 = acc[ai][bj][m][0], v1 = acc[ai][bj][m][1];
                        unsigned q[8];
#pragma unroll
                        for (int z = 0; z < 4; ++z) { q[z] = (unsigned)(sigmoidf_(v0[z]) * 255.0f + 0.5f); q[4 + z] = (unsigned)(sigmoidf_(v1[z]) * 255.0f + 0.5f); }
                        u32x2 w; w.x = q[0] | (q[1] << 8) | (q[2] << 16) | (q[3] << 24); w.y = q[4] | (q[5] << 8) | (q[6] << 16) | (q[7] << 24);
                        *(u32x2*)(rowp + bj * HALF) = w; } }
        } else {
            bf16_t* O = CB; const int ldc = 1024; const int col0 = u.pn * BM + wc * 32 + 8 * fq;
#pragma unroll
            for (int ai = 0; ai < 2; ++ai)
#pragma unroll
                for (int m = 0; m < 4; ++m) { bf16_t* rowp = O + (size_t)(row0 + ai * HALF + m * 16) * ldc + col0;
#pragma unroll
                    for (int bj = 0; bj < 2; ++bj) { const f32x4 v0 = acc[ai][bj][m][0], v1 = acc[ai][bj][m][1];
                        u32x4 w; w.x = cvt_pk_bf16(v0[0], v0[1]); w.y = cvt_pk_bf16(v0[2], v0[3]); w.z = cvt_pk_bf16(v1[0], v1[1]); w.w = cvt_pk_bf16(v1[2], v1[3]);
                        *(u32x4*)(rowp + bj * HALF) = w; } }
        }
    }
};
struct EpiResBf16SS {
    static constexpr bool PERM = true, AFTER_DRAIN = false;
    const float* base; bf16_t* O; float* SS; int ldc;
    __device__ __forceinline__ void operator()(const f32x4 (&acc)[2][2][4][2], const Unit& u, int wr, int wc, int fr, int fq) const {
        const int row0 = u.pm * BM + wr * 64 + fr; const int col0 = u.pn * BM + wc * 32 + 8 * fq;
#pragma unroll
        for (int ai = 0; ai < 2; ++ai) {
            f32x4 pre[4][2][2];
#pragma unroll
            for (int m = 0; m < 4; ++m)
#pragma unroll
                for (int bj = 0; bj < 2; ++bj) { const size_t o = (size_t)(row0 + ai * HALF + m * 16) * ldc + col0 + bj * HALF; pre[m][bj][0] = *(const f32x4*)(base + o); pre[m][bj][1] = *(const f32x4*)(base + o + 4); }
            asm volatile("" ::: "memory");
#pragma unroll
            for (int m = 0; m < 4; ++m) { const size_t r = (size_t)(row0 + ai * HALF + m * 16); float ssq = 0.f;
#pragma unroll
                for (int bj = 0; bj < 2; ++bj) { const size_t o = r * ldc + col0 + bj * HALF;
                    const f32x4 h0 = pre[m][bj][0] + acc[ai][bj][m][0], h1 = pre[m][bj][1] + acc[ai][bj][m][1];
                    ssq += (h0[0] * h0[0] + h0[1] * h0[1]) + (h0[2] * h0[2] + h0[3] * h0[3]) + (h1[0] * h1[0] + h1[1] * h1[1]) + (h1[2] * h1[2] + h1[3] * h1[3]);
                    u32x4 w; w.x = cvt_pk_bf16(h0[0], h0[1]); w.y = cvt_pk_bf16(h0[2], h0[3]); w.z = cvt_pk_bf16(h1[0], h1[1]); w.w = cvt_pk_bf16(h1[2], h1[3]);
                    *(u32x4*)(O + o) = w; }
                ssq += __shfl_xor(ssq, 16); ssq += __shfl_xor(ssq, 32);
                if (fq == 0) SS[r * 16 + u.pn * 4 + wc] = ssq; }
        }
    }
};
struct EpiPleBf16SS {
    static constexpr bool PERM = true, AFTER_DRAIN = false;
    const bf16_t* H; const bf16_t* P; bf16_t* O; const float* RS; float* SS; int ldc;
    __device__ __forceinline__ void operator()(const f32x4 (&acc)[2][2][4][2], const Unit& u, int wr, int wc, int fr, int fq) const {
        const int row0 = u.pm * BM + wr * 64 + fr; const int col0 = u.pn * BM + wc * 32 + 8 * fq;
#pragma unroll
        for (int ai = 0; ai < 2; ++ai) {
            float rsv[4];
#pragma unroll
            for (int m = 0; m < 4; ++m) { const size_t r = (size_t)(row0 + ai * HALF + m * 16); rsv[m] = RS[r]; }
            asm volatile("" : "+v"(rsv[0]), "+v"(rsv[1]), "+v"(rsv[2]), "+v"(rsv[3]) :: "memory");
            u32x4 hpre[4][2], ppre[4][2];
#pragma unroll
            for (int m = 0; m < 4; ++m) { const size_t r = (size_t)(row0 + ai * HALF + m * 16);
#pragma unroll
                for (int bj = 0; bj < 2; ++bj) { const size_t o = r * ldc + col0 + bj * HALF; hpre[m][bj] = *(const u32x4*)(H + o); ppre[m][bj] = *(const u32x4*)(P + o); } }
            asm volatile("" ::: "memory");
#pragma unroll
            for (int m = 0; m < 4; ++m) { const size_t r = (size_t)(row0 + ai * HALF + m * 16); float ssq = 0.f; const float rs = rsv[m];
#pragma unroll
                for (int bj = 0; bj < 2; ++bj) { const size_t o = r * ldc + col0 + bj * HALF;
                    const u32x4 hw = hpre[m][bj], pw = ppre[m][bj]; const f32x4 a0 = acc[ai][bj][m][0], a1 = acc[ai][bj][m][1];
                    float h[8];
                    h[0] = bf_lo(hw.x) + sigmoidf_(rs * a0[0]) * bf_lo(pw.x); h[1] = bf_hi(hw.x) + sigmoidf_(rs * a0[1]) * bf_hi(pw.x);
                    h[2] = bf_lo(hw.y) + sigmoidf_(rs * a0[2]) * bf_lo(pw.y); h[3] = bf_hi(hw.y) + sigmoidf_(rs * a0[3]) * bf_hi(pw.y);
                    h[4] = bf_lo(hw.z) + sigmoidf_(rs * a1[0]) * bf_lo(pw.z); h[5] = bf_hi(hw.z) + sigmoidf_(rs * a1[1]) * bf_hi(pw.z);
                    h[6] = bf_lo(hw.w) + sigmoidf_(rs * a1[2]) * bf_lo(pw.w); h[7] = bf_hi(hw.w) + sigmoidf_(rs * a1[3]) * bf_hi(pw.w);
#pragma unroll
                    for (int z = 0; z < 8; ++z) ssq += h[z] * h[z];
                    u32x4 w; w.x = cvt_pk_bf16(h[0], h[1]); w.y = cvt_pk_bf16(h[2], h[3]); w.z = cvt_pk_bf16(h[4], h[5]); w.w = cvt_pk_bf16(h[6], h[7]);
                    *(u32x4*)(O + o) = w; }
                ssq += __shfl_xor(ssq, 16); ssq += __shfl_xor(ssq, 32);
                if (fq == 0) SS[r * 16 + u.pn * 4 + wc] = ssq; }
        }
    }
};
struct EpiPle {
    static constexpr bool PERM = false, AFTER_DRAIN = false;
    const float* base; float* out; const bf16_t* P; int ldc;
    __device__ __forceinline__ void operator()(const f32x4 (&acc)[2][2][4][2], const Unit& u, int wr, int wc, int fr, int fq) const {
        const int row0 = u.pm * BM + wr * 64 + fr; const int col0 = u.pn * BM + wc * 32 + 4 * fq;
#pragma unroll
        for (int ai = 0; ai < 2; ++ai)
#pragma unroll
            for (int m = 0; m < 4; ++m) { const size_t off = (size_t)(row0 + ai * HALF + m * 16) * ldc + col0;
#pragma unroll
                for (int bj = 0; bj < 2; ++bj)
#pragma unroll
                    for (int n = 0; n < 2; ++n) { const size_t o = off + bj * HALF + n * 16; const f32x4 b = *(const f32x4*)(base + o); const u32x2 p = *(const u32x2*)(P + o); const f32x4 a = acc[ai][bj][m][n];
                        f32x4 r; r[0] = b[0] + sigmoidf_(a[0]) * bf_lo(p.x); r[1] = b[1] + sigmoidf_(a[1]) * bf_hi(p.x); r[2] = b[2] + sigmoidf_(a[2]) * bf_lo(p.y); r[3] = b[3] + sigmoidf_(a[3]) * bf_hi(p.y);
                        *(f32x4*)(out + o) = r; } }
    }
};

template <class Epi, class Sched, bool ALIGN_EPI>
__device__ __forceinline__ void gemm_phase(PG8_LAS unsigned char* lds, const Gemm g, const Sched& S, const Epi& E) {
    const int tid = threadIdx.x, wid = __builtin_amdgcn_readfirstlane(tid >> 6), lane = tid & 63, wr = wid >> 2, wc = wid & 3, fr = lane & 15, fq = lane >> 4;
    const int K = g.K, nt = K / BK, lda = g.lda;
    unsigned voffA[2], voffB[2];
#pragma unroll
    for (int i = 0; i < 2; ++i) { int R, C; stage_rc(tid * 16 + i * 8192, R, C); const int Rb = Epi::PERM ? ((R & ~31) + perm32(R & 31)) : R;
        voffA[i] = (unsigned)(R * lda + C) * 2u; voffB[i] = (unsigned)(Rb * K + C) * 2u; }
    const size_t kstep = (size_t)(BK * 2);
    const size_t hstepA = (size_t)HALF * lda * 2, hstepB = (size_t)HALF * K * 2;
    const size_t tstepA = 2 * hstepA, tstepB = 2 * hstepB;
    const size_t pnstepA = (size_t)g.a_pn_cols * 2;
    const unsigned ldsw = (unsigned)wid * 1024u;
    const int aoff = lds_byte(wr * 64 + fr, fq * 8), boff = lds_byte(wc * 32 + fr, fq * 8);
#define PG8_SA(b, h) (((b) * 2 + (h)) * HTB)
#define PG8_SB(b, h) ((4 + (b) * 2 + (h)) * HTB)
#define PG8_STAGE(bufoff, gbase, voff) do { _Pragma("unroll") for (int _i = 0; _i < 2; ++_i) \
        __builtin_amdgcn_global_load_lds((const unsigned*)((const char*)(gbase) + (voff)[_i]), (PG8_LAS unsigned*)(lds + (bufoff) + ldsw + _i * 8192), 16, 0, 0); } while (0)
#define PG8_LDA(dst, b, h) do { _Pragma("unroll") for (int m = 0; m < 4; ++m) _Pragma("unroll") for (int k = 0; k < 2; ++k) dst[m][k] = *(const PG8_LAS bf16x8*)(lds + PG8_SA(b, h) + aoff + m * 2048 + k * 1024); } while (0)
#define PG8_LDB(dst, b, h) do { _Pragma("unroll") for (int n = 0; n < 2; ++n) _Pragma("unroll") for (int k = 0; k < 2; ++k) dst[n][k] = *(const PG8_LAS bf16x8*)(lds + PG8_SB(b, h) + boff + n * 2048 + k * 1024); } while (0)
#define PG8_MMA(ai, bj, At, Bt) do { __builtin_amdgcn_s_setprio(1); _Pragma("unroll") for (int m = 0; m < 4; ++m) _Pragma("unroll") for (int n = 0; n < 2; ++n) _Pragma("unroll") for (int k = 0; k < 2; ++k) \
        acc[ai][bj][m][n] = __builtin_amdgcn_mfma_f32_16x16x32_bf16(Bt[n][k], At[m][k], acc[ai][bj][m][n], 0, 0, 0); __builtin_amdgcn_s_setprio(0); } while (0)
#define PG8_WAIT_V(n) asm volatile("s_waitcnt vmcnt(" #n ")" ::: "memory")
#define PG8_WAIT_L(n) asm volatile("s_waitcnt lgkmcnt(" #n ")" ::: "memory")
#define PG8_BAR __builtin_amdgcn_s_barrier()
#define PG8_SCHED __builtin_amdgcn_sched_barrier(0)
    Unit cur, nxt; int ui = 0;
    if (!S.next(0, cur)) return;
    f32x4 acc[2][2][4][2];
#pragma unroll
    for (int a = 0; a < 2; ++a)
#pragma unroll
        for (int b = 0; b < 2; ++b)
#pragma unroll
            for (int m = 0; m < 4; ++m)
#pragma unroll
                for (int n = 0; n < 2; ++n) acc[a][b][m][n] = (f32x4){0.f, 0.f, 0.f, 0.f};
    bf16x8 At[4][2], B0[2][2], B1[2][2];
    const char* cA = (const char*)g.A + (size_t)cur.pm * tstepA + (size_t)cur.pn * pnstepA; const char* cB = (const char*)g.Bt + (size_t)cur.pn * tstepB;
    S.a_ready(cur);
    PG8_STAGE(PG8_SB(0, 0), cB, voffB); PG8_STAGE(PG8_SB(0, 1), cB + hstepB, voffB); PG8_STAGE(PG8_SA(0, 0), cA, voffA); PG8_STAGE(PG8_SA(0, 1), cA + hstepA, voffA);
    if (wr == 1) PG8_BAR;
    PG8_WAIT_V(2); PG8_BAR;
    PG8_STAGE(PG8_SB(1, 0), cB + kstep, voffB); PG8_STAGE(PG8_SA(1, 0), cA + kstep, voffA); PG8_STAGE(PG8_SB(1, 1), cB + hstepB + kstep, voffB);
    PG8_WAIT_V(6); PG8_BAR;
    for (;;) {
        const bool has_next = S.next(ui + 1, nxt);
        const char* nA = has_next ? (const char*)g.A + (size_t)nxt.pm * tstepA + (size_t)nxt.pn * pnstepA : cA; const char* nB = has_next ? (const char*)g.Bt + (size_t)nxt.pn * tstepB : cB;
        for (int t = 0; t < nt; t += 2) {
            const bool last = (t == nt - 2);
            const char* a1 = cA + (size_t)(t + 1) * kstep;
            const char* a2 = last ? nA : cA + (size_t)(t + 2) * kstep; const char* b2 = last ? nB : cB + (size_t)(t + 2) * kstep;
            const char* a3 = a2 + kstep; const char* b3 = b2 + kstep;
            if (last && has_next) S.a_ready(nxt);
            PG8_LDB(B0, 0, 0); PG8_LDB(B1, 0, 1); PG8_SCHED; PG8_LDA(At, 0, 0); PG8_STAGE(PG8_SA(1, 1), a1 + hstepA, voffA);
            PG8_WAIT_V(8); PG8_WAIT_L(0); PG8_BAR; PG8_MMA(0, 0, At, B0); PG8_MMA(0, 1, At, B1); PG8_BAR; PG8_SCHED;
            PG8_LDA(At, 0, 1); PG8_STAGE(PG8_SB(0, 0), b2, voffB); PG8_STAGE(PG8_SB(0, 1), b2 + hstepB, voffB); PG8_STAGE(PG8_SA(0, 0), a2, voffA);
            PG8_WAIT_V(8); PG8_WAIT_L(0); PG8_BAR; PG8_MMA(1, 0, At, B0); PG8_MMA(1, 1, At, B1); PG8_BAR; PG8_SCHED;
            PG8_LDB(B0, 1, 0); PG8_LDB(B1, 1, 1); PG8_SCHED; PG8_LDA(At, 1, 0); PG8_STAGE(PG8_SA(0, 1), a2 + hstepA, voffA);
            PG8_WAIT_V(8); PG8_WAIT_L(0); PG8_BAR; PG8_MMA(0, 0, At, B0); PG8_MMA(0, 1, At, B1); PG8_BAR; PG8_SCHED;
            PG8_LDA(At, 1, 1); PG8_STAGE(PG8_SB(1, 0), b3, voffB); PG8_STAGE(PG8_SB(1, 1), b3 + hstepB, voffB); PG8_STAGE(PG8_SA(1, 0), a3, voffA);
            PG8_WAIT_V(8); PG8_WAIT_L(0); PG8_BAR; PG8_MMA(1, 0, At, B0); PG8_MMA(1, 1, At, B1); PG8_BAR; PG8_SCHED;
        }
        if constexpr (ALIGN_EPI) { if (wr == 0) PG8_BAR; }
        E(acc, cur, wr, wc, fr, fq); S.done(cur);
        if (!has_next) break;
#pragma unroll
        for (int a = 0; a < 2; ++a)
#pragma unroll
            for (int b = 0; b < 2; ++b)
#pragma unroll
                for (int m = 0; m < 4; ++m)
#pragma unroll
                    for (int n = 0; n < 2; ++n) acc[a][b][m][n] = (f32x4){0.f, 0.f, 0.f, 0.f};
        cur = nxt; cA = nA; cB = nB; ++ui;
        if constexpr (ALIGN_EPI) { if (wr == 1) PG8_BAR; }
    }
    PG8_WAIT_V(0);
    if constexpr (!ALIGN_EPI) { if (wr == 0) PG8_BAR; }
    PG8_BAR;
#undef PG8_SA
#undef PG8_SB
#undef PG8_STAGE
#undef PG8_LDA
#undef PG8_LDB
#undef PG8_MMA
#undef PG8_WAIT_V
#undef PG8_WAIT_L
#undef PG8_BAR
#undef PG8_SCHED
}
}

constexpr int NWAVES = 8, NTHREADS = NWAVES * 64;
constexpr int BATCH = 8, SEQ = 4096, D = 1024, T = BATCH * SEQ;
constexpr int RH = 4, RDK = 128, RDV = 256, RC = 128, NCH = SEQ / RC;
constexpr int RQK = RH * RDK, RV = RH * RDV;
constexpr int INW = 8192;
constexpr int PH = 8, PNK = 128, PNE = PNK * PNK, PQD = 256, PHALF = 128, PTOPK = 16, NSEL = PH * PTOPK;
constexpr int PLE = 256;
constexpr float EPS = 1e-6f;
constexpr int NUNITS_R = BATCH * NCH * RH;

constexpr size_t MiB = 1u << 20;
constexpr size_t WS_CTL = 0, CTL_ZERO_BYTES = 64 * 1024;
constexpr size_t WS_COS = 1 * MiB, WS_SIN = 2 * MiB;
constexpr size_t WS_WIN = 3 * MiB;
constexpr size_t WS_WRU = 19 * MiB, WS_WCU = 21 * MiB, WS_WOUT = 23 * MiB;
constexpr size_t WS_WPQ = 25 * MiB;
constexpr size_t WS_WPP = 29 * MiB;
constexpr size_t WS_K1 = 29 * MiB + 512 * 1024, WS_K2 = 29 * MiB + 768 * 1024;
constexpr size_t WS_WPG = 30 * MiB;
constexpr size_t WS_UB = 32 * MiB, WS_VB = 64 * MiB;
constexpr size_t WS_XN = 96 * MiB;
constexpr size_t WS_BIG = 160 * MiB;
constexpr size_t WS_PREV = 352 * MiB;
constexpr size_t WS_ARET = 416 * MiB;
constexpr size_t WS_IDX = 480 * MiB, WS_GATE = 496 * MiB;
constexpr size_t WS_END = 512 * MiB;

constexpr int LDS_BYTES = 160 * 1024;

constexpr int PNE_ROWS = 16384;
typedef unsigned short bf16;
typedef unsigned v4u __attribute__((ext_vector_type(4)));
typedef unsigned v2u __attribute__((ext_vector_type(2)));
typedef float f32x4 __attribute__((ext_vector_type(4)));
#define LAS __attribute__((address_space(3)))

__device__ __forceinline__ unsigned f2bf(float f) { unsigned u = __float_as_uint(f); return (u + 0x7fffu + ((u >> 16) & 1u)) >> 16; }
__device__ __forceinline__ unsigned pk2(float lo, float hi) { return f2bf(lo) | (f2bf(hi) << 16); }
__device__ __forceinline__ float bflo(unsigned w) { return __uint_as_float(w << 16); }
__device__ __forceinline__ float bfhi(unsigned w) { return __uint_as_float(w & 0xffff0000u); }
__device__ __forceinline__ float bf2f(bf16 h) { return __uint_as_float(((unsigned)h) << 16); }
__device__ __forceinline__ float wave_sum(float v) {
#pragma unroll
    for (int o = 1; o < 64; o <<= 1) v += __shfl_xor(v, o);
    return v;
}
__device__ __forceinline__ float wave_max(float v) {
#pragma unroll
    for (int o = 1; o < 64; o <<= 1) v = fmaxf(v, __shfl_xor(v, o));
    return v;
}
__device__ __forceinline__ void unpack8(const v4u w, float* f) { f[0] = bflo(w.x); f[1] = bfhi(w.x); f[2] = bflo(w.y); f[3] = bfhi(w.y); f[4] = bflo(w.z); f[5] = bfhi(w.z); f[6] = bflo(w.w); f[7] = bfhi(w.w); }


typedef float f32x16 __attribute__((ext_vector_type(16)));
typedef short bf16x8v __attribute__((ext_vector_type(8)));
__device__ __forceinline__ unsigned ord_key(float f) { const unsigned u = __float_as_uint(f); return u ^ ((unsigned)((int)u >> 31) | 0x80000000u); }
__device__ __forceinline__ float ord_val(unsigned k) { return __uint_as_float(k ^ (~(unsigned)((int)k >> 31) | 0x80000000u)); }
__device__ __forceinline__ void sort16_desc(unsigned (&x)[16]) {
#pragma unroll
    for (int ks = 1; ks <= 4; ++ks) {
#pragma unroll
        for (int js = ks - 1; js >= 0; --js) {
#pragma unroll
            for (int i = 0; i < 16; ++i) { const int k = 1 << ks, j = 1 << js, l = i ^ j;
                if (l > i) { const unsigned hi = max(x[i], x[l]), lo = min(x[i], x[l]); if ((i & k) == 0) { x[i] = hi; x[l] = lo; } else { x[i] = lo; x[l] = hi; } } }
        }
    }
}
__device__ __forceinline__ void merge16_desc(unsigned (&a)[16], const unsigned (&b)[16]) {
#pragma unroll
    for (int i = 0; i < 16; ++i) a[i] = max(a[i], b[15 - i]);
#pragma unroll
    for (int js = 3; js >= 0; --js) {
#pragma unroll
        for (int i = 0; i < 16; ++i) { const int j = 1 << js, l = i ^ j;
            if (l > i) { const unsigned hi = max(a[i], a[l]), lo = min(a[i], a[l]); a[i] = hi; a[l] = lo; } }
    }
}

__device__ __forceinline__ void peer_half_topk(const bf16* qrow, const bf16* kb, int hg, unsigned (&V)[16]) {
    constexpr int LS = 136;
    bf16x8v qf[8];
#pragma unroll
    for (int ks = 0; ks < 8; ++ks) qf[ks] = *(const bf16x8v*)(qrow + 16 * ks);
    f32x16 acc[4];
#pragma unroll
    for (int b = 0; b < 4; ++b)
#pragma unroll
        for (int z = 0; z < 16; ++z) acc[b][z] = 0.f;
#pragma unroll
    for (int ks = 0; ks < 8; ++ks)
#pragma unroll
        for (int b = 0; b < 4; ++b) { const bf16x8v a = *(const bf16x8v*)(kb + b * 32 * LS + 16 * ks); acc[b] = __builtin_amdgcn_mfma_f32_32x32x16_bf16(a, qf[ks], acc[b], 0, 0, 0); }
    unsigned x0[16], x1[16], x2[16], x3[16];
#pragma unroll
    for (int z = 0; z < 16; ++z) { const int nb = (z & 3) + 8 * (z >> 2) + 4 * hg;
        x0[z] = (ord_key(acc[0][z]) & ~0x7Fu) | (unsigned)(127 - nb);
        x1[z] = (ord_key(acc[1][z]) & ~0x7Fu) | (unsigned)(127 - (32 + nb));
        x2[z] = (ord_key(acc[2][z]) & ~0x7Fu) | (unsigned)(127 - (64 + nb));
        x3[z] = (ord_key(acc[3][z]) & ~0x7Fu) | (unsigned)(127 - (96 + nb)); }
    sort16_desc(x0); sort16_desc(x1); merge16_desc(x0, x1);
    sort16_desc(x2); sort16_desc(x3); merge16_desc(x2, x3);
    merge16_desc(x0, x2);
    unsigned pz[16];
#pragma unroll
    for (int z = 0; z < 16; ++z) { auto rr = __builtin_amdgcn_permlane32_swap(x0[z], x0[z], false, false); pz[z] = hg ? rr[0] : rr[1]; }
    merge16_desc(x0, pz);
#pragma unroll
    for (int z = 0; z < 16; ++z) V[z] = x0[z];
}

typedef short v4i16_t __attribute__((ext_vector_type(4)));
__device__ __forceinline__ v4i16_t ds_tr4(LAS const unsigned char* p) { return __builtin_amdgcn_ds_read_tr16_b64_v4i16((LAS v4i16_t*)p); }
__device__ __forceinline__ bf16x8v cat8(v4i16_t a, v4i16_t b) { return __builtin_shufflevector(a, b, 0, 1, 2, 3, 4, 5, 6, 7); }

__device__ __forceinline__ void sort128_asc(unsigned& k0, unsigned& k1, int lane) {
#pragma unroll
    for (int ks = 1; ks <= 7; ++ks) {
#pragma unroll
        for (int js = ks - 1; js >= 0; --js) {
            const int K = 1 << ks, J = 1 << js;
            if (J == 64) { const unsigned lo = min(k0, k1), hi = max(k0, k1); k0 = lo; k1 = hi; }
            else {
                const bool lower = (lane & J) == 0;
                const bool up0 = (K <= 32) ? ((lane & K) == 0) : true;
                const bool up1 = (K <= 32) ? ((lane & K) == 0) : (K == 128);
                const unsigned o0 = __shfl_xor(k0, J), o1 = __shfl_xor(k1, J);
                k0 = (lower == up0) ? min(k0, o0) : max(k0, o0);
                k1 = (lower == up1) ? min(k1, o1) : max(k1, o1);
            }
        }
    }
}

#define XB_TMO      128
#define XB_XCNT(j)  (256  + 64 * (j))
#define XB_XSUB(j)  (1280 + 64 * (j))
#define XB_XGEN(j)  (2304 + 64 * (j))
#define XB_TOP      3328
#define XB_TOPGEN   3392
#define XCD_BAR_WORDS 3456
#define XB_SPIN_CAP (1u << 20)
__device__ __forceinline__ unsigned xb_ld(unsigned* p)              { return __hip_atomic_load(p, __ATOMIC_RELAXED, __HIP_MEMORY_SCOPE_AGENT); }
__device__ __forceinline__ unsigned xb_add(unsigned* p, unsigned v) { return __hip_atomic_fetch_add(p, v, __ATOMIC_RELAXED, __HIP_MEMORY_SCOPE_AGENT); }
__device__ __forceinline__ unsigned xb_xcc_id() { return (unsigned)__builtin_amdgcn_s_getreg((3 << 11) | 20) & 0xFu; }
#define XB_SPIN(cond, bar) do { unsigned _sp = 0; while (cond) { __builtin_amdgcn_s_sleep(1); \
    if ((++_sp & 255u) == 0u) { if (xb_ld(&(bar)[XB_TMO])) break; if (_sp > XB_SPIN_CAP) { atomicAdd(&(bar)[XB_TMO], 1u); break; } } } } while (0)
struct XcdBarrier { unsigned* bar; unsigned x; volatile LAS unsigned* st; };
__device__ __forceinline__ XcdBarrier xcd_barrier_post(unsigned* bar, volatile LAS unsigned* st) {
    XcdBarrier b; b.bar = bar; b.x = xb_xcc_id(); b.st = st;
    if (threadIdx.x == 0) (void)xb_add(&bar[XB_XCNT(b.x)], 1u);
    return b;
}
__device__ __forceinline__ void xcd_barrier_complete(unsigned* bar, unsigned x, unsigned& nloc, unsigned& nx) {
    const unsigned G = gridDim.x * gridDim.y * gridDim.z;
    unsigned sum, cnt, mine, sp = 0u;
    for (;;) {
        sum = 0u; cnt = 0u; mine = 0u;
#pragma unroll
        for (unsigned j = 0; j < 16; ++j) { const unsigned c = xb_ld(&bar[XB_XCNT(j)]); sum += c; cnt += (c > 0u) ? 1u : 0u; mine = (j == x) ? c : mine; }
        if (sum == G) break;
        __builtin_amdgcn_s_sleep(1);
        if ((++sp & 255u) == 0u) { if (xb_ld(&bar[XB_TMO])) break; if (sp > XB_SPIN_CAP) { atomicAdd(&bar[XB_TMO], 1u); break; } }
    }
    nloc = mine > 0u ? mine : 1u; nx = cnt > 0u ? cnt : 1u;
}
__device__ __forceinline__ void xcd_barrier(const XcdBarrier& b) {
    asm volatile("s_waitcnt vmcnt(0)" ::: "memory");
    __syncthreads();
    if (threadIdx.x == 0) {
        unsigned* bar = b.bar;
        __builtin_amdgcn_s_waitcnt(0);
        unsigned nloc = b.st[0], nx = b.st[1];
        if (nloc == 0u) { xcd_barrier_complete(bar, b.x, nloc, nx); b.st[0] = nloc; b.st[1] = nx; }
        const unsigned old = xb_add(&bar[XB_XSUB(b.x)], 1u);
        const unsigned gen = old / nloc;
        if (old + 1u == (gen + 1u) * nloc) {
            __builtin_amdgcn_fence(__ATOMIC_RELEASE, "agent");
            asm volatile("s_waitcnt vmcnt(0)" ::: "memory");
            const unsigned og = xb_add(&bar[XB_TOP], 1u);
            const unsigned tg = og / nx;
            if (og + 1u == (tg + 1u) * nx) xb_add(&bar[XB_TOPGEN], 1u);
            else XB_SPIN(xb_ld(&bar[XB_TOPGEN]) == tg, bar);
            __builtin_amdgcn_fence(__ATOMIC_ACQUIRE, "agent");
            xb_add(&bar[XB_XGEN(b.x)], 1u);
            asm volatile("s_waitcnt vmcnt(0)" ::: "memory");
        } else {
            XB_SPIN(xb_ld(&bar[XB_XGEN(b.x)]) == gen, bar);
            __builtin_amdgcn_fence(__ATOMIC_ACQUIRE, "agent");
            asm volatile("s_waitcnt vmcnt(0)" ::: "memory");
        }
    }
    __syncthreads();
}

struct Args {
    const float* in[19]; float* out; unsigned char* ws; int ph_lo, ph_hi;
};

struct Frame {
    unsigned char* lds;
    int tid, lane, wave, G, gw, NGW, gt, NGT;
};

__device__ __forceinline__ void p0_transpose_item(const float* W, int K, int N, bf16* WT, float* scr, int item, int lane, const float* gk = nullptr, bool win_remap = false) {
    const int nblk = N / 32, kb = item / nblk, nb = item % nblk, k0 = 64 * kb, n0 = 32 * nb;

#pragma unroll 8
    for (int i = 0; i < 32; ++i) { const int kk = 2 * i + (lane >> 5); scr[kk * 33 + (lane & 31)] = W[(size_t)(k0 + kk) * N + n0 + (lane & 31)] * (gk ? gk[k0 + kk] : 1.0f); }
    asm volatile("s_waitcnt lgkmcnt(0)" ::: "memory");
    const int c = lane & 7;
#pragma unroll
    for (int j = 0; j < 4; ++j) { const int n = (lane >> 3) + 8 * j; const float* s = scr + (8 * c) * 33 + n;
        v4u o; o.x = pk2(s[0 * 33], s[1 * 33]); o.y = pk2(s[2 * 33], s[3 * 33]); o.z = pk2(s[4 * 33], s[5 * 33]); o.w = pk2(s[6 * 33], s[7 * 33]);
        int dn = n0 + n;
        if (win_remap) {
            if (dn < 1024) { const int hc = dn & 127, i = hc & 63; dn = (dn & ~127) + 8 * (i >> 2) + ((hc >> 6) << 2) + (i & 3); }
            else if (dn >= 4096 && dn < 6144) { const int cc = dn - 4096; dn = cc < 1024 ? 4096 + (cc >> 7) * 256 + (cc & 127) : 4096 + ((cc - 1024) >> 7) * 256 + 128 + ((cc - 1024) & 127); } }
        *(v4u*)(WT + (size_t)dn * K + k0 + 8 * c) = o; }
    asm volatile("s_waitcnt lgkmcnt(0)" ::: "memory");
}
__device__ __forceinline__ void cvt_f32_bf16(const Frame& F, const float* src, bf16* dst, size_t count) {
    const size_t n4 = count / 4, st = (size_t)F.NGT;
    size_t i = F.gt;
    for (; i + 3 * st < n4; i += 4 * st) { f32x4 v[4];
#pragma unroll
        for (int q = 0; q < 4; ++q) v[q] = ((const f32x4*)src)[i + q * st];
#pragma unroll
        for (int q = 0; q < 4; ++q) { v2u o; o.x = pk2(v[q][0], v[q][1]); o.y = pk2(v[q][2], v[q][3]); ((v2u*)dst)[i + q * st] = o; } }
    for (; i < n4; i += st) { const f32x4 v = ((const f32x4*)src)[i]; v2u o; o.x = pk2(v[0], v[1]); o.y = pk2(v[2], v[3]); ((v2u*)dst)[i] = o; }
}
__device__ __forceinline__ void rms_row_to_bf16(const float* xrow, const float* g, bf16* orow, int lane) {
    const f32x4* xr = (const f32x4*)xrow + lane; const f32x4* gr = (const f32x4*)g + lane;
    f32x4 v[4]; float s = 0.f;
#pragma unroll
    for (int j = 0; j < 4; ++j) { v[j] = xr[64 * j]; s += (v[j][0] * v[j][0] + v[j][1] * v[j][1]) + (v[j][2] * v[j][2] + v[j][3] * v[j][3]); }
    const float rs = 1.0f / sqrtf(wave_sum(s) * (1.f / D) + EPS);
    unsigned long long* o8 = (unsigned long long*)orow + lane;
#pragma unroll
    for (int j = 0; j < 4; ++j) { const f32x4 gg = gr[64 * j]; o8[64 * j] = (unsigned long long)pk2(v[j][0] * rs * gg[0], v[j][1] * rs * gg[1]) | ((unsigned long long)pk2(v[j][2] * rs * gg[2], v[j][3] * rs * gg[3]) << 32); }
}


__device__ __forceinline__ void quant_row_fp8(const float* srow, unsigned char* drow, float* inv_scale, int lane, const float* gcol = nullptr) {
    const f32x4* xr = (const f32x4*)srow + lane;
    f32x4 v[4]; float am = 0.f;
#pragma unroll
    for (int j = 0; j < 4; ++j) { v[j] = xr[64 * j]; if (gcol) v[j] = v[j] * ((const f32x4*)gcol + lane)[64 * j]; am = fmaxf(am, fmaxf(fmaxf(fabsf(v[j][0]), fabsf(v[j][1])), fmaxf(fabsf(v[j][2]), fabsf(v[j][3])))); }
    am = wave_max(am);
    int k = 0;
    if (am > 0.f) { k = (int)floorf(log2f(224.0f / am)); k = k < -100 ? -100 : (k > 100 ? 100 : k); }
    const float sc = ldexpf(1.0f, k), isc = ldexpf(1.0f, -k);
    v4u o;
    { int w = __builtin_amdgcn_cvt_pk_fp8_f32(v[0][0] * sc, v[0][1] * sc, 0, false); w = __builtin_amdgcn_cvt_pk_fp8_f32(v[0][2] * sc, v[0][3] * sc, w, true); o.x = (unsigned)w; }
    { int w = __builtin_amdgcn_cvt_pk_fp8_f32(v[1][0] * sc, v[1][1] * sc, 0, false); w = __builtin_amdgcn_cvt_pk_fp8_f32(v[1][2] * sc, v[1][3] * sc, w, true); o.y = (unsigned)w; }
    { int w = __builtin_amdgcn_cvt_pk_fp8_f32(v[2][0] * sc, v[2][1] * sc, 0, false); w = __builtin_amdgcn_cvt_pk_fp8_f32(v[2][2] * sc, v[2][3] * sc, w, true); o.z = (unsigned)w; }
    { int w = __builtin_amdgcn_cvt_pk_fp8_f32(v[3][0] * sc, v[3][1] * sc, 0, false); w = __builtin_amdgcn_cvt_pk_fp8_f32(v[3][2] * sc, v[3][3] * sc, w, true); o.w = (unsigned)w; }
    *((v4u*)drow + lane) = o;
    if (lane == 0) *inv_scale = isc;
}
__device__ __forceinline__ void quant_row_fp8_cp(const float* srow, unsigned char* tab, int e, float* inv_scale, int lane, const float* gcol = nullptr) {
    const f32x4* xr = (const f32x4*)(srow + 16 * lane);
    f32x4 v[4]; float am = 0.f;
#pragma unroll
    for (int q = 0; q < 4; ++q) { v[q] = xr[q]; if (gcol) v[q] = v[q] * ((const f32x4*)(gcol + 16 * lane))[q]; am = fmaxf(am, fmaxf(fmaxf(fabsf(v[q][0]), fabsf(v[q][1])), fmaxf(fabsf(v[q][2]), fabsf(v[q][3])))); }
    am = wave_max(am);
    int k = 0;
    if (am > 0.f) { k = (int)floorf(log2f(224.0f / am)); k = k < -100 ? -100 : (k > 100 ? 100 : k); }
    const float sc = ldexpf(1.0f, k), isc = ldexpf(1.0f, -k);
    v4u o;
    { int w = __builtin_amdgcn_cvt_pk_fp8_f32(v[0][0] * sc, v[0][1] * sc, 0, false); w = __builtin_amdgcn_cvt_pk_fp8_f32(v[0][2] * sc, v[0][3] * sc, w, true); o.x = (unsigned)w; }
    { int w = __builtin_amdgcn_cvt_pk_fp8_f32(v[1][0] * sc, v[1][1] * sc, 0, false); w = __builtin_amdgcn_cvt_pk_fp8_f32(v[1][2] * sc, v[1][3] * sc, w, true); o.y = (unsigned)w; }
    { int w = __builtin_amdgcn_cvt_pk_fp8_f32(v[2][0] * sc, v[2][1] * sc, 0, false); w = __builtin_amdgcn_cvt_pk_fp8_f32(v[2][2] * sc, v[2][3] * sc, w, true); o.z = (unsigned)w; }
    { int w = __builtin_amdgcn_cvt_pk_fp8_f32(v[3][0] * sc, v[3][1] * sc, 0, false); w = __builtin_amdgcn_cvt_pk_fp8_f32(v[3][2] * sc, v[3][3] * sc, w, true); o.w = (unsigned)w; }
    *(v4u*)(tab + ((size_t)(lane >> 3) * PNE_ROWS + e) * 128 + (lane & 7) * 16) = o;
    if (lane == 0) *inv_scale = isc;
}
__device__ __forceinline__ void quant_row_i8_cp_fin(f32x4 (&v)[4], unsigned char* tab, int e, float* inv_scale, int lane, const float* gcol) {
    float am = 0.f;
#pragma unroll
    for (int q = 0; q < 4; ++q) { if (gcol) v[q] = v[q] * ((const f32x4*)(gcol + 16 * lane))[q]; am = fmaxf(am, fmaxf(fmaxf(fabsf(v[q][0]), fabsf(v[q][1])), fmaxf(fabsf(v[q][2]), fabsf(v[q][3])))); }
    am = wave_max(am);
    const float sc = am > 0.f ? 127.0f / am : 0.f;
    unsigned w[4];
#pragma unroll
    for (int q = 0; q < 4; ++q) { const int q0 = (int)rintf(v[q][0] * sc), q1 = (int)rintf(v[q][1] * sc), q2 = (int)rintf(v[q][2] * sc), q3 = (int)rintf(v[q][3] * sc);
        w[q] = (unsigned)(q0 & 0xff) | ((unsigned)(q1 & 0xff) << 8) | ((unsigned)(q2 & 0xff) << 16) | ((unsigned)(q3 & 0xff) << 24); }
    *(v4u*)(tab + ((size_t)(lane >> 3) * PNE_ROWS + e) * 128 + (lane & 7) * 16) = (v4u){w[0], w[1], w[2], w[3]};
    if (lane == 0) *inv_scale = am * (1.0f / 127.0f);
}
__device__ __forceinline__ void quant_row_i8_slices(f32x4 (&v)[4], unsigned char* tab, int e, float* inv_scale, int lane) {
    float am = 0.f;
#pragma unroll
    for (int q = 0; q < 4; ++q) am = fmaxf(am, fmaxf(fmaxf(fabsf(v[q][0]), fabsf(v[q][1])), fmaxf(fabsf(v[q][2]), fabsf(v[q][3]))));
    am = wave_max(am);
    const float sc = am > 0.f ? 127.0f / am : 0.f;
    unsigned w[4];
#pragma unroll
    for (int q = 0; q < 4; ++q) { const int q0 = (int)rintf(v[q][0] * sc), q1 = (int)rintf(v[q][1] * sc), q2 = (int)rintf(v[q][2] * sc), q3 = (int)rintf(v[q][3] * sc);
        w[q] = (unsigned)(q0 & 0xff) | ((unsigned)(q1 & 0xff) << 8) | ((unsigned)(q2 & 0xff) << 16) | ((unsigned)(q3 & 0xff) << 24); }
    *(v2u*)(tab + ((size_t)(2 * lane) * PNE_ROWS + e) * 8) = (v2u){w[0], w[1]};
    *(v2u*)(tab + ((size_t)(2 * lane + 1) * PNE_ROWS + e) * 8) = (v2u){w[2], w[3]};
    if (lane == 0) *inv_scale = am * (1.0f / 127.0f);
}
typedef float f32x2 __attribute__((ext_vector_type(2)));
typedef unsigned v4u_raw __attribute__((__vector_size__(16)));
typedef unsigned v2u_raw __attribute__((__vector_size__(8)));
__device__ __forceinline__ void fp8x16_to_f32(const v4u w, float* f) {
    f32x2 t;
    t = __builtin_amdgcn_cvt_pk_f32_fp8((int)w.x, false); f[0] = t.x; f[1] = t.y; t = __builtin_amdgcn_cvt_pk_f32_fp8((int)w.x, true); f[2] = t.x; f[3] = t.y;
    t = __builtin_amdgcn_cvt_pk_f32_fp8((int)w.y, false); f[4] = t.x; f[5] = t.y; t = __builtin_amdgcn_cvt_pk_f32_fp8((int)w.y, true); f[6] = t.x; f[7] = t.y;
    t = __builtin_amdgcn_cvt_pk_f32_fp8((int)w.z, false); f[8] = t.x; f[9] = t.y; t = __builtin_amdgcn_cvt_pk_f32_fp8((int)w.z, true); f[10] = t.x; f[11] = t.y;
    t = __builtin_amdgcn_cvt_pk_f32_fp8((int)w.w, false); f[12] = t.x; f[13] = t.y; t = __builtin_amdgcn_cvt_pk_f32_fp8((int)w.w, true); f[14] = t.x; f[15] = t.y;
}

__device__ __forceinline__ float gelu_f(float v) {
    const float av = fabsf(v), t = __builtin_amdgcn_rcpf(av * 0.2316418882f + 1.0f);
    float q = t * 0.5307027145f + (-0.7265760135f); q = q * t + 0.7107068705f; q = q * t + (-0.142248368f); q = q * t + 0.127414796f; q = q * t;
    const float e = __builtin_amdgcn_exp2f((v * v) * (-0.72134752044f));
    const float m = v * (q * e);
    return v < 0.f ? m : v - m;
}
__device__ __forceinline__ float gamma_of(int h) { return 1.0f - exp2f(-5.0f - (float)h); }

__global__ void __launch_bounds__(NTHREADS, 2) mega(Args args) {
    extern __shared__ __attribute__((aligned(16))) unsigned char lds[];
    Frame F;
    F.lds = lds; F.tid = threadIdx.x; F.lane = F.tid & 63; F.wave = __builtin_amdgcn_readfirstlane(F.tid >> 6);
    F.G = gridDim.x; F.gw = blockIdx.x * NWAVES + F.wave; F.NGW = F.G * NWAVES; F.gt = blockIdx.x * NTHREADS + F.tid; F.NGT = F.G * NTHREADS;
    unsigned char* ws = args.ws;
    const float* x = args.in[0]; const float* p = args.in[1]; const float* g_mix = args.in[2]; const float* w_in = args.in[3];
    const float* conv_w = args.in[4]; const float* conv_b = args.in[5]; const float* w_ret_up = args.in[6]; const float* w_conv_up = args.in[7];
    const float* w_out = args.in[8]; const float* g_ffn = args.in[9]; const float* w_peer_q = args.in[10]; const float* peer_k1 = args.in[11];
    const float* peer_k2 = args.in[12]; const float* peer_u = args.in[13]; const float* peer_v = args.in[14]; const float* g_ple = args.in[15];
    const float* w_ple_proj = args.in[16]; const float* w_ple_gate = args.in[17]; const float* g_final = args.in[18];
    float* out = args.out;
    float* COS = (float*)(ws + WS_COS); float* SIN = (float*)(ws + WS_SIN);
    bf16* WIN = (bf16*)(ws + WS_WIN); bf16* WRU = (bf16*)(ws + WS_WRU); bf16* WCU = (bf16*)(ws + WS_WCU); bf16* WOUT = (bf16*)(ws + WS_WOUT);
    bf16* WPQ = (bf16*)(ws + WS_WPQ); bf16* WPP = (bf16*)(ws + WS_WPP); bf16* K1 = (bf16*)(ws + WS_K1); bf16* K2 = (bf16*)(ws + WS_K2); bf16* WPG = (bf16*)(ws + WS_WPG);
    unsigned char* U8 = ws + WS_UB; unsigned char* V8 = ws + WS_VB;
    float* SU = (float*)(ws + 128 * 1024); float* SV = (float*)(ws + 256 * 1024);
    float* SS2 = (float*)(ws + 80 * MiB);
    float* RS2 = (float*)(ws + 512 * 1024);
    unsigned* KK = (unsigned*)(ws + WS_BIG + 64 * MiB);
    float* SSP = (float*)(ws + WS_BIG + 80 * MiB);
    float* WSC = (float*)(ws + 82 * MiB);
    unsigned* WCNT = (unsigned*)(ws + 32 * 1024);
    float* PACT = (float*)(ws + WS_PREV);
    float* SS1 = (float*)(ws + WS_COS);
    float* SS3 = (float*)(ws + WS_IDX);
    bf16* XN = (bf16*)(ws + WS_XN); bf16* BIG = (bf16*)(ws + WS_BIG); bf16* PREV = (bf16*)(ws + WS_PREV); bf16* ARET = (bf16*)(ws + WS_ARET);
    int* IDX = (int*)(ws + WS_IDX); float* GATE = (float*)(ws + WS_GATE);
    bf16* CB = BIG;
    bf16* UU = BIG + (size_t)T * 1024;
    bf16* ACONV = CB;
    bf16* GATES = BIG + (size_t)T * 2048;
    bf16* M1 = UU;
    bf16* HB = XN;
    bf16* PB = (bf16*)(ws + 48 * MiB);
    bf16* QP = PREV;
    bf16* PLEB = BIG;
    bf16* H3B = BIG + (size_t)T * 1024;
    PG8_LAS unsigned char* ldsl = (PG8_LAS unsigned char*)lds;

    const int lo = args.ph_lo, hi = args.ph_hi;
#if MK_ONE_LAUNCH
    cg::grid_group grid = cg::this_grid();
    volatile LAS unsigned* lctl = (volatile LAS unsigned*)((LAS unsigned char*)lds + LDS_BYTES - 64);
    if (F.tid < 16) lctl[F.tid] = 0u;
    __syncthreads();
    const XcdBarrier xbar = xcd_barrier_post((unsigned*)(ws + WS_CTL), lctl);
#define SEAM(k) do { if ((k) + 1 < hi) { if ((k) == 0) grid.sync(); else xcd_barrier(xbar); } } while (0)
#else
#define SEAM(k) do { } while (0)
#endif
#define IN(k) (lo <= (k) && (k) < hi)

    if (IN(0)) {
        float* scr = (float*)(lds + F.wave * 16384);
        constexpr int I_IN = (D / 64) * (INW / 32), I_SQ = (D / 64) * (D / 32), I_PQ = (D / 64) * (2048 / 32), I_PP = (PLE / 64) * (D / 32);
        constexpr int NITEMS = I_IN + 4 * I_SQ + I_PQ + I_PP;
        for (int it = F.gw; it < NITEMS; it += F.NGW) {
            int r = it;
            if (r < I_IN) { p0_transpose_item(w_in, D, INW, WIN, scr, r, F.lane, nullptr, true); continue; } r -= I_IN;
            if (r < I_SQ) { p0_transpose_item(w_ret_up, D, D, WRU, scr, r, F.lane); continue; } r -= I_SQ;
            if (r < I_SQ) { p0_transpose_item(w_conv_up, D, D, WCU, scr, r, F.lane); continue; } r -= I_SQ;
            if (r < I_SQ) { p0_transpose_item(w_out, D, D, WOUT, scr, r, F.lane); continue; } r -= I_SQ;
            if (r < I_SQ) { p0_transpose_item(w_ple_gate, D, D, WPG, scr, r, F.lane, g_ple); continue; } r -= I_SQ;
            if (r < I_PQ) { p0_transpose_item(w_peer_q, D, 2048, WPQ, scr, r, F.lane, g_ffn); continue; } r -= I_PQ;
            p0_transpose_item(w_ple_proj, PLE, D, WPP, scr, r, F.lane);
        }
        cvt_f32_bf16(F, p, PB, (size_t)T * PLE);
        cvt_f32_bf16(F, peer_k1, K1, (size_t)PH * PNK * PHALF);
        cvt_f32_bf16(F, peer_k2, K2, (size_t)PH * PNK * PHALF);
        for (int r = F.gw; r < PNE; r += F.NGW) {
            f32x4 vu[4], vv[4];
#pragma unroll
            for (int q = 0; q < 4; ++q) { vu[q] = ((const f32x4*)(peer_u + (size_t)r * D + 16 * F.lane))[q]; vv[q] = ((const f32x4*)(peer_v + (size_t)r * D + 16 * F.lane))[q]; }
            quant_row_i8_cp_fin(vu, U8, r, SU + r, F.lane, g_ffn);
            quant_row_i8_slices(vv, V8, r, SV + r, F.lane);
        }
        for (int e = F.gt; e < SEQ * 64; e += F.NGT) { const int s = e >> 6, i = e & 63; const double inv = pow(10000.0, -(double)i / 64.0); const double ang = (double)s * inv; COS[e] = (float)cos(ang); SIN[e] = (float)sin(ang); }
        {
            const f32x4* gr = (const f32x4*)g_mix + F.lane; f32x4 gg[4];
#pragma unroll
            for (int j = 0; j < 4; ++j) gg[j] = gr[64 * j];
            for (int m = F.gw; m < T / 2; m += F.NGW) {
                const int ma = m, mb = m + T / 2;
                const f32x4* xa_ = (const f32x4*)(x + (size_t)ma * D) + F.lane; const f32x4* xb_ = (const f32x4*)(x + (size_t)mb * D) + F.lane;
                f32x4 va[4], vb[4]; float sa = 0.f, sb = 0.f;
#pragma unroll
                for (int j = 0; j < 4; ++j) { va[j] = xa_[64 * j]; vb[j] = xb_[64 * j]; }
#pragma unroll
                for (int j = 0; j < 4; ++j) { sa += (va[j][0] * va[j][0] + va[j][1] * va[j][1]) + (va[j][2] * va[j][2] + va[j][3] * va[j][3]); sb += (vb[j][0] * vb[j][0] + vb[j][1] * vb[j][1]) + (vb[j][2] * vb[j][2] + vb[j][3] * vb[j][3]); }
                const float ra = 1.0f / sqrtf(wave_sum(sa) * (1.f / D) + EPS), rb = 1.0f / sqrtf(wave_sum(sb) * (1.f / D) + EPS);
                unsigned long long* oa = (unsigned long long*)(XN + (size_t)ma * D) + F.lane; unsigned long long* ob = (unsigned long long*)(XN + (size_t)mb * D) + F.lane;
#pragma unroll
                for (int j = 0; j < 4; ++j) {
                    oa[64 * j] = (unsigned long long)pk2(va[j][0] * ra * gg[j][0], va[j][1] * ra * gg[j][1]) | ((unsigned long long)pk2(va[j][2] * ra * gg[j][2], va[j][3] * ra * gg[j][3]) << 32);
                    ob[64 * j] = (unsigned long long)pk2(vb[j][0] * rb * gg[j][0], vb[j][1] * rb * gg[j][1]) | ((unsigned long long)pk2(vb[j][2] * rb * gg[j][2], vb[j][3] * rb * gg[j][3]) << 32); }
            }
        }
        SEAM(0);
    }

    if (IN(1)) {
        pg8::Gemm g{XN, WIN, T, 3072, D, D, 0}; pg8::StaticOrder S; S.init(T, 3072, F.G, (int)blockIdx.x);
        pg8::EpiQKVG E{BIG, COS, SIN};
        pg8::gemm_phase<pg8::EpiQKVG, pg8::StaticOrder, true>(ldsl, g, S, E);
        SEAM(1);
    }

    if (IN(2)) {
        constexpr int KS = 160, VS = 288;
        bf16* kt = (bf16*)lds;
        bf16* vt = kt + 128 * KS;
        LAS const unsigned char* kt3 = (LAS const unsigned char*)lds; LAS const unsigned char* vt3 = kt3 + 128 * KS * 2;
        const int r32 = F.lane & 31, hg = F.lane >> 5, wm = F.wave >> 2, wn = F.wave & 3;
        const int tq = (F.lane & 15) >> 2, tp = F.lane & 3, tcs = (F.lane >> 4) & 1;
        for (int u = blockIdx.x; u < NUNITS_R; u += F.G) {
            const int h = u & 3, n = (u >> 2) & 31, b = u >> 7; const size_t t0 = (size_t)b * SEQ + (size_t)n * RC;
            const float lg = logf(gamma_of(h));
            __syncthreads();
            for (int c = F.tid; c < 128 * 16; c += NTHREADS) { const int j = c >> 4, c8 = c & 15;
                float f[8]; unpack8(*(const v4u*)(BIG + (t0 + j) * 3072 + RQK + h * RDK + c8 * 8), f);
                const float zeta = __expf(lg * (float)(RC - 1 - j));
                v4u z1; z1.x = pk2(f[0] * zeta, f[1] * zeta); z1.y = pk2(f[2] * zeta, f[3] * zeta); z1.z = pk2(f[4] * zeta, f[5] * zeta); z1.w = pk2(f[6] * zeta, f[7] * zeta);
                *(v4u*)(kt + j * KS + c8 * 8) = z1; }
            for (int c = F.tid; c < 128 * 32; c += NTHREADS) { const int j = c >> 5, c8 = c & 31;
                *(v4u*)(vt + j * VS + c8 * 8) = *(const v4u*)(BIG + (t0 + j) * 3072 + 2 * RQK + h * RDV + c8 * 8); }
            __syncthreads();
            f32x16 acc[2][2];
#pragma unroll
            for (int bm = 0; bm < 2; ++bm)
#pragma unroll
                for (int bn = 0; bn < 2; ++bn)
#pragma unroll
                    for (int z = 0; z < 16; ++z) acc[bm][bn][z] = 0.f;
#pragma unroll
            for (int ks = 0; ks < 8; ++ks) {
                bf16x8v af[2], bfr[2];
#pragma unroll
                for (int q = 0; q < 2; ++q) {
                    LAS const unsigned char* ka = kt3 + ((16 * ks + 8 * hg + tq) * KS + 64 * wm + 32 * q + 16 * tcs + 4 * tp) * 2;
                    LAS const unsigned char* va = vt3 + ((16 * ks + 8 * hg + tq) * VS + 64 * wn + 32 * q + 16 * tcs + 4 * tp) * 2;
                    af[q] = cat8(ds_tr4(ka), ds_tr4(ka + 4 * KS * 2)); bfr[q] = cat8(ds_tr4(va), ds_tr4(va + 4 * VS * 2)); }
#pragma unroll
                for (int bm = 0; bm < 2; ++bm)
#pragma unroll
                    for (int bn = 0; bn < 2; ++bn) acc[bm][bn] = __builtin_amdgcn_mfma_f32_32x32x16_bf16(af[bm], bfr[bn], acc[bm][bn], 0, 0, 0);
            }
#pragma unroll
            for (int bm = 0; bm < 2; ++bm)
#pragma unroll
                for (int bn = 0; bn < 2; ++bn) { const int e = 64 * wn + 32 * bn + r32;
#pragma unroll
                    for (int g = 0; g < 4; ++g) { const int d0 = 64 * wm + 32 * bm + 8 * g + 4 * hg; v2u o; o.x = pk2(acc[bm][bn][4 * g], acc[bm][bn][4 * g + 1]); o.y = pk2(acc[bm][bn][4 * g + 2], acc[bm][bn][4 * g + 3]);
                        *(v2u*)(PREV + ((size_t)u * 256 + e) * 128 + d0) = o; } }
        }
        SEAM(2);
    }

    if (IN(3)) {
        for (int c = F.gt; c < BATCH * RH * 128 * 32; c += F.NGT) {
            const int e8 = c & 31, d = (c >> 5) & 127, h = (c >> 12) & 3, b = c >> 14;
            const float cd = powf(gamma_of(h), (float)RC);
            float st[8];
#pragma unroll
            for (int q = 0; q < 8; ++q) st[q] = 0.f;
            for (int n = 0; n < NCH; ++n) {
                const int u = b * 128 + n * 4 + h; v4u* ptr = (v4u*)(PREV + ((size_t)u * 128 + d) * 256 + e8 * 8);
                const v4u w = *ptr; float f[8]; unpack8(w, f);
                v4u o; o.x = pk2(st[0], st[1]); o.y = pk2(st[2], st[3]); o.z = pk2(st[4], st[5]); o.w = pk2(st[6], st[7]); *ptr = o;
#pragma unroll
                for (int q = 0; q < 8; ++q) st[q] = st[q] * cd + f[q];
            }
        }
        SEAM(3);
    }

    if (IN(4)) {
        constexpr int LS = 136;
        bf16* ksN = (bf16*)lds;
        constexpr int VS = 288;
        bf16* vt = ksN + 128 * LS;
        LAS const unsigned char* vt3 = (LAS const unsigned char*)lds + 128 * LS * 2;
        float* stx = (float*)(vt + 128 * VS);
        const int tq = (F.lane & 15) >> 2, tp = F.lane & 3, tcs = (F.lane >> 4) & 1;
        const int r32 = F.lane & 31, hg = F.lane >> 5, iw = F.wave & 3, eh = F.wave >> 2;
        const int i = 32 * iw + r32;
        for (int u = blockIdx.x; u < NUNITS_R; u += F.G) {
            const int h = u & 3, n = (u >> 2) & 31, b = u >> 7; const size_t t0 = (size_t)b * SEQ + (size_t)n * RC;
            const float lg = logf(gamma_of(h));
            __syncthreads();
            bf16* pt = vt;
            for (int c = F.tid; c < 128 * 16; c += NTHREADS) { const int j = c >> 4, c8 = c & 15;
                *(v4u*)(ksN + j * LS + c8 * 8) = *(const v4u*)(BIG + (t0 + j) * 3072 + RQK + h * RDK + c8 * 8); }
            for (int c = F.tid; c < 256 * 16; c += NTHREADS) { const int e_ = c >> 4, c8 = c & 15;
                *(v4u*)(pt + e_ * LS + c8 * 8) = *(const v4u*)(PREV + ((size_t)u * 256 + e_) * 128 + c8 * 8); }
            bf16x8v qf[8];
            { const bf16* qrow = BIG + (t0 + i) * 3072 + h * RDK + 8 * hg;
#pragma unroll
              for (int ks = 0; ks < 8; ++ks) qf[ks] = *(const bf16x8v*)(qrow + 16 * ks); }
            v4u vst[8];
#pragma unroll
            for (int q = 0; q < 8; ++q) { const int c = F.tid + q * NTHREADS, j = c >> 5, c8 = c & 31; vst[q] = *(const v4u*)(BIG + (t0 + j) * 3072 + 2 * RQK + h * RDV + c8 * 8); }
            f32x16 acc[4];
#pragma unroll
            for (int eb = 0; eb < 4; ++eb)
#pragma unroll
                for (int z = 0; z < 16; ++z) acc[eb][z] = 0.f;
            __syncthreads();
            {
                const bf16* pp = pt + (128 * eh + r32) * LS + 8 * hg;
#pragma unroll
                for (int ks = 0; ks < 8; ++ks)
#pragma unroll
                    for (int eb = 0; eb < 4; ++eb) { const bf16x8v a = *(const bf16x8v*)(pp + (32 * eb) * LS + 16 * ks); acc[eb] = __builtin_amdgcn_mfma_f32_32x32x16_bf16(a, qf[ks], acc[eb], 0, 0, 0); }
                const float xi = __expf(lg * (float)(i + 1));
#pragma unroll
                for (int eb = 0; eb < 4; ++eb)
#pragma unroll
                    for (int z = 0; z < 16; ++z) acc[eb][z] *= xi;
            }
            __syncthreads();
#pragma unroll
            for (int q = 0; q < 8; ++q) { const int c = F.tid + q * NTHREADS, j = c >> 5, c8 = c & 31; *(v4u*)(vt + j * VS + c8 * 8) = vst[q]; }
            __syncthreads();
#pragma unroll 1
            for (int jb = 0; jb <= iw; ++jb) {
                f32x16 X;
#pragma unroll
                for (int z = 0; z < 16; ++z) X[z] = 0.f;
#pragma unroll
                for (int ks = 0; ks < 8; ++ks) { const bf16x8v a = *(const bf16x8v*)(ksN + (32 * jb + r32) * LS + 16 * ks + 8 * hg); X = __builtin_amdgcn_mfma_f32_32x32x16_bf16(a, qf[ks], X, 0, 0, 0); }
#pragma unroll
                for (int z = 0; z < 16; ++z) { const int j = 32 * jb + (z & 3) + 8 * (z >> 2) + 4 * hg; const int df = i - j; X[z] = df >= 0 ? X[z] * __expf(lg * (float)df) : 0.f; }
#pragma unroll
                for (int s2 = 0; s2 < 2; ++s2) {
                    v4u pw; pw.x = pk2(X[8 * s2 + 0], X[8 * s2 + 1]); pw.y = pk2(X[8 * s2 + 2], X[8 * s2 + 3]); pw.z = pk2(X[8 * s2 + 4], X[8 * s2 + 5]); pw.w = pk2(X[8 * s2 + 6], X[8 * s2 + 7]);
                    const bf16x8v pf = __builtin_bit_cast(bf16x8v, pw);
#pragma unroll
                    for (int eb = 0; eb < 4; ++eb) {
                        LAS const unsigned char* va = vt3 + ((32 * jb + 16 * s2 + 4 * hg + tq) * VS + 128 * eh + 32 * eb + 16 * tcs + 4 * tp) * 2;
                        acc[eb] = __builtin_amdgcn_mfma_f32_32x32x16_bf16(cat8(ds_tr4(va), ds_tr4(va + 8 * VS * 2)), pf, acc[eb], 0, 0, 0); }
                }
            }
            float s1 = 0.f, s2 = 0.f;
#pragma unroll
            for (int eb = 0; eb < 4; ++eb)
#pragma unroll
                for (int z = 0; z < 16; ++z) { const float v = acc[eb][z]; s1 += v; s2 += v * v; }
            { auto r1 = __builtin_amdgcn_permlane32_swap(__float_as_uint(s1), __float_as_uint(s1), false, false); s1 = __uint_as_float(r1[0]) + __uint_as_float(r1[1]);
              auto r2 = __builtin_amdgcn_permlane32_swap(__float_as_uint(s2), __float_as_uint(s2), false, false); s2 = __uint_as_float(r2[0]) + __uint_as_float(r2[1]); }
            if (hg == 0) { stx[(eh * 128 + i) * 2] = s1; stx[(eh * 128 + i) * 2 + 1] = s2; }
            __syncthreads();
            { const float o1 = stx[((eh ^ 1) * 128 + i) * 2], o2 = stx[((eh ^ 1) * 128 + i) * 2 + 1]; s1 += o1; s2 += o2; }
            const float mu = s1 * (1.f / 256.f); const float var = fmaxf(s2 * (1.f / 256.f) - mu * mu, 0.f); const float rstd = 1.0f / sqrtf(var + EPS);
            {
                constexpr int YS = 264;
                bf16* ys = vt;
#pragma unroll
                for (int eb = 0; eb < 4; ++eb)
#pragma unroll
                    for (int g = 0; g < 4; ++g) { const int ec = 128 * eh + 32 * eb + 8 * g + 4 * hg;
                        v2u o; o.x = pk2((acc[eb][4 * g] - mu) * rstd, (acc[eb][4 * g + 1] - mu) * rstd); o.y = pk2((acc[eb][4 * g + 2] - mu) * rstd, (acc[eb][4 * g + 3] - mu) * rstd);
                        *(v2u*)(ys + i * YS + ec) = o; }
                __syncthreads();
#pragma unroll
                for (int q = 0; q < 8; ++q) { const int c = F.tid + q * NTHREADS, tkn = c >> 5, c8 = c & 31;
                    float yf[8], gf[8]; unpack8(*(const v4u*)(ys + tkn * YS + c8 * 8), yf); unpack8(*(const v4u*)(BIG + (t0 + tkn) * 3072 + 2 * RQK + RV + h * RDV + c8 * 8), gf);
                    float o[8];
#pragma unroll
                    for (int z = 0; z < 8; ++z) o[z] = yf[z] * gf[z] / (1.0f + __expf(-gf[z]));
                    v4u w; w.x = pk2(o[0], o[1]); w.y = pk2(o[2], o[3]); w.z = pk2(o[4], o[5]); w.w = pk2(o[6], o[7]);
                    *(v4u*)(ARET + (t0 + tkn) * 1024 + h * RDV + c8 * 8) = w; }
            }
        }
        SEAM(4);
    }

    if (IN(5)) {
        pg8::Gemm g{XN, WIN + (size_t)3072 * D, T, 5120, D, D, 0}; pg8::StaticOrder S; S.init(T, 5120, F.G, (int)blockIdx.x);
        pg8::EpiConvGates E{CB, UU, GATES};
        pg8::gemm_phase<pg8::EpiConvGates, pg8::StaticOrder, true>(ldsl, g, S, E);
        SEAM(5);
    }

    if (IN(6)) {
        for (int it = F.gt; it < (T / 8) * 128; it += F.NGT) {
            const int c8 = it & 127, t0 = (it >> 7) * 8, s0 = t0 & (SEQ - 1); const int col = c8 * 8;
            v4u uw[10], cw[8];
#pragma unroll
            for (int r = 0; r < 8; ++r) { uw[r + 2] = *(const v4u*)(UU + (size_t)(t0 + r) * 1024 + col); cw[r] = *(const v4u*)(CB + (size_t)(t0 + r) * 1024 + col); }
            if (s0 != 0) { uw[0] = *(const v4u*)(UU + (size_t)(t0 - 2) * 1024 + col); uw[1] = *(const v4u*)(UU + (size_t)(t0 - 1) * 1024 + col); }
            else { uw[0] = (v4u){0u, 0u, 0u, 0u}; uw[1] = (v4u){0u, 0u, 0u, 0u}; }
            float w0[8], w1[8], w2[8], bs[8];
            *(f32x4*)w0 = *(const f32x4*)(conv_w + col); *(f32x4*)(w0 + 4) = *(const f32x4*)(conv_w + col + 4);
            *(f32x4*)w1 = *(const f32x4*)(conv_w + 1024 + col); *(f32x4*)(w1 + 4) = *(const f32x4*)(conv_w + 1024 + col + 4);
            *(f32x4*)w2 = *(const f32x4*)(conv_w + 2048 + col); *(f32x4*)(w2 + 4) = *(const f32x4*)(conv_w + 2048 + col + 4);
            *(f32x4*)bs = *(const f32x4*)(conv_b + col); *(f32x4*)(bs + 4) = *(const f32x4*)(conv_b + col + 4);
            float ua[8], ub[8], uc[8];
            unpack8(uw[0], ua); unpack8(uw[1], ub);
#pragma unroll
            for (int r = 0; r < 8; ++r) {
                float cb[8], o[8]; unpack8(uw[r + 2], uc); unpack8(cw[r], cb);
#pragma unroll
                for (int z = 0; z < 8; ++z) { o[z] = cb[z] * (w0[z] * ua[z] + w1[z] * ub[z] + w2[z] * uc[z] + bs[z]); ua[z] = ub[z]; ub[z] = uc[z]; }
                v4u w; w.x = pk2(o[0], o[1]); w.y = pk2(o[2], o[3]); w.z = pk2(o[4], o[5]); w.w = pk2(o[6], o[7]);
                *(v4u*)(ACONV + (size_t)(t0 + r) * 1024 + col) = w;
            }
        }
        SEAM(6);
    }


    if (IN(8)) {
        pg8::StaticOrder S; S.init(T, D, F.G, (int)blockIdx.x);
        { pg8::Gemm g{ARET, WRU, T, D, D, D, 0}; pg8::EpiGate<false> E{M1, D, GATES, 2048, 0};
          pg8::gemm_phase<pg8::EpiGate<false>, pg8::StaticOrder, true>(ldsl, g, S, E); }
        asm volatile("s_waitcnt vmcnt(0)" ::: "memory"); __syncthreads();
        { pg8::Gemm g{ACONV, WCU, T, D, D, D, 0}; pg8::EpiGate<true> E{M1, D, GATES, 2048, 1024};
          pg8::gemm_phase<pg8::EpiGate<true>, pg8::StaticOrder, true>(ldsl, g, S, E); }
        SEAM(8);
    }

    if (IN(9)) {
        pg8::Gemm g{M1, WOUT, T, D, D, D, 0}; pg8::StaticOrder S; S.init(T, D, F.G, (int)blockIdx.x);
        pg8::EpiResBf16SS E{x, HB, SS1, D};
        pg8::gemm_phase<pg8::EpiResBf16SS, pg8::StaticOrder, true>(ldsl, g, S, E);
        SEAM(9);
    }


    if (IN(11)) {
        { pg8::Gemm g{HB, WPQ, T, 2048, D, D, 0}; pg8::StaticOrder S; S.init(T, 2048, F.G, (int)blockIdx.x);
          pg8::EpiBf16 E{QP, 2048};
          pg8::gemm_phase<pg8::EpiBf16, pg8::StaticOrder, true>(ldsl, g, S, E); }
        { pg8::Gemm g{PB, WPP, T, D, PLE, PLE, 0}; pg8::StaticOrder S; S.init(T, D, F.G, (int)blockIdx.x);
          pg8::EpiBf16 E{PLEB, D};
          pg8::gemm_phase<pg8::EpiBf16, pg8::StaticOrder, true>(ldsl, g, S, E); }
        SEAM(11);
    }

    if (IN(12)) {
        constexpr int LS = 136;
        bf16* k1s = (bf16*)lds; bf16* k2s = k1s + 128 * LS;
        const int h = blockIdx.x & 7;
        __syncthreads();
        for (int c = F.tid; c < 128 * 16; c += NTHREADS) { const int j = c >> 4, c8 = c & 15;
            *(v4u*)(k1s + j * LS + c8 * 8) = *(const v4u*)(K1 + ((size_t)h * 128 + j) * 128 + c8 * 8);
            *(v4u*)(k2s + j * LS + c8 * 8) = *(const v4u*)(K2 + ((size_t)h * 128 + j) * 128 + c8 * 8); }
        __syncthreads();
        const int r32 = F.lane & 31, hg = F.lane >> 5;
        const int nwv = (F.G >> 3) * NWAVES;
        for (int tt = (blockIdx.x >> 3) * NWAVES + F.wave; tt < T / 32; tt += nwv) {
            const int t0 = tt * 32;
            unsigned V1[16], V2[16];
            peer_half_topk(QP + (size_t)(t0 + r32) * 2048 + h * 256 + 8 * hg, k1s + r32 * 136 + 8 * hg, hg, V1);
            __builtin_amdgcn_sched_barrier(0);
            peer_half_topk(QP + (size_t)(t0 + r32) * 2048 + h * 256 + 128 + 8 * hg, k2s + r32 * 136 + 8 * hg, hg, V2);
            __builtin_amdgcn_sched_barrier(0);
            float v1[16], v2[16];
#pragma unroll
            for (int z = 0; z < 16; ++z) { v1[z] = ord_val(V1[z] & ~0x7Fu); v2[z] = ord_val(V2[z] & ~0x7Fu); }
#define CKEY(a, b) ((ord_key(v1[a] + v2[b]) & ~0xFFu) | (unsigned)(255 - ((a) * 16 + (b))))
            unsigned g0[16], g1[16], g2[16], g3[16];
#pragma unroll
            for (int b = 0; b < 16; ++b) g0[b] = CKEY(0, b);
#pragma unroll
            for (int b = 0; b < 8; ++b) g1[b] = CKEY(1, b);
#pragma unroll
            for (int b = 0; b < 5; ++b) g1[8 + b] = CKEY(2, b);
#pragma unroll
            for (int b = 0; b < 3; ++b) g1[13 + b] = CKEY(3, b);
            g2[0] = CKEY(3, 3);
#pragma unroll
            for (int b = 0; b < 3; ++b) g2[1 + b] = CKEY(4, b);
#pragma unroll
            for (int b = 0; b < 2; ++b) { g2[4 + b] = CKEY(5, b); g2[6 + b] = CKEY(6, b); g2[8 + b] = CKEY(7, b); }
#pragma unroll
            for (int a = 8; a < 14; ++a) g2[10 + (a - 8)] = CKEY(a, 0);
            { const unsigned c14 = CKEY(14, 0), c15 = CKEY(15, 0); g3[0] = max(c14, c15); g3[1] = min(c14, c15); }
#pragma unroll
            for (int z = 2; z < 16; ++z) g3[z] = 0u;
#undef CKEY
            sort16_desc(g1); sort16_desc(g2); merge16_desc(g1, g2); merge16_desc(g1, g3); merge16_desc(g0, g1);
            float ts[16], ex[16]; float den = 0.f;
            float rs1;
            { const f32x4* sp = (const f32x4*)(SS1 + (size_t)(t0 + r32) * 16); const f32x4 s0 = sp[0], s1 = sp[1], s2 = sp[2], s3 = sp[3];
              const float ssum = ((s0[0] + s0[1]) + (s0[2] + s0[3])) + ((s1[0] + s1[1]) + (s1[2] + s1[3])) + ((s2[0] + s2[1]) + (s2[2] + s2[3])) + ((s3[0] + s3[1]) + (s3[2] + s3[3]));
              rs1 = 1.0f / sqrtf(ssum * (1.f / D) + EPS); }
#pragma unroll
            for (int z = 0; z < 16; ++z) ts[z] = ord_val(g0[z] & ~0xFFu) * rs1;
#pragma unroll
            for (int z = 0; z < 16; ++z) { ex[z] = __expf(ts[z] - ts[0]); den += ex[z]; }
            const float inv = 1.0f / den;
            int oi[8]; float og[8];
#pragma unroll
            for (int rr = 0; rr < 8; ++rr) {
                unsigned klo = g0[rr], khi = g0[8 + rr]; float elo = ex[rr], ehi = ex[8 + rr];
                asm volatile("" : "+v"(klo), "+v"(khi), "+v"(elo), "+v"(ehi));
                const unsigned key = hg ? khi : klo; const int c = 255 - (int)(key & 0xFFu); const int a = c >> 4, b = c & 15;
                unsigned ka = V1[0], kb2 = V2[0];
#pragma unroll
                for (int z = 1; z < 16; ++z) { ka = (a == z) ? V1[z] : ka; kb2 = (b == z) ? V2[z] : kb2; }
                oi[rr] = (127 - (int)(ka & 0x7Fu)) * PNK + (127 - (int)(kb2 & 0x7Fu));
                og[rr] = (hg ? ehi : elo) * inv;
            }
            int* ip = IDX + (size_t)(t0 + r32) * NSEL + h * PTOPK + 8 * hg; float* gp = GATE + (size_t)(t0 + r32) * NSEL + h * PTOPK + 8 * hg;
            *(v4u*)ip = (v4u){(unsigned)oi[0], (unsigned)oi[1], (unsigned)oi[2], (unsigned)oi[3]}; *(v4u*)(ip + 4) = (v4u){(unsigned)oi[4], (unsigned)oi[5], (unsigned)oi[6], (unsigned)oi[7]};
            *(f32x4*)gp = (f32x4){og[0], og[1], og[2], og[3]}; *(f32x4*)(gp + 4) = (f32x4){og[4], og[5], og[6], og[7]};
        }
        SEAM(12);
    }

    if (IN(13)) {
        volatile int* item_w = (volatile int*)(lds + 1024);
        const int s8 = F.lane & 7, r8 = F.lane >> 3; const int xcc = (int)(xb_xcc_id() & 7u);
        for (;;) {
            __syncthreads();
            if (F.tid == 0) { int it = -1;
                for (int k = 0; k < 8 && it < 0; ++k) { const int jj = (xcc + k) & 7; const unsigned cc = __hip_atomic_fetch_add(WCNT + jj, 1u, __ATOMIC_RELAXED, __HIP_MEMORY_SCOPE_AGENT); if (cc < (unsigned)(T / 64)) it = (jj << 16) | (int)cc; }
                item_w[0] = it; }
            __syncthreads();
            const int item = item_w[0];
            if (item < 0) break;
            const int j = item >> 16, ch = item & 0xffff;
            const unsigned char* tabj = U8 + (size_t)j * PNE_ROWS * 128 + s8 * 16;
            const int tb = ch * 64 + F.wave * 8;
            int ida[8], idb[8]; v4u xa[8], xb[8];
#pragma unroll
            for (int tt = 0; tt < 8; ++tt) { ida[tt] = IDX[(size_t)(tb + tt) * NSEL + F.lane]; idb[tt] = IDX[(size_t)(tb + tt) * NSEL + 64 + F.lane];
                const bf16* xp = HB + (size_t)(tb + tt) * D + 128 * j + 16 * s8; xa[tt] = *(const v4u*)xp; xb[tt] = *(const v4u*)(xp + 8); }
            v4u rowsA[8], rowsB[8];
#define P13_ROWS(buf, tt, hh) do { _Pragma("unroll") for (int g = 0; g < 8; ++g) { const int id = __shfl((hh) ? idb[tt] : ida[tt], 8 * g + r8); buf[g] = *(const v4u*)(tabj + (size_t)id * 128); } } while (0)
#define P13_DOT(buf, hh, xq, sx, pp) do { \
                _Pragma("unroll") for (int g = 0; g < 8; ++g) { int d_ = __builtin_amdgcn_sdot4((int)buf[g].x, xq[0], 0, false); d_ = __builtin_amdgcn_sdot4((int)buf[g].y, xq[1], d_, false); \
                    d_ = __builtin_amdgcn_sdot4((int)buf[g].z, xq[2], d_, false); d_ = __builtin_amdgcn_sdot4((int)buf[g].w, xq[3], d_, false); \
                    pp[8 * (hh) + g] = (float)d_ * sx; } } while (0)
            const bool b4_ = (s8 & 4) != 0, b2_ = (s8 & 2) != 0, b1_ = (s8 & 1) != 0;
            P13_ROWS(rowsA, 0, 0);
#pragma unroll
            for (int tt = 0; tt < 8; ++tt) {
                float xf[16]; unpack8(xa[tt], xf); unpack8(xb[tt], xf + 8); float pp[16];
                P13_ROWS(rowsB, tt, 1);
                float am = 0.f;
#pragma unroll
                for (int z = 0; z < 16; ++z) am = fmaxf(am, fabsf(xf[z]));
                am = fmaxf(am, __shfl_xor(am, 1)); am = fmaxf(am, __shfl_xor(am, 2)); am = fmaxf(am, __shfl_xor(am, 4));
                const float qs = am > 0.f ? 127.0f / am : 0.f, sx = am * (1.0f / 127.0f);
                int xq[4];
#pragma unroll
                for (int q = 0; q < 4; ++q) { const int q0 = (int)rintf(xf[4 * q] * qs), q1 = (int)rintf(xf[4 * q + 1] * qs), q2 = (int)rintf(xf[4 * q + 2] * qs), q3 = (int)rintf(xf[4 * q + 3] * qs);
                    xq[q] = (int)((unsigned)(q0 & 0xff) | ((unsigned)(q1 & 0xff) << 8) | ((unsigned)(q2 & 0xff) << 16) | ((unsigned)(q3 & 0xff) << 24)); }
                P13_DOT(rowsA, 0, xq, sx, pp); __builtin_amdgcn_sched_barrier(0);
                if (tt < 7) P13_ROWS(rowsA, tt + 1, 0);
                P13_DOT(rowsB, 1, xq, sx, pp);
                float a8[8], a4[4], a2[2];
#pragma unroll
                for (int g = 0; g < 8; ++g) { const float keep = b4_ ? pp[g + 8] : pp[g], give = b4_ ? pp[g] : pp[g + 8]; a8[g] = keep + __shfl_xor(give, 4); }
#pragma unroll
                for (int g = 0; g < 4; ++g) { const float keep = b2_ ? a8[g + 4] : a8[g], give = b2_ ? a8[g] : a8[g + 4]; a4[g] = keep + __shfl_xor(give, 2); }
#pragma unroll
                for (int g = 0; g < 2; ++g) { const float keep = b1_ ? a4[g + 2] : a4[g], give = b1_ ? a4[g] : a4[g + 2]; a2[g] = keep + __shfl_xor(give, 1); }
                float* pa = PACT + ((size_t)j * T + (tb + tt)) * NSEL + 16 * s8 + r8; pa[0] = a2[0]; pa[8] = a2[1];
                __builtin_amdgcn_sched_barrier(0);
            }
#undef P13_ROWS
#undef P13_DOT
        }
        SEAM(13);
    }

    if (IN(14)) {
        unsigned* tl = (unsigned*)lds;
        for (int ch = blockIdx.x; ch < T / 64; ch += F.G) {
            __syncthreads();
#pragma unroll 1
            for (int tt = 0; tt < 8; ++tt) {
                const int tloc = F.wave * 8 + tt, t = ch * 64 + tloc;
                float ssum = 0.f;
                if (F.lane < 16) ssum = SS1[(size_t)t * 16 + F.lane];
                ssum = wave_sum(ssum);
                const float rs1 = 1.0f / sqrtf(ssum * (1.f / D) + EPS);
                float a0 = 0.f, a1 = 0.f;
#pragma unroll
                for (int j = 0; j < 8; ++j) { const float* pa = PACT + ((size_t)j * T + t) * NSEL + F.lane; a0 += pa[0]; a1 += pa[64]; }
                const int id0 = IDX[(size_t)t * NSEL + F.lane], id1 = IDX[(size_t)t * NSEL + 64 + F.lane];
                const float g0 = GATE[(size_t)t * NSEL + F.lane], g1 = GATE[(size_t)t * NSEL + 64 + F.lane];
                const float w0 = g0 * gelu_f(a0 * rs1 * SU[id0]) * SV[id0], w1 = g1 * gelu_f(a1 * rs1 * SU[id1]) * SV[id1];
                const float am = wave_max(fmaxf(fabsf(w0), fabsf(w1))); const float qs = am > 0.f ? 127.0f / am : 0.f;
                tl[F.lane * 65 + tloc] = ((unsigned)id0 << 11) | ((unsigned)((int)rintf(w0 * qs)) & 0xffu);
                tl[(64 + F.lane) * 65 + tloc] = ((unsigned)id1 << 11) | ((unsigned)((int)rintf(w1 * qs)) & 0xffu);
                if (F.lane == 0) WSC[t] = am * (1.0f / 127.0f);
            }
            __syncthreads();
#pragma unroll
            for (int q = 0; q < 16; ++q) { const int c = F.tid + q * NTHREADS, e_ = c >> 6, tl_ = c & 63; KK[(size_t)e_ * T + ch * 64 + tl_] = tl[e_ * 65 + tl_]; }
        }
        SEAM(14);
    }

    if (IN(7)) {
        LAS const unsigned char* vl3 = (LAS const unsigned char*)lds;
        const __amdgpu_buffer_rsrc_t rsK = __builtin_amdgcn_make_buffer_rsrc((void*)KK, 0, NSEL * T * 4, 0x00020000);
        for (int work = blockIdx.x; work < 256; work += F.G) {
            const int sl = work >> 1, tbase = (work & 1) * (T / 2);
            __syncthreads();
            for (int c = F.tid; c < PNE_ROWS * 8 / 16; c += NTHREADS) *((v4u*)lds + c) = *((const v4u*)(V8 + (size_t)sl * PNE_ROWS * 8) + c);
            __syncthreads();
#pragma unroll 1
            for (int grp = F.wave; grp < T / 2 / 64; grp += NWAVES) {
                const int t = tbase + grp * 64 + F.lane;
                const int kvo = t * 4;
                int acci[8];
#pragma unroll
                for (int z = 0; z < 8; ++z) acci[z] = 0;
                unsigned kc[2][32];
#pragma unroll
                for (int q = 0; q < 32; ++q) kc[0][q] = __builtin_amdgcn_raw_buffer_load_b32(rsK, kvo, q * (T * 4), 0);
#pragma unroll
                for (int ck = 0; ck < 4; ++ck) {
                    if (ck < 3) {
#pragma unroll
                        for (int q = 0; q < 32; ++q) kc[(ck + 1) & 1][q] = __builtin_amdgcn_raw_buffer_load_b32(rsK, kvo, (32 * (ck + 1) + q) * (T * 4), 0);
                    }
#pragma unroll
                    for (int e8 = 0; e8 < 4; ++e8) {
                        v2u vr[8];
#pragma unroll
                        for (int q = 0; q < 8; ++q) vr[q] = *(const LAS v2u*)(vl3 + (kc[ck & 1][8 * e8 + q] >> 8));
#pragma unroll
                        for (int g4 = 0; g4 < 2; ++g4) {
                            const unsigned k0 = kc[ck & 1][8 * e8 + 4 * g4], k1 = kc[ck & 1][8 * e8 + 4 * g4 + 1], k2 = kc[ck & 1][8 * e8 + 4 * g4 + 2], k3 = kc[ck & 1][8 * e8 + 4 * g4 + 3];
                            const unsigned w01_ = __builtin_amdgcn_perm(k1, k0, 0x0c0c0400u), w23_ = __builtin_amdgcn_perm(k3, k2, 0x0c0c0400u); const int w4_ = (int)__builtin_amdgcn_perm(w23_, w01_, 0x05040100u);
#pragma unroll
                            for (int c4 = 0; c4 < 2; ++c4) { const unsigned a_ = vr[4 * g4][c4], b_ = vr[4 * g4 + 1][c4], c_ = vr[4 * g4 + 2][c4], d_ = vr[4 * g4 + 3][c4];
                                const unsigned t0_ = __builtin_amdgcn_perm(b_, a_, 0x05010400u), t1_ = __builtin_amdgcn_perm(b_, a_, 0x07030602u), t2_ = __builtin_amdgcn_perm(d_, c_, 0x05010400u), t3_ = __builtin_amdgcn_perm(d_, c_, 0x07030602u);
                                acci[4 * c4 + 0] = __builtin_amdgcn_sdot4((int)__builtin_amdgcn_perm(t2_, t0_, 0x05040100u), w4_, acci[4 * c4 + 0], false);
                                acci[4 * c4 + 1] = __builtin_amdgcn_sdot4((int)__builtin_amdgcn_perm(t2_, t0_, 0x07060302u), w4_, acci[4 * c4 + 1], false);
                                acci[4 * c4 + 2] = __builtin_amdgcn_sdot4((int)__builtin_amdgcn_perm(t3_, t1_, 0x05040100u), w4_, acci[4 * c4 + 2], false);
                                acci[4 * c4 + 3] = __builtin_amdgcn_sdot4((int)__builtin_amdgcn_perm(t3_, t1_, 0x07060302u), w4_, acci[4 * c4 + 3], false); }
                        }
                    }
                }
                const float wsc = WSC[t];
                v4u* hp = (v4u*)(HB + (size_t)t * D + 8 * sl);
                float hf[8]; unpack8(*hp, hf);
                float ssq = 0.f;
#pragma unroll
                for (int z = 0; z < 8; ++z) { hf[z] += (float)acci[z] * wsc; ssq += hf[z] * hf[z]; }
                v4u o; o.x = pk2(hf[0], hf[1]); o.y = pk2(hf[2], hf[3]); o.z = pk2(hf[4], hf[5]); o.w = pk2(hf[6], hf[7]);
                *hp = o;
                SSP[(size_t)sl * T + t] = ssq;
            }
        }
        SEAM(7);
    }

    if (IN(10)) {
        for (int t = F.gt; t < T; t += F.NGT) { float s_ = 0.f;
#pragma unroll 16
            for (int sl = 0; sl < 128; ++sl) s_ += SSP[(size_t)sl * T + t];
            RS2[t] = 1.0f / sqrtf(s_ * (1.f / D) + EPS); }
        SEAM(10);
    }


    if (IN(15)) {
        pg8::Gemm g{HB, WPG, T, D, D, D, 0}; pg8::StaticOrder S; S.init(T, D, F.G, (int)blockIdx.x);
        pg8::EpiPleBf16SS E{HB, PLEB, H3B, RS2, SS3, D};
        pg8::gemm_phase<pg8::EpiPleBf16SS, pg8::StaticOrder, true>(ldsl, g, S, E);
        SEAM(15);
    }

    if (IN(16)) {
        const f32x4* gr = (const f32x4*)g_final + F.lane;
        f32x4 gg[4];
#pragma unroll
        for (int j = 0; j < 4; ++j) gg[j] = gr[64 * j];
        for (int m = F.gw; m < T / 2; m += F.NGW) {
            const int ma = m, mb = m + T / 2;
            float sa = 0.f, sb = 0.f;
            if (F.lane < 16) { sa = SS3[(size_t)ma * 16 + F.lane]; sb = SS3[(size_t)mb * 16 + F.lane]; }
            const v2u* ha = (const v2u*)(H3B + (size_t)ma * D) + F.lane; const v2u* hb = (const v2u*)(H3B + (size_t)mb * D) + F.lane;
            v2u wa[4], wb[4];
#pragma unroll
            for (int j = 0; j < 4; ++j) { wa[j] = ha[64 * j]; wb[j] = hb[64 * j]; }
            sa = wave_sum(sa); sb = wave_sum(sb);
            const float ra = 1.0f / sqrtf(sa * (1.f / D) + EPS), rb = 1.0f / sqrtf(sb * (1.f / D) + EPS);
            f32x4* oa = (f32x4*)(out + (size_t)ma * D) + F.lane; f32x4* ob = (f32x4*)(out + (size_t)mb * D) + F.lane;
#pragma unroll
            for (int j = 0; j < 4; ++j) {
                oa[64 * j] = (f32x4){bflo(wa[j].x) * ra * gg[j][0], bfhi(wa[j].x) * ra * gg[j][1], bflo(wa[j].y) * ra * gg[j][2], bfhi(wa[j].y) * ra * gg[j][3]};
                ob[64 * j] = (f32x4){bflo(wb[j].x) * rb * gg[j][0], bfhi(wb[j].x) * rb * gg[j][1], bflo(wb[j].y) * rb * gg[j][2], bfhi(wb[j].y) * rb * gg[j][3]}; }
        }
    }
#undef IN
#undef SEAM
}

constexpr int N_PHASES = 17;

extern "C" void kernel_launch(void* const* d_in, const int* in_sizes, int n_in, void* d_out, int out_size, void* d_ws, size_t ws_size, hipStream_t stream) {
    static int grid = 0;
    if (grid == 0) {
        if (n_in != 19 || out_size != T * D || ws_size < WS_END) { fprintf(stderr, "kernel_launch: unexpected shapes: n_in %d out %d ws %zu\n", n_in, out_size, ws_size); grid = -1; return; }
        int dev = 0, cus = 0, per_cu = 0;
        hipGetDevice(&dev); hipDeviceGetAttribute(&cus, hipDeviceAttributeMultiprocessorCount, dev);
        if (hipFuncSetAttribute((const void*)mega, hipFuncAttributeMaxDynamicSharedMemorySize, LDS_BYTES) != hipSuccess) { fprintf(stderr, "kernel_launch: hipFuncSetAttribute failed\n"); grid = -1; return; }
        if (hipOccupancyMaxActiveBlocksPerMultiprocessor(&per_cu, (const void*)mega, NTHREADS, LDS_BYTES) != hipSuccess || per_cu < 1) { fprintf(stderr, "kernel_launch: occupancy query says %d\n", per_cu); per_cu = 1; }
        (void)hipGetLastError();
        grid = cus;
        if (grid % 8 != 0) fprintf(stderr, "kernel_launch: grid %d not a multiple of 8\n", grid);
    }
    if (grid < 0) return;
    Args a{};
    for (int i = 0; i < 19; ++i) a.in[i] = (const float*)d_in[i];
    a.out = (float*)d_out; a.ws = (unsigned char*)d_ws;
#if MK_ONE_LAUNCH
    a.ph_lo = 0; a.ph_hi = N_PHASES;
    if (hipMemsetAsync((char*)d_ws + WS_CTL, 0, CTL_ZERO_BYTES, stream) != hipSuccess) { fprintf(stderr, "kernel_launch: memset failed\n"); return; }
    void* kargs[] = {&a};
    hipError_t e = hipLaunchCooperativeKernel((const void*)mega, dim3(grid), dim3(NTHREADS), kargs, LDS_BYTES, stream);
    if (e != hipSuccess) fprintf(stderr, "cooperative launch failed: %s (grid %d)\n", hipGetErrorString(e), grid);
#else
    for (int ph = 0; ph < N_PHASES; ++ph) {
        a.ph_lo = ph; a.ph_hi = ph + 1;
        hipLaunchKernelGGL(mega, dim3(grid), dim3(NTHREADS), LDS_BYTES, stream, a);
    }
#endif
}
```

```cpp
#include <hip/hip_runtime.h>
#include <hip/hip_cooperative_groups.h>
#include <cstdio>
#include <cstdint>
#include <cmath>
namespace cg = cooperative_groups;

#ifndef MK_ONE_LAUNCH
#define MK_ONE_LAUNCH 1
#endif

namespace pg8 {
#define PG8_LAS __attribute__((address_space(3)))
typedef unsigned short bf16_t;
typedef short bf16x8 __attribute__((ext_vector_type(8)));
typedef float f32x4 __attribute__((ext_vector_type(4)));
typedef unsigned u32x4 __attribute__((ext_vector_type(4)));
typedef unsigned u32x2 __attribute__((ext_vector_type(2)));
constexpr int BM = 256, BK = 64, HALF = 128, HTB = HALF * BK * 2, STAGE_BYTES = 8 * HTB, NXCD = 8, WGM = 8;

__host__ __device__ __forceinline__ int lds_byte(int r, int c) { const int st = (r >> 4) * 2 + (c >> 5), rr = r & 15, cc = c & 31, ob = rr * 64 + cc * 2; return st * 1024 + (ob ^ (((ob >> 9) & 1) << 5)); }
__host__ __device__ __forceinline__ void stage_rc(int b, int& R, int& C) { const int st = b / 1024, sb = b % 1024, swz = sb ^ (((sb >> 9) & 1) << 5); R = (st >> 1) * 16 + swz / 64; C = (st & 1) * 32 + (swz % 64) / 2; }
__host__ __device__ __forceinline__ int perm32(int rho) { const int n = rho >> 4, i = rho & 15; return 8 * (i >> 2) + 4 * n + (i & 3); }

struct Unit { int pm, pn; };
struct Gemm { const bf16_t* A; const bf16_t* Bt; int M, N, K, lda, a_pn_cols; };

struct StaticOrder {
    int nM, nN, nwg, G, c;
    __host__ __device__ void init(int M, int N, int G_, int c_) { nM = M / BM; nN = N / BM; nwg = nM * nN; G = G_; c = c_; }
    __host__ __device__ bool next(int i, Unit& u) const {
        const long L = (long)i * G + c; if (L >= nwg) return false;
        int wgid = (int)L; { const int q = nwg / NXCD, r = nwg % NXCD, xcd = wgid % NXCD, off = wgid / NXCD; wgid = (xcd < r ? xcd * (q + 1) : r * (q + 1) + (xcd - r) * q) + off; }
        const int nig = WGM * nN, gid = wgid / nig, fm = gid * WGM, gsz = (nM - fm) < WGM ? (nM - fm) : WGM;
        u.pm = fm + ((wgid % nig) % gsz); u.pn = (wgid % nig) / gsz; return true;
    }
    __device__ __forceinline__ void a_ready(const Unit&) const {}
    __device__ __forceinline__ void done(const Unit&) const {}
};

__device__ __forceinline__ unsigned cvt_pk_bf16(float lo, float hi) { unsigned r; asm volatile("v_cvt_pk_bf16_f32 %0, %1, %2" : "=v"(r) : "v"(lo), "v"(hi)); return r; }
__device__ __forceinline__ float bf_lo(unsigned w) { return __uint_as_float(w << 16); }
__device__ __forceinline__ float bf_hi(unsigned w) { return __uint_as_float(w & 0xffff0000u); }
__device__ __forceinline__ float sigmoidf_(float x) { return 1.0f / (1.0f + __expf(-x)); }

struct EpiBf16 {
    static constexpr bool PERM = true, AFTER_DRAIN = false;
    bf16_t* O; int ldc;
    __device__ __forceinline__ void operator()(const f32x4 (&acc)[2][2][4][2], const Unit& u, int wr, int wc, int fr, int fq) const {
        const int row0 = u.pm * BM + wr * 64 + fr; const int col0 = u.pn * BM + wc * 32 + 8 * fq;
#pragma unroll
        for (int ai = 0; ai < 2; ++ai)
#pragma unroll
            for (int m = 0; m < 4; ++m) { bf16_t* rowp = O + (size_t)(row0 + ai * HALF + m * 16) * ldc + col0;
#pragma unroll
                for (int bj = 0; bj < 2; ++bj) { const f32x4 v0 = acc[ai][bj][m][0], v1 = acc[ai][bj][m][1];
                    u32x4 w; w.x = cvt_pk_bf16(v0[0], v0[1]); w.y = cvt_pk_bf16(v0[2], v0[3]); w.z = cvt_pk_bf16(v1[0], v1[1]); w.w = cvt_pk_bf16(v1[2], v1[3]);
                    *(u32x4*)(rowp + bj * HALF) = w; } }
    }
};
template <bool ACCUM> struct EpiGate {
    static constexpr bool PERM = true, AFTER_DRAIN = false;
    bf16_t* O; int ldc; const bf16_t* G; int ldg; int gcol;
    __device__ __forceinline__ void operator()(const f32x4 (&acc)[2][2][4][2], const Unit& u, int wr, int wc, int fr, int fq) const {
        const int row0 = u.pm * BM + wr * 64 + fr; const int col0 = u.pn * BM + wc * 32 + 8 * fq;
#pragma unroll
        for (int ai = 0; ai < 2; ++ai) {
            u32x2 gpre[4][2]; u32x4 opre[4][2];
#pragma unroll
            for (int m = 0; m < 4; ++m)
#pragma unroll
                for (int bj = 0; bj < 2; ++bj) { const size_t r = (size_t)(row0 + ai * HALF + m * 16); gpre[m][bj] = *(const u32x2*)((const unsigned char*)G + r * ldg + gcol + col0 + bj * HALF);
                    if (ACCUM) opre[m][bj] = *(const u32x4*)(O + r * ldc + col0 + bj * HALF); }
            asm volatile("" ::: "memory");
#pragma unroll
            for (int m = 0; m < 4; ++m) { const size_t r = (size_t)(row0 + ai * HALF + m * 16);
#pragma unroll
                for (int bj = 0; bj < 2; ++bj) { const f32x4 v0 = acc[ai][bj][m][0], v1 = acc[ai][bj][m][1];
                    const u32x2 g = gpre[m][bj]; constexpr float k255 = 1.0f / 255.0f;
                    float o[8];
                    o[0] = (float)(g.x & 0xffu) * k255 * v0[0]; o[1] = (float)((g.x >> 8) & 0xffu) * k255 * v0[1]; o[2] = (float)((g.x >> 16) & 0xffu) * k255 * v0[2]; o[3] = (float)(g.x >> 24) * k255 * v0[3];
                    o[4] = (float)(g.y & 0xffu) * k255 * v1[0]; o[5] = (float)((g.y >> 8) & 0xffu) * k255 * v1[1]; o[6] = (float)((g.y >> 16) & 0xffu) * k255 * v1[2]; o[7] = (float)(g.y >> 24) * k255 * v1[3];
                    bf16_t* op = O + r * ldc + col0 + bj * HALF;
                    if (ACCUM) { const u32x4 p = opre[m][bj];
                        o[0] += bf_lo(p.x); o[1] += bf_hi(p.x); o[2] += bf_lo(p.y); o[3] += bf_hi(p.y); o[4] += bf_lo(p.z); o[5] += bf_hi(p.z); o[6] += bf_lo(p.w); o[7] += bf_hi(p.w); }
                    u32x4 w; w.x = cvt_pk_bf16(o[0], o[1]); w.y = cvt_pk_bf16(o[2], o[3]); w.z = cvt_pk_bf16(o[4], o[5]); w.w = cvt_pk_bf16(o[6], o[7]);
                    *(u32x4*)op = w; } }
        }
    }
};
struct EpiResF32 {
    static constexpr bool PERM = false, AFTER_DRAIN = false;
    const float* base; float* out; int ldc;
    __device__ __forceinline__ void operator()(const f32x4 (&acc)[2][2][4][2], const Unit& u, int wr, int wc, int fr, int fq) const {
        const int row0 = u.pm * BM + wr * 64 + fr; const int col0 = u.pn * BM + wc * 32 + 4 * fq;
#pragma unroll
        for (int ai = 0; ai < 2; ++ai)
#pragma unroll
            for (int m = 0; m < 4; ++m) { const size_t off = (size_t)(row0 + ai * HALF + m * 16) * ldc + col0;
#pragma unroll
                for (int bj = 0; bj < 2; ++bj)
#pragma unroll
                    for (int n = 0; n < 2; ++n) { const f32x4 b = *(const f32x4*)(base + off + bj * HALF + n * 16); *(f32x4*)(out + off + bj * HALF + n * 16) = b + acc[ai][bj][m][n]; } }
    }
};
struct EpiQKVG {
    static constexpr bool PERM = true, AFTER_DRAIN = false;
    bf16_t* O; const float* COS; const float* SIN;
    __device__ __forceinline__ void operator()(const f32x4 (&acc)[2][2][4][2], const Unit& u, int wr, int wc, int fr, int fq) const {
        const int row0 = u.pm * BM + wr * 64 + fr; const int col0 = u.pn * BM + wc * 32 + 8 * fq;
        const bool rot = u.pn < 4; const float sc = (u.pn >= 2 && u.pn < 4) ? 0.08838834764831845f : 1.0f; const int i0 = 4 * (wc * 4 + fq);
#pragma unroll
        for (int ai = 0; ai < 2; ++ai)
#pragma unroll
            for (int m = 0; m < 4; ++m) { const int row = row0 + ai * HALF + m * 16; bf16_t* rowp = O + (size_t)row * 3072 + col0;
                f32x4 c = (f32x4){1.f, 1.f, 1.f, 1.f}, s = (f32x4){0.f, 0.f, 0.f, 0.f};
                if (rot) { const size_t ti = (size_t)(row & 4095) * 64 + i0; c = *(const f32x4*)(COS + ti) * sc; s = *(const f32x4*)(SIN + ti) * sc; }
#pragma unroll
                for (int bj = 0; bj < 2; ++bj) { f32x4 v0 = acc[ai][bj][m][0], v1 = acc[ai][bj][m][1];
                    if (rot) { const f32x4 r1 = v0 * c - v1 * s, r2 = v0 * s + v1 * c; v0 = r1; v1 = r2; }
                    u32x4 w; w.x = cvt_pk_bf16(v0[0], v0[1]); w.y = cvt_pk_bf16(v0[2], v0[3]); w.z = cvt_pk_bf16(v1[0], v1[1]); w.w = cvt_pk_bf16(v1[2], v1[3]);
                    *(u32x4*)(rowp + bj * HALF) = w; } }
    }
};
struct EpiConvGates {
    static constexpr bool PERM = true, AFTER_DRAIN = false;
    bf16_t* CB; bf16_t* UU; bf16_t* GT;
    __device__ __forceinline__ void operator()(const f32x4 (&acc)[2][2][4][2], const Unit& u, int wr, int wc, int fr, int fq) const {
        const int row0 = u.pm * BM + wr * 64 + fr;
        if (u.pn >= 4 && u.pn < 12) {
            const int col0 = (u.pn - 4) * 128 + wc * 32 + 8 * fq;
#pragma unroll
            for (int ai = 0; ai < 2; ++ai)
#pragma unroll
                for (int m = 0; m < 4; ++m) { const f32x4 v0 = acc[ai][0][m][0] * acc[ai][1][m][0], v1 = acc[ai][0][m][1] * acc[ai][1][m][1];
                    u32x4 w; w.x = cvt_pk_bf16(v0[0], v0[1]); w.y = cvt_pk_bf16(v0[2], v0[3]); w.z = cvt_pk_bf16(v1[0], v1[1]); w.w = cvt_pk_bf16(v1[2], v1[3]);
                    *(u32x4*)(UU + (size_t)(row0 + ai * HALF + m * 16) * 1024 + col0) = w; }
        } else if (u.pn >= 12) {
            unsigned char* G8 = (unsigned char*)GT; const int col0 = (u.pn - 12) * BM + wc * 32 + 8 * fq;
#pragma unroll
            for (int ai = 0; ai < 2; ++ai)
#pragma unroll
                for (int m = 0; m < 4; ++m) { unsigned char* rowp = G8 + (size_t)(row0 + ai * HALF + m * 16) * 2048 + col0;
#pragma unroll
                    for (int bj = 0; bj < 2; ++bj) { const f32x4 v0 = acc[ai][bj][m][0], v1 = acc[ai][bj][m][1];
                        unsigned q[8];
#pragma unroll
                        for (int z = 0; z < 4; ++z) { q[z] = (unsigned)(sigmoidf_(v0[z]) * 255.0f + 0.5f); q[4 + z] = (unsigned)(sigmoidf_(v1[z]) * 255.0f + 0.5f); }
                        u32x2 w; w.x = q[0] | (q[1] << 8) | (q[2] << 16) | (q[3] << 24); w.y = q[4] | (q[5] << 8) | (q[6] << 16) | (q[7] << 24);
                        *(u32x2*)(rowp + bj * HALF) = w; } }
        } else {
            bf16_t* O = CB; const int ldc = 1024; const int col0 = u.pn * BM + wc * 32 + 8 * fq;
#pragma unroll
            for (int ai = 0; ai < 2; ++ai)
#pragma unroll
                for (int m = 0; m < 4; ++m) { bf16_t* rowp = O + (size_t)(row0 + ai * HALF + m * 16) * ldc + col0;
#pragma unroll
                    for (int bj = 0; bj < 2; ++bj) { const f32x4 v0 = acc[ai][bj][m][0], v1 = acc[ai][bj][m][1];
                        u32x4 w; w.x = cvt_pk_bf16(v0[0], v0[1]); w.y = cvt_pk_bf16(v0[2], v0[3]); w.z = cvt_pk_bf16(v1[0], v1[1]); w.w = cvt_pk_bf16(v1[2], v1[3]);
                        *(u32x4*)(rowp + bj * HALF) = w; } }
        }
    }
};
struct EpiResBf16SS {
    static constexpr bool PERM = true, AFTER_DRAIN = false;
    const float* base; bf16_t* O; float* SS; int ldc;
    __device__ __forceinline__ void operator()(const f32x4 (&acc)[2][2][4][2], const Unit& u, int wr, int wc, int fr, int fq) const {
        const int row0 = u.pm * BM + wr * 64 + fr; const int col0 = u.pn * BM + wc * 32 + 8 * fq;
#pragma unroll
        for (int ai = 0; ai < 2; ++ai) {
            f32x4 pre[4][2][2];
#pragma unroll
            for (int m = 0; m < 4; ++m)
#pragma unroll
                for (int bj = 0; bj < 2; ++bj) { const size_t o = (size_t)(row0 + ai * HALF + m * 16) * ldc + col0 + bj * HALF; pre[m][bj][0] = *(const f32x4*)(base + o); pre[m][bj][1] = *(const f32x4*)(base + o + 4); }
            asm volatile("" ::: "memory");
#pragma unroll
            for (int m = 0; m < 4; ++m) { const size_t r = (size_t)(row0 + ai * HALF + m * 16); float ssq = 0.f;
#pragma unroll
                for (int bj = 0; bj < 2; ++bj) { const size_t o = r * ldc + col0 + bj * HALF;
                    const f32x4 h0 = pre[m][bj][0] + acc[ai][bj][m][0], h1 = pre[m][bj][1] + acc[ai][bj][m][1];
                    ssq += (h0[0] * h0[0] + h0[1] * h0[1]) + (h0[2] * h0[2] + h0[3] * h0[3]) + (h1[0] * h1[0] + h1[1] * h1[1]) + (h1[2] * h1[2] + h1[3] * h1[3]);
                    u32x4 w; w.x = cvt_pk_bf16(h0[0], h0[1]); w.y = cvt_pk_bf16(h0[2], h0[3]); w.z = cvt_pk_bf16(h1[0], h1[1]); w.w = cvt_pk_bf16(h1[2], h1[3]);
                    *(u32x4*)(O + o) = w; }
                ssq += __shfl_xor(ssq, 16); ssq += __shfl_xor(ssq, 32);
                if (fq == 0) SS[r * 16 + u.pn * 4 + wc] = ssq; }
        }
    }
};
struct EpiPleBf16SS {
    static constexpr bool PERM = true, AFTER_DRAIN = false;
    const bf16_t* H; const bf16_t* P; bf16_t* O; const float* RS; float* SS; int ldc;
    __device__ __forceinline__ void operator()(const f32x4 (&acc)[2][2][4][2], const Unit& u, int wr, int wc, int fr, int fq) const {
        const int row0 = u.pm * BM + wr * 64 + fr; const int col0 = u.pn * BM + wc * 32 + 8 * fq;
#pragma unroll
        for (int ai = 0; ai < 2; ++ai) {
            float rsv[4];
#pragma unroll
            for (int m = 0; m < 4; ++m) { const size_t r = (size_t)(row0 + ai * HALF + m * 16); rsv[m] = RS[r]; }
            asm volatile("" : "+v"(rsv[0]), "+v"(rsv[1]), "+v"(rsv[2]), "+v"(rsv[3]) :: "memory");
            u32x4 hpre[4][2], ppre[4][2];
#pragma unroll
            for (int m = 0; m < 4; ++m) { const size_t r = (size_t)(row0 + ai * HALF + m * 16);
#pragma unroll
                for (int bj = 0; bj < 2; ++bj) { const size_t o = r * ldc + col0 + bj * HALF; hpre[m][bj] = *(const u32x4*)(H + o); ppre[m][bj] = *(const u32x4*)(P + o); } }
            asm volatile("" ::: "memory");
#pragma unroll
            for (int m = 0; m < 4; ++m) { const size_t r = (size_t)(row0 + ai * HALF + m * 16); float ssq = 0.f; const float rs = rsv[m];
#pragma unroll
                for (int bj = 0; bj < 2; ++bj) { const size_t o = r * ldc + col0 + bj * HALF;
                    const u32x4 hw = hpre[m][bj], pw = ppre[m][bj]; const f32x4 a0 = acc[ai][bj][m][0], a1 = acc[ai][bj][m][1];
                    float h[8];
                    h[0] = bf_lo(hw.x) + sigmoidf_(rs * a0[0]) * bf_lo(pw.x); h[1] = bf_hi(hw.x) + sigmoidf_(rs * a0[1]) * bf_hi(pw.x);
                    h[2] = bf_lo(hw.y) + sigmoidf_(rs * a0[2]) * bf_lo(pw.y); h[3] = bf_hi(hw.y) + sigmoidf_(rs * a0[3]) * bf_hi(pw.y);
                    h[4] = bf_lo(hw.z) + sigmoidf_(rs * a1[0]) * bf_lo(pw.z); h[5] = bf_hi(hw.z) + sigmoidf_(rs * a1[1]) * bf_hi(pw.z);
                    h[6] = bf_lo(hw.w) + sigmoidf_(rs * a1[2]) * bf_lo(pw.w); h[7] = bf_hi(hw.w) + sigmoidf_(rs * a1[3]) * bf_hi(pw.w);
#pragma unroll
                    for (int z = 0; z < 8; ++z) ssq += h[z] * h[z];
                    u32x4 w; w.x = cvt_pk_bf16(h[0], h[1]); w.y = cvt_pk_bf16(h[2], h[3]); w.z = cvt_pk_bf16(h[4], h[5]); w.w = cvt_pk_bf16(h[6], h[7]);
                    *(u32x4*)(O + o) = w; }
                ssq += __shfl_xor(ssq, 16); ssq += __shfl_xor(ssq, 32);
                if (fq == 0) SS[r * 16 + u.pn * 4 + wc] = ssq; }
        }
    }
};
struct EpiPle {
    static constexpr bool PERM = false, AFTER_DRAIN = false;
    const float* base; float* out; const bf16_t* P; int ldc;
    __device__ __forceinline__ void operator()(const f32x4 (&acc)[2][2][4][2], const Unit& u, int wr, int wc, int fr, int fq) const {
        const int row0 = u.pm * BM + wr * 64 + fr; const int col0 = u.pn * BM + wc * 32 + 4 * fq;
#pragma unroll
        for (int ai = 0; ai < 2; ++ai)
#pragma unroll
            for (int m = 0; m < 4; ++m) { const size_t off = (size_t)(row0 + ai * HALF + m * 16) * ldc + col0;
#pragma unroll
                for (int bj = 0; bj < 2; ++bj)
#pragma unroll
                    for (int n = 0; n < 2; ++n) { const size_t o = off + bj * HALF + n * 16; const f32x4 b = *(const f32x4*)(base + o); const u32x2 p = *(const u32x2*)(P + o); const f32x4 a = acc[ai][bj][m][n];
                        f32x4 r; r[0] = b[0] + sigmoidf_(a[0]) * bf_lo(p.x); r[1] = b[1] + sigmoidf_(a[1]) * bf_hi(p.x); r[2] = b[2] + sigmoidf_(a[2]) * bf_lo(p.y); r[3] = b[3] + sigmoidf_(a[3]) * bf_hi(p.y);
                        *(f32x4*)(out + o) = r; } }
    }
};

template <class Epi, class Sched, bool ALIGN_EPI>
__device__ __forceinline__ void gemm_phase(PG8_LAS unsigned char* lds, const Gemm g, const Sched& S, const Epi& E) {
    const int tid = threadIdx.x, wid = __builtin_amdgcn_readfirstlane(tid >> 6), lane = tid & 63, wr = wid >> 2, wc = wid & 3, fr = lane & 15, fq = lane >> 4;
    const int K = g.K, nt = K / BK, lda = g.lda;
    unsigned voffA[2], voffB[2];
#pragma unroll
    for (int i = 0; i < 2; ++i) { int R, C; stage_rc(tid * 16 + i * 8192, R, C); const int Rb = Epi::PERM ? ((R & ~31) + perm32(R & 31)) : R;
        voffA[i] = (unsigned)(R * lda + C) * 2u; voffB[i] = (unsigned)(Rb * K + C) * 2u; }
    const size_t kstep = (size_t)(BK * 2);
    const size_t hstepA = (size_t)HALF * lda * 2, hstepB = (size_t)HALF * K * 2;
    const size_t tstepA = 2 * hstepA, tstepB = 2 * hstepB;
    const size_t pnstepA = (size_t)g.a_pn_cols * 2;
    const unsigned ldsw = (unsigned)wid * 1024u;
    const int aoff = lds_byte(wr * 64 + fr, fq * 8), boff = lds_byte(wc * 32 + fr, fq * 8);
#define PG8_SA(b, h) (((b) * 2 + (h)) * HTB)
#define PG8_SB(b, h) ((4 + (b) * 2 + (h)) * HTB)
#define PG8_STAGE(bufoff, gbase, voff) do { _Pragma("unroll") for (int _i = 0; _i < 2; ++_i) \
        __builtin_amdgcn_global_load_lds((const unsigned*)((const char*)(gbase) + (voff)[_i]), (PG8_LAS unsigned*)(lds + (bufoff) + ldsw + _i * 8192), 16, 0, 0); } while (0)
#define PG8_LDA(dst, b, h) do { _Pragma("unroll") for (int m = 0; m < 4; ++m) _Pragma("unroll") for (int k = 0; k < 2; ++k) dst[m][k] = *(const PG8_LAS bf16x8*)(lds + PG8_SA(b, h) + aoff + m * 2048 + k * 1024); } while (0)
#define PG8_LDB(dst, b, h) do { _Pragma("unroll") for (int n = 0; n < 2; ++n) _Pragma("unroll") for (int k = 0; k < 2; ++k) dst[n][k] = *(const PG8_LAS bf16x8*)(lds + PG8_SB(b, h) + boff + n * 2048 + k * 1024); } while (0)
#define PG8_MMA(ai, bj, At, Bt) do { __builtin_amdgcn_s_setprio(1); _Pragma("unroll") for (int m = 0; m < 4; ++m) _Pragma("unroll") for (int n = 0; n < 2; ++n) _Pragma("unroll") for (int k = 0; k < 2; ++k) \
        acc[ai][bj][m][n] = __builtin_amdgcn_mfma_f32_16x16x32_bf16(Bt[n][k], At[m][k], acc[ai][bj][m][n], 0, 0, 0); __builtin_amdgcn_s_setprio(0); } while (0)
#define PG8_WAIT_V(n) asm volatile("s_waitcnt vmcnt(" #n ")" ::: "memory")
#define PG8_WAIT_L(n) asm volatile("s_waitcnt lgkmcnt(" #n ")" ::: "memory")
#define PG8_BAR __builtin_amdgcn_s_barrier()
#define PG8_SCHED __builtin_amdgcn_sched_barrier(0)
    Unit cur, nxt; int ui = 0;
    if (!S.next(0, cur)) return;
    f32x4 acc[2][2][4][2];
#pragma unroll
    for (int a = 0; a < 2; ++a)
#pragma unroll
        for (int b = 0; b < 2; ++b)
#pragma unroll
            for (int m = 0; m < 4; ++m)
#pragma unroll
                for (int n = 0; n < 2; ++n) acc[a][b][m][n] = (f32x4){0.f, 0.f, 0.f, 0.f};
    bf16x8 At[4][2], B0[2][2], B1[2][2];
    const char* cA = (const char*)g.A + (size_t)cur.pm * tstepA + (size_t)cur.pn * pnstepA; const char* cB = (const char*)g.Bt + (size_t)cur.pn * tstepB;
    S.a_ready(cur);
    PG8_STAGE(PG8_SB(0, 0), cB, voffB); PG8_STAGE(PG8_SB(0, 1), cB + hstepB, voffB); PG8_STAGE(PG8_SA(0, 0), cA, voffA); PG8_STAGE(PG8_SA(0, 1), cA + hstepA, voffA);
    if (wr == 1) PG8_BAR;
    PG8_WAIT_V(2); PG8_BAR;
    PG8_STAGE(PG8_SB(1, 0), cB + kstep, voffB); PG8_STAGE(PG8_SA(1, 0), cA + kstep, voffA); PG8_STAGE(PG8_SB(1, 1), cB + hstepB + kstep, voffB);
    PG8_WAIT_V(6); PG8_BAR;
    for (;;) {
        const bool has_next = S.next(ui + 1, nxt);
        const char* nA = has_next ? (const char*)g.A + (size_t)nxt.pm * tstepA + (size_t)nxt.pn * pnstepA : cA; const char* nB = has_next ? (const char*)g.Bt + (size_t)nxt.pn * tstepB : cB;
        for (int t = 0; t < nt; t += 2) {
            const bool last = (t == nt - 2);
            const char* a1 = cA + (size_t)(t + 1) * kstep;
            const char* a2 = last ? nA : cA + (size_t)(t + 2) * kstep; const char* b2 = last ? nB : cB + (size_t)(t + 2) * kstep;
            const char* a3 = a2 + kstep; const char* b3 = b2 + kstep;
            if (last && has_next) S.a_ready(nxt);
            PG8_LDB(B0, 0, 0); PG8_LDB(B1, 0, 1); PG8_SCHED; PG8_LDA(At, 0, 0); PG8_STAGE(PG8_SA(1, 1), a1 + hstepA, voffA);
            PG8_WAIT_V(8); PG8_WAIT_L(0); PG8_BAR; PG8_MMA(0, 0, At, B0); PG8_MMA(0, 1, At, B1); PG8_BAR; PG8_SCHED;
            PG8_LDA(At, 0, 1); PG8_STAGE(PG8_SB(0, 0), b2, voffB); PG8_STAGE(PG8_SB(0, 1), b2 + hstepB, voffB); PG8_STAGE(PG8_SA(0, 0), a2, voffA);
            PG8_WAIT_V(8); PG8_WAIT_L(0); PG8_BAR; PG8_MMA(1, 0, At, B0); PG8_MMA(1, 1, At, B1); PG8_BAR; PG8_SCHED;
            PG8_LDB(B0, 1, 0); PG8_LDB(B1, 1, 1); PG8_SCHED; PG8_LDA(At, 1, 0); PG8_STAGE(PG8_SA(0, 1), a2 + hstepA, voffA);
            PG8_WAIT_V(8); PG8_WAIT_L(0); PG8_BAR; PG8_MMA(0, 0, At, B0); PG8_MMA(0, 1, At, B1); PG8_BAR; PG8_SCHED;
            PG8_LDA(At, 1, 1); PG8_STAGE(PG8_SB(1, 0), b3, voffB); PG8_STAGE(PG8_SB(1, 1), b3 + hstepB, voffB); PG8_STAGE(PG8_SA(1, 0), a3, voffA);
            PG8_WAIT_V(8); PG8_WAIT_L(0); PG8_BAR; PG8_MMA(1, 0, At, B0); PG8_MMA(1, 1, At, B1); PG8_BAR; PG8_SCHED;
        }
        if constexpr (ALIGN_EPI) { if (wr == 0) PG8_BAR; }
        E(acc, cur, wr, wc, fr, fq); S.done(cur);
        if (!has_next) break;
#pragma unroll
        for (int a = 0; a < 2; ++a)
#pragma unroll
            for (int b = 0; b < 2; ++b)
#pragma unroll
                for (int m = 0; m < 4; ++m)
#pragma unroll
                    for (int n = 0; n < 2; ++n) acc[a][b][m][n] = (f32x4){0.f, 0.f, 0.f, 0.f};
        cur = nxt; cA = nA; cB = nB; ++ui;
        if constexpr (ALIGN_EPI) { if (wr == 1) PG8_BAR; }
    }
    PG8_WAIT_V(0);
    if constexpr (!ALIGN_EPI) { if (wr == 0) PG8_BAR; }
    PG8_BAR;
#undef PG8_SA
#undef PG8_SB
#undef PG8_STAGE
#undef PG8_LDA
#undef PG8_LDB
#undef PG8_MMA
#undef PG8_WAIT_V
#undef PG8_WAIT_L
#undef PG8_BAR
#undef PG8_SCHED
}
}

constexpr int NWAVES = 8, NTHREADS = NWAVES * 64;
constexpr int BATCH = 8, SEQ = 4096, D = 1024, T = BATCH * SEQ;
constexpr int RH = 4, RDK = 128, RDV = 256, RC = 128, NCH = SEQ / RC;
constexpr int RQK = RH * RDK, RV = RH * RDV;
constexpr int INW = 8192;
constexpr int PH = 8, PNK = 128, PNE = PNK * PNK, PQD = 256, PHALF = 128, PTOPK = 16, NSEL = PH * PTOPK;
constexpr int PLE = 256;
constexpr float EPS = 1e-6f;
constexpr int NUNITS_R = BATCH * NCH * RH;

constexpr size_t MiB = 1u << 20;
constexpr size_t WS_CTL = 0, CTL_ZERO_BYTES = 64 * 1024;
constexpr size_t WS_COS = 1 * MiB, WS_SIN = 2 * MiB;
constexpr size_t WS_WIN = 3 * MiB;
constexpr size_t WS_WRU = 19 * MiB, WS_WCU = 21 * MiB, WS_WOUT = 23 * MiB;
constexpr size_t WS_WPQ = 25 * MiB;
constexpr size_t WS_WPP = 29 * MiB;
constexpr size_t WS_K1 = 29 * MiB + 512 * 1024, WS_K2 = 29 * MiB + 768 * 1024;
constexpr size_t WS_WPG = 30 * MiB;
constexpr size_t WS_UB = 32 * MiB, WS_VB = 64 * MiB;
constexpr size_t WS_XN = 96 * MiB;
constexpr size_t WS_BIG = 160 * MiB;
constexpr size_t WS_PREV = 352 * MiB;
constexpr size_t WS_ARET = 416 * MiB;
constexpr size_t WS_IDX = 480 * MiB, WS_GATE = 496 * MiB;
constexpr size_t WS_END = 512 * MiB;

constexpr int LDS_BYTES = 160 * 1024;

constexpr int PNE_ROWS = 16384;
typedef unsigned short bf16;
typedef unsigned v4u __attribute__((ext_vector_type(4)));
typedef unsigned v2u __attribute__((ext_vector_type(2)));
typedef float f32x4 __attribute__((ext_vector_type(4)));
#define LAS __attribute__((address_space(3)))

__device__ __forceinline__ unsigned f2bf(float f) { unsigned u = __float_as_uint(f); return (u + 0x7fffu + ((u >> 16) & 1u)) >> 16; }
__device__ __forceinline__ unsigned pk2(float lo, float hi) { return f2bf(lo) | (f2bf(hi) << 16); }
__device__ __forceinline__ float bflo(unsigned w) { return __uint_as_float(w << 16); }
__device__ __forceinline__ float bfhi(unsigned w) { return __uint_as_float(w & 0xffff0000u); }
__device__ __forceinline__ float bf2f(bf16 h) { return __uint_as_float(((unsigned)h) << 16); }
__device__ __forceinline__ float wave_sum(float v) {
#pragma unroll
    for (int o = 1; o < 64; o <<= 1) v += __shfl_xor(v, o);
    return v;
}
__device__ __forceinline__ float wave_max(float v) {
#pragma unroll
    for (int o = 1; o < 64; o <<= 1) v = fmaxf(v, __shfl_xor(v, o));
    return v;
}
__device__ __forceinline__ void unpack8(const v4u w, float* f) { f[0] = bflo(w.x); f[1] = bfhi(w.x); f[2] = bflo(w.y); f[3] = bfhi(w.y); f[4] = bflo(w.z); f[5] = bfhi(w.z); f[6] = bflo(w.w); f[7] = bfhi(w.w); }


typedef float f32x16 __attribute__((ext_vector_type(16)));
typedef short bf16x8v __attribute__((ext_vector_type(8)));
__device__ __forceinline__ unsigned ord_key(float f) { const unsigned u = __float_as_uint(f); return u ^ ((unsigned)((int)u >> 31) | 0x80000000u); }
__device__ __forceinline__ float ord_val(unsigned k) { return __uint_as_float(k ^ (~(unsigned)((int)k >> 31) | 0x80000000u)); }
__device__ __forceinline__ void sort16_desc(unsigned (&x)[16]) {
#pragma unroll
    for (int ks = 1; ks <= 4; ++ks) {
#pragma unroll
        for (int js = ks - 1; js >= 0; --js) {
#pragma unroll
            for (int i = 0; i < 16; ++i) { const int k = 1 << ks, j = 1 << js, l = i ^ j;
                if (l > i) { const unsigned hi = max(x[i], x[l]), lo = min(x[i], x[l]); if ((i & k) == 0) { x[i] = hi; x[l] = lo; } else { x[i] = lo; x[l] = hi; } } }
        }
    }
}
__device__ __forceinline__ void merge16_desc(unsigned (&a)[16], const unsigned (&b)[16]) {
#pragma unroll
    for (int i = 0; i < 16; ++i) a[i] = max(a[i], b[15 - i]);
#pragma unroll
    for (int js = 3; js >= 0; --js) {
#pragma unroll
        for (int i = 0; i < 16; ++i) { const int j = 1 << js, l = i ^ j;
            if (l > i) { const unsigned hi = max(a[i], a[l]), lo = min(a[i], a[l]); a[i] = hi; a[l] = lo; } }
    }
}

__device__ __forceinline__ void peer_half_topk(const bf16* qrow, const bf16* kb, int hg, unsigned (&V)[16]) {
    constexpr int LS = 136;
    bf16x8v qf[8];
#pragma unroll
    for (int ks = 0; ks < 8; ++ks) qf[ks] = *(const bf16x8v*)(qrow + 16 * ks);
    f32x16 acc[4];
#pragma unroll
    for (int b = 0; b < 4; ++b)
#pragma unroll
        for (int z = 0; z < 16; ++z) acc[b][z] = 0.f;
#pragma unroll
    for (int ks = 0; ks < 8; ++ks)
#pragma unroll
        for (int b = 0; b < 4; ++b) { const bf16x8v a = *(const bf16x8v*)(kb + b * 32 * LS + 16 * ks); acc[b] = __builtin_amdgcn_mfma_f32_32x32x16_bf16(a, qf[ks], acc[b], 0, 0, 0); }
    unsigned x0[16], x1[16], x2[16], x3[16];
#pragma unroll
    for (int z = 0; z < 16; ++z) { const int nb = (z & 3) + 8 * (z >> 2) + 4 * hg;
        x0[z] = (ord_key(acc[0][z]) & ~0x7Fu) | (unsigned)(127 - nb);
        x1[z] = (ord_key(acc[1][z]) & ~0x7Fu) | (unsigned)(127 - (32 + nb));
        x2[z] = (ord_key(acc[2][z]) & ~0x7Fu) | (unsigned)(127 - (64 + nb));
        x3[z] = (ord_key(acc[3][z]) & ~0x7Fu) | (unsigned)(127 - (96 + nb)); }
    sort16_desc(x0); sort16_desc(x1); merge16_desc(x0, x1);
    sort16_desc(x2); sort16_desc(x3); merge16_desc(x2, x3);
    merge16_desc(x0, x2);
    unsigned pz[16];
#pragma unroll
    for (int z = 0; z < 16; ++z) { auto rr = __builtin_amdgcn_permlane32_swap(x0[z], x0[z], false, false); pz[z] = hg ? rr[0] : rr[1]; }
    merge16_desc(x0, pz);
#pragma unroll
    for (int z = 0; z < 16; ++z) V[z] = x0[z];
}

typedef short v4i16_t __attribute__((ext_vector_type(4)));
__device__ __forceinline__ v4i16_t ds_tr4(LAS const unsigned char* p) { return __builtin_amdgcn_ds_read_tr16_b64_v4i16((LAS v4i16_t*)p); }
__device__ __forceinline__ bf16x8v cat8(v4i16_t a, v4i16_t b) { return __builtin_shufflevector(a, b, 0, 1, 2, 3, 4, 5, 6, 7); }

__device__ __forceinline__ void sort128_asc(unsigned& k0, unsigned& k1, int lane) {
#pragma unroll
    for (int ks = 1; ks <= 7; ++ks) {
#pragma unroll
        for (int js = ks - 1; js >= 0; --js) {
            const int K = 1 << ks, J = 1 << js;
            if (J == 64) { const unsigned lo = min(k0, k1), hi = max(k0, k1); k0 = lo; k1 = hi; }
            else {
                const bool lower = (lane & J) == 0;
                const bool up0 = (K <= 32) ? ((lane & K) == 0) : true;
                const bool up1 = (K <= 32) ? ((lane & K) == 0) : (K == 128);
                const unsigned o0 = __shfl_xor(k0, J), o1 = __shfl_xor(k1, J);
                k0 = (lower == up0) ? min(k0, o0) : max(k0, o0);
                k1 = (lower == up1) ? min(k1, o1) : max(k1, o1);
            }
        }
    }
}

#define XB_TMO      128
#define XB_XCNT(j)  (256  + 64 * (j))
#define XB_XSUB(j)  (1280 + 64 * (j))
#define XB_XGEN(j)  (2304 + 64 * (j))
#define XB_TOP      3328
#define XB_TOPGEN   3392
#define XCD_BAR_WORDS 3456
#define XB_SPIN_CAP (1u << 20)
__device__ __forceinline__ unsigned xb_ld(unsigned* p)              { return __hip_atomic_load(p, __ATOMIC_RELAXED, __HIP_MEMORY_SCOPE_AGENT); }
__device__ __forceinline__ unsigned xb_add(unsigned* p, unsigned v) { return __hip_atomic_fetch_add(p, v, __ATOMIC_RELAXED, __HIP_MEMORY_SCOPE_AGENT); }
__device__ __forceinline__ unsigned xb_xcc_id() { return (unsigned)__builtin_amdgcn_s_getreg((3 << 11) | 20) & 0xFu; }
#define XB_SPIN(cond, bar) do { unsigned _sp = 0; while (cond) { __builtin_amdgcn_s_sleep(1); \
    if ((++_sp & 255u) == 0u) { if (xb_ld(&(bar)[XB_TMO])) break; if (_sp > XB_SPIN_CAP) { atomicAdd(&(bar)[XB_TMO], 1u); break; } } } } while (0)
struct XcdBarrier { unsigned* bar; unsigned x; volatile LAS unsigned* st; };
__device__ __forceinline__ XcdBarrier xcd_barrier_post(unsigned* bar, volatile LAS unsigned* st) {
    XcdBarrier b; b.bar = bar; b.x = xb_xcc_id(); b.st = st;
    if (threadIdx.x == 0) (void)xb_add(&bar[XB_XCNT(b.x)], 1u);
    return b;
}
__device__ __forceinline__ void xcd_barrier_complete(unsigned* bar, unsigned x, unsigned& nloc, unsigned& nx) {
    const unsigned G = gridDim.x * gridDim.y * gridDim.z;
    unsigned sum, cnt, mine, sp = 0u;
    for (;;) {
        sum = 0u; cnt = 0u; mine = 0u;
#pragma unroll
        for (unsigned j = 0; j < 16; ++j) { const unsigned c = xb_ld(&bar[XB_XCNT(j)]); sum += c; cnt += (c > 0u) ? 1u : 0u; mine = (j == x) ? c : mine; }
        if (sum == G) break;
        __builtin_amdgcn_s_sleep(1);
        if ((++sp & 255u) == 0u) { if (xb_ld(&bar[XB_TMO])) break; if (sp > XB_SPIN_CAP) { atomicAdd(&bar[XB_TMO], 1u); break; } }
    }
    nloc = mine > 0u ? mine : 1u; nx = cnt > 0u ? cnt : 1u;
}
__device__ __forceinline__ void xcd_barrier(const XcdBarrier& b) {
    asm volatile("s_waitcnt vmcnt(0)" ::: "memory");
    __syncthreads();
    if (threadIdx.x == 0) {
        unsigned* bar = b.bar;
        __builtin_amdgcn_s_waitcnt(0);
        unsigned nloc = b.st[0], nx = b.st[1];
        if (nloc == 0u) { xcd_barrier_complete(bar, b.x, nloc, nx); b.st[0] = nloc; b.st[1] = nx; }
        const unsigned old = xb_add(&bar[XB_XSUB(b.x)], 1u);
        const unsigned gen = old / nloc;
        if (old + 1u == (gen + 1u) * nloc) {
            __builtin_amdgcn_fence(__ATOMIC_RELEASE, "agent");
            asm volatile("s_waitcnt vmcnt(0)" ::: "memory");
            const unsigned og = xb_add(&bar[XB_TOP], 1u);
            const unsigned tg = og / nx;
            if (og + 1u == (tg + 1u) * nx) xb_add(&bar[XB_TOPGEN], 1u);
            else XB_SPIN(xb_ld(&bar[XB_TOPGEN]) == tg, bar);
            __builtin_amdgcn_fence(__ATOMIC_ACQUIRE, "agent");
            xb_add(&bar[XB_XGEN(b.x)], 1u);
            asm volatile("s_waitcnt vmcnt(0)" ::: "memory");
        } else {
            XB_SPIN(xb_ld(&bar[XB_XGEN(b.x)]) == gen, bar);
            __builtin_amdgcn_fence(__ATOMIC_ACQUIRE, "agent");
            asm volatile("s_waitcnt vmcnt(0)" ::: "memory");
        }
    }
    __syncthreads();
}

struct Args {
    const float* in[19]; float* out; unsigned char* ws; int ph_lo, ph_hi;
};

struct Frame {
    unsigned char* lds;
    int tid, lane, wave, G, gw, NGW, gt, NGT;
};

__device__ __forceinline__ void p0_transpose_item(const float* W, int K, int N, bf16* WT, float* scr, int item, int lane, const float* gk = nullptr, bool win_remap = false) {
    const int nblk = N / 32, kb = item / nblk, nb = item % nblk, k0 = 64 * kb, n0 = 32 * nb;

#pragma unroll 8
    for (int i = 0; i < 32; ++i) { const int kk = 2 * i + (lane >> 5); scr[kk * 33 + (lane & 31)] = W[(size_t)(k0 + kk) * N + n0 + (lane & 31)] * (gk ? gk[k0 + kk] : 1.0f); }
    asm volatile("s_waitcnt lgkmcnt(0)" ::: "memory");
    const int c = lane & 7;
#pragma unroll
    for (int j = 0; j < 4; ++j) { const int n = (lane >> 3) + 8 * j; const float* s = scr + (8 * c) * 33 + n;
        v4u o; o.x = pk2(s[0 * 33], s[1 * 33]); o.y = pk2(s[2 * 33], s[3 * 33]); o.z = pk2(s[4 * 33], s[5 * 33]); o.w = pk2(s[6 * 33], s[7 * 33]);
        int dn = n0 + n;
        if (win_remap) {
            if (dn < 1024) { const int hc = dn & 127, i = hc & 63; dn = (dn & ~127) + 8 * (i >> 2) + ((hc >> 6) << 2) + (i & 3); }
            else if (dn >= 4096 && dn < 6144) { const int cc = dn - 4096; dn = cc < 1024 ? 4096 + (cc >> 7) * 256 + (cc & 127) : 4096 + ((cc - 1024) >> 7) * 256 + 128 + ((cc - 1024) & 127); } }
        *(v4u*)(WT + (size_t)dn * K + k0 + 8 * c) = o; }
    asm volatile("s_waitcnt lgkmcnt(0)" ::: "memory");
}
__device__ __forceinline__ void cvt_f32_bf16(const Frame& F, const float* src, bf16* dst, size_t count) {
    const size_t n4 = count / 4, st = (size_t)F.NGT;
    size_t i = F.gt;
    for (; i + 3 * st < n4; i += 4 * st) { f32x4 v[4];
#pragma unroll
        for (int q = 0; q < 4; ++q) v[q] = ((const f32x4*)src)[i + q * st];
#pragma unroll
        for (int q = 0; q < 4; ++q) { v2u o; o.x = pk2(v[q][0], v[q][1]); o.y = pk2(v[q][2], v[q][3]); ((v2u*)dst)[i + q * st] = o; } }
    for (; i < n4; i += st) { const f32x4 v = ((const f32x4*)src)[i]; v2u o; o.x = pk2(v[0], v[1]); o.y = pk2(v[2], v[3]); ((v2u*)dst)[i] = o; }
}
__device__ __forceinline__ void rms_row_to_bf16(const float* xrow, const float* g, bf16* orow, int lane) {
    const f32x4* xr = (const f32x4*)xrow + lane; const f32x4* gr = (const f32x4*)g + lane;
    f32x4 v[4]; float s = 0.f;
#pragma unroll
    for (int j = 0; j < 4; ++j) { v[j] = xr[64 * j]; s += (v[j][0] * v[j][0] + v[j][1] * v[j][1]) + (v[j][2] * v[j][2] + v[j][3] * v[j][3]); }
    const float rs = 1.0f / sqrtf(wave_sum(s) * (1.f / D) + EPS);
    unsigned long long* o8 = (unsigned long long*)orow + lane;
#pragma unroll
    for (int j = 0; j < 4; ++j) { const f32x4 gg = gr[64 * j]; o8[64 * j] = (unsigned long long)pk2(v[j][0] * rs * gg[0], v[j][1] * rs * gg[1]) | ((unsigned long long)pk2(v[j][2] * rs * gg[2], v[j][3] * rs * gg[3]) << 32); }
}


__device__ __forceinline__ void quant_row_fp8(const float* srow, unsigned char* drow, float* inv_scale, int lane, const float* gcol = nullptr) {
    const f32x4* xr = (const f32x4*)srow + lane;
    f32x4 v[4]; float am = 0.f;
#pragma unroll
    for (int j = 0; j < 4; ++j) { v[j] = xr[64 * j]; if (gcol) v[j] = v[j] * ((const f32x4*)gcol + lane)[64 * j]; am = fmaxf(am, fmaxf(fmaxf(fabsf(v[j][0]), fabsf(v[j][1])), fmaxf(fabsf(v[j][2]), fabsf(v[j][3])))); }
    am = wave_max(am);
    int k = 0;
    if (am > 0.f) { k = (int)floorf(log2f(224.0f / am)); k = k < -100 ? -100 : (k > 100 ? 100 : k); }
    const float sc = ldexpf(1.0f, k), isc = ldexpf(1.0f, -k);
    v4u o;
    { int w = __builtin_amdgcn_cvt_pk_fp8_f32(v[0][0] * sc, v[0][1] * sc, 0, false); w = __builtin_amdgcn_cvt_pk_fp8_f32(v[0][2] * sc, v[0][3] * sc, w, true); o.x = (unsigned)w; }
    { int w = __builtin_amdgcn_cvt_pk_fp8_f32(v[1][0] * sc, v[1][1] * sc, 0, false); w = __builtin_amdgcn_cvt_pk_fp8_f32(v[1][2] * sc, v[1][3] * sc, w, true); o.y = (unsigned)w; }
    { int w = __builtin_amdgcn_cvt_pk_fp8_f32(v[2][0] * sc, v[2][1] * sc, 0, false); w = __builtin_amdgcn_cvt_pk_fp8_f32(v[2][2] * sc, v[2][3] * sc, w, true); o.z = (unsigned)w; }
    { int w = __builtin_amdgcn_cvt_pk_fp8_f32(v[3][0] * sc, v[3][1] * sc, 0, false); w = __builtin_amdgcn_cvt_pk_fp8_f32(v[3][2] * sc, v[3][3] * sc, w, true); o.w = (unsigned)w; }
    *((v4u*)drow + lane) = o;
    if (lane == 0) *inv_scale = isc;
}
__device__ __forceinline__ void quant_row_fp8_cp(const float* srow, unsigned char* tab, int e, float* inv_scale, int lane, const float* gcol = nullptr) {
    const f32x4* xr = (const f32x4*)(srow + 16 * lane);
    f32x4 v[4]; float am = 0.f;
#pragma unroll
    for (int q = 0; q < 4; ++q) { v[q] = xr[q]; if (gcol) v[q] = v[q] * ((const f32x4*)(gcol + 16 * lane))[q]; am = fmaxf(am, fmaxf(fmaxf(fabsf(v[q][0]), fabsf(v[q][1])), fmaxf(fabsf(v[q][2]), fabsf(v[q][3])))); }
    am = wave_max(am);
    int k = 0;
    if (am > 0.f) { k = (int)floorf(log2f(224.0f / am)); k = k < -100 ? -100 : (k > 100 ? 100 : k); }
    const float sc = ldexpf(1.0f, k), isc = ldexpf(1.0f, -k);
    v4u o;
    { int w = __builtin_amdgcn_cvt_pk_fp8_f32(v[0][0] * sc, v[0][1] * sc, 0, false); w = __builtin_amdgcn_cvt_pk_fp8_f32(v[0][2] * sc, v[0][3] * sc, w, true); o.x = (unsigned)w; }
    { int w = __builtin_amdgcn_cvt_pk_fp8_f32(v[1][0] * sc, v[1][1] * sc, 0, false); w = __builtin_amdgcn_cvt_pk_fp8_f32(v[1][2] * sc, v[1][3] * sc, w, true); o.y = (unsigned)w; }
    { int w = __builtin_amdgcn_cvt_pk_fp8_f32(v[2][0] * sc, v[2][1] * sc, 0, false); w = __builtin_amdgcn_cvt_pk_fp8_f32(v[2][2] * sc, v[2][3] * sc, w, true); o.z = (unsigned)w; }
    { int w = __builtin_amdgcn_cvt_pk_fp8_f32(v[3][0] * sc, v[3][1] * sc, 0, false); w = __builtin_amdgcn_cvt_pk_fp8_f32(v[3][2] * sc, v[3][3] * sc, w, true); o.w = (unsigned)w; }
    *(v4u*)(tab + ((size_t)(lane >> 3) * PNE_ROWS + e) * 128 + (lane & 7) * 16) = o;
    if (lane == 0) *inv_scale = isc;
}
__device__ __forceinline__ void quant_row_i8_cp_fin(f32x4 (&v)[4], unsigned char* tab, int e, float* inv_scale, int lane, const float* gcol) {
    float am = 0.f;
#pragma unroll
    for (int q = 0; q < 4; ++q) { if (gcol) v[q] = v[q] * ((const f32x4*)(gcol + 16 * lane))[q]; am = fmaxf(am, fmaxf(fmaxf(fabsf(v[q][0]), fabsf(v[q][1])), fmaxf(fabsf(v[q][2]), fabsf(v[q][3])))); }
    am = wave_max(am);
    const float sc = am > 0.f ? 127.0f / am : 0.f;
    unsigned w[4];
#pragma unroll
    for (int q = 0; q < 4; ++q) { const int q0 = (int)rintf(v[q][0] * sc), q1 = (int)rintf(v[q][1] * sc), q2 = (int)rintf(v[q][2] * sc), q3 = (int)rintf(v[q][3] * sc);
        w[q] = (unsigned)(q0 & 0xff) | ((unsigned)(q1 & 0xff) << 8) | ((unsigned)(q2 & 0xff) << 16) | ((unsigned)(q3 & 0xff) << 24); }
    *(v4u*)(tab + ((size_t)(lane >> 3) * PNE_ROWS + e) * 128 + (lane & 7) * 16) = (v4u){w[0], w[1], w[2], w[3]};
    if (lane == 0) *inv_scale = am * (1.0f / 127.0f);
}
__device__ __forceinline__ void quant_row_i8_slices(f32x4 (&v)[4], unsigned char* tab, int e, float* inv_scale, int lane) {
    float am = 0.f;
#pragma unroll
    for (int q = 0; q < 4; ++q) am = fmaxf(am, fmaxf(fmaxf(fabsf(v[q][0]), fabsf(v[q][1])), fmaxf(fabsf(v[q][2]), fabsf(v[q][3]))));
    am = wave_max(am);
    const float sc = am > 0.f ? 127.0f / am : 0.f;
    unsigned w[4];
#pragma unroll
    for (int q = 0; q < 4; ++q) { const int q0 = (int)rintf(v[q][0] * sc), q1 = (int)rintf(v[q][1] * sc), q2 = (int)rintf(v[q][2] * sc), q3 = (int)rintf(v[q][3] * sc);
        w[q] = (unsigned)(q0 & 0xff) | ((unsigned)(q1 & 0xff) << 8) | ((unsigned)(q2 & 0xff) << 16) | ((unsigned)(q3 & 0xff) << 24); }
    *(v2u*)(tab + ((size_t)(2 * lane) * PNE_ROWS + e) * 8) = (v2u){w[0], w[1]};
    *(v2u*)(tab + ((size_t)(2 * lane + 1) * PNE_ROWS + e) * 8) = (v2u){w[2], w[3]};
    if (lane == 0) *inv_scale = am * (1.0f / 127.0f);
}
typedef float f32x2 __attribute__((ext_vector_type(2)));
typedef unsigned v4u_raw __attribute__((__vector_size__(16)));
typedef unsigned v2u_raw __attribute__((__vector_size__(8)));
__device__ __forceinline__ void fp8x16_to_f32(const v4u w, float* f) {
    f32x2 t;
    t = __builtin_amdgcn_cvt_pk_f32_fp8((int)w.x, false); f[0] = t.x; f[1] = t.y; t = __builtin_amdgcn_cvt_pk_f32_fp8((int)w.x, true); f[2] = t.x; f[3] = t.y;
    t = __builtin_amdgcn_cvt_pk_f32_fp8((int)w.y, false); f[4] = t.x; f[5] = t.y; t = __builtin_amdgcn_cvt_pk_f32_fp8((int)w.y, true); f[6] = t.x; f[7] = t.y;
    t = __builtin_amdgcn_cvt_pk_f32_fp8((int)w.z, false); f[8] = t.x; f[9] = t.y; t = __builtin_amdgcn_cvt_pk_f32_fp8((int)w.z, true); f[10] = t.x; f[11] = t.y;
    t = __builtin_amdgcn_cvt_pk_f32_fp8((int)w.w, false); f[12] = t.x; f[13] = t.y; t = __builtin_amdgcn_cvt_pk_f32_fp8((int)w.w, true); f[14] = t.x; f[15] = t.y;
}

__device__ __forceinline__ float gelu_f(float v) {
    const float av = fabsf(v), t = __builtin_amdgcn_rcpf(av * 0.2316418882f + 1.0f);
    float q = t * 0.5307027145f + (-0.7265760135f); q = q * t + 0.7107068705f; q = q * t + (-0.142248368f); q = q * t + 0.127414796f; q = q * t;
    const float e = __builtin_amdgcn_exp2f((v * v) * (-0.72134752044f));
    const float m = v * (q * e);
    return v < 0.f ? m : v - m;
}
__device__ __forceinline__ float gamma_of(int h) { return 1.0f - exp2f(-5.0f - (float)h); }

__global__ void __launch_bounds__(NTHREADS, 2) mega(Args args) {
    extern __shared__ __attribute__((aligned(16))) unsigned char lds[];
    Frame F;
    F.lds = lds; F.tid = threadIdx.x; F.lane = F.tid & 63; F.wave = __builtin_amdgcn_readfirstlane(F.tid >> 6);
    F.G = gridDim.x; F.gw = blockIdx.x * NWAVES + F.wave; F.NGW = F.G * NWAVES; F.gt = blockIdx.x * NTHREADS + F.tid; F.NGT = F.G * NTHREADS;
    unsigned char* ws = args.ws;
    const float* x = args.in[0]; const float* p = args.in[1]; const float* g_mix = args.in[2]; const float* w_in = args.in[3];
    const float* conv_w = args.in[4]; const float* conv_b = args.in[5]; const float* w_ret_up = args.in[6]; const float* w_conv_up = args.in[7];
    const float* w_out = args.in[8]; const float* g_ffn = args.in[9]; const float* w_peer_q = args.in[10]; const float* peer_k1 = args.in[11];
    const float* peer_k2 = args.in[12]; const float* peer_u = args.in[13]; const float* peer_v = args.in[14]; const float* g_ple = args.in[15];
    const float* w_ple_proj = args.in[16]; const float* w_ple_gate = args.in[17]; const float* g_final = args.in[18];
    float* out = args.out;
    float* COS = (float*)(ws + WS_COS); float* SIN = (float*)(ws + WS_SIN);
    bf16* WIN = (bf16*)(ws + WS_WIN); bf16* WRU = (bf16*)(ws + WS_WRU); bf16* WCU = (bf16*)(ws + WS_WCU); bf16* WOUT = (bf16*)(ws + WS_WOUT);
    bf16* WPQ = (bf16*)(ws + WS_WPQ); bf16* WPP = (bf16*)(ws + WS_WPP); bf16* K1 = (bf16*)(ws + WS_K1); bf16* K2 = (bf16*)(ws + WS_K2); bf16* WPG = (bf16*)(ws + WS_WPG);
    unsigned char* U8 = ws + WS_UB; unsigned char* V8 = ws + WS_VB;
    float* SU = (float*)(ws + 128 * 1024); float* SV = (float*)(ws + 256 * 1024);
    float* SS2 = (float*)(ws + 80 * MiB);
    float* RS2 = (float*)(ws + 512 * 1024);
    unsigned* KK = (unsigned*)(ws + WS_BIG + 64 * MiB);
    float* SSP = (float*)(ws + WS_BIG + 80 * MiB);
    float* WSC = (float*)(ws + 82 * MiB);
    unsigned* WCNT = (unsigned*)(ws + 32 * 1024);
    float* PACT = (float*)(ws + WS_PREV);
    float* SS1 = (float*)(ws + WS_COS);
    float* SS3 = (float*)(ws + WS_IDX);
    bf16* XN = (bf16*)(ws + WS_XN); bf16* BIG = (bf16*)(ws + WS_BIG); bf16* PREV = (bf16*)(ws + WS_PREV); bf16* ARET = (bf16*)(ws + WS_ARET);
    int* IDX = (int*)(ws + WS_IDX); float* GATE = (float*)(ws + WS_GATE);
    bf16* CB = BIG;
    bf16* UU = BIG + (size_t)T * 1024;
    bf16* ACONV = CB;
    bf16* GATES = BIG + (size_t)T * 2048;
    bf16* M1 = UU;
    bf16* HB = XN;
    bf16* PB = (bf16*)(ws + 48 * MiB);
    bf16* QP = PREV;
    bf16* PLEB = BIG;
    bf16* H3B = BIG + (size_t)T * 1024;
    PG8_LAS unsigned char* ldsl = (PG8_LAS unsigned char*)lds;

    const int lo = args.ph_lo, hi = args.ph_hi;
#if MK_ONE_LAUNCH
    cg::grid_group grid = cg::this_grid();
    volatile LAS unsigned* lctl = (volatile LAS unsigned*)((LAS unsigned char*)lds + LDS_BYTES - 64);
    if (F.tid < 16) lctl[F.tid] = 0u;
    __syncthreads();
    const XcdBarrier xbar = xcd_barrier_post((unsigned*)(ws + WS_CTL), lctl);
#define SEAM(k) do { if ((k) + 1 < hi) { if ((k) == 0) grid.sync(); else xcd_barrier(xbar); } } while (0)
#else
#define SEAM(k) do { } while (0)
#endif
#define IN(k) (lo <= (k) && (k) < hi)

    if (IN(0)) {
        float* scr = (float*)(lds + F.wave * 16384);
        constexpr int I_IN = (D / 64) * (INW / 32), I_SQ = (D / 64) * (D / 32), I_PQ = (D / 64) * (2048 / 32), I_PP = (PLE / 64) * (D / 32);
        constexpr int NITEMS = I_IN + 4 * I_SQ + I_PQ + I_PP;
        for (int it = F.gw; it < NITEMS; it += F.NGW) {
            int r = it;
            if (r < I_IN) { p0_transpose_item(w_in, D, INW, WIN, scr, r, F.lane, nullptr, true); continue; } r -= I_IN;
            if (r < I_SQ) { p0_transpose_item(w_ret_up, D, D, WRU, scr, r, F.lane); continue; } r -= I_SQ;
            if (r < I_SQ) { p0_transpose_item(w_conv_up, D, D, WCU, scr, r, F.lane); continue; } r -= I_SQ;
            if (r < I_SQ) { p0_transpose_item(w_out, D, D, WOUT, scr, r, F.lane); continue; } r -= I_SQ;
            if (r < I_SQ) { p0_transpose_item(w_ple_gate, D, D, WPG, scr, r, F.lane, g_ple); continue; } r -= I_SQ;
            if (r < I_PQ) { p0_transpose_item(w_peer_q, D, 2048, WPQ, scr, r, F.lane, g_ffn); continue; } r -= I_PQ;
            p0_transpose_item(w_ple_proj, PLE, D, WPP, scr, r, F.lane);
        }
        cvt_f32_bf16(F, p, PB, (size_t)T * PLE);
        cvt_f32_bf16(F, peer_k1, K1, (size_t)PH * PNK * PHALF);
        cvt_f32_bf16(F, peer_k2, K2, (size_t)PH * PNK * PHALF);
        for (int r = F.gw; r < PNE; r += F.NGW) {
            f32x4 vu[4], vv[4];
#pragma unroll
            for (int q = 0; q < 4; ++q) { vu[q] = ((const f32x4*)(peer_u + (size_t)r * D + 16 * F.lane))[q]; vv[q] = ((const f32x4*)(peer_v + (size_t)r * D + 16 * F.lane))[q]; }
            quant_row_i8_cp_fin(vu, U8, r, SU + r, F.lane, g_ffn);
            quant_row_i8_slices(vv, V8, r, SV + r, F.lane);
        }
        for (int e = F.gt; e < SEQ * 64; e += F.NGT) { const int s = e >> 6, i = e & 63; const double inv = pow(10000.0, -(double)i / 64.0); const double ang = (double)s * inv; COS[e] = (float)cos(ang); SIN[e] = (float)sin(ang); }
        {
            const f32x4* gr = (const f32x4*)g_mix + F.lane; f32x4 gg[4];
#pragma unroll
            for (int j = 0; j < 4; ++j) gg[j] = gr[64 * j];
            for (int m = F.gw; m < T / 2; m += F.NGW) {
                const int ma = m, mb = m + T / 2;
                const f32x4* xa_ = (const f32x4*)(x + (size_t)ma * D) + F.lane; const f32x4* xb_ = (const f32x4*)(x + (size_t)mb * D) + F.lane;
                f32x4 va[4], vb[4]; float sa = 0.f, sb = 0.f;
#pragma unroll
                for (int j = 0; j < 4; ++j) { va[j] = xa_[64 * j]; vb[j] = xb_[64 * j]; }
#pragma unroll
                for (int j = 0; j < 4; ++j) { sa += (va[j][0] * va[j][0] + va[j][1] * va[j][1]) + (va[j][2] * va[j][2] + va[j][3] * va[j][3]); sb += (vb[j][0] * vb[j][0] + vb[j][1] * vb[j][1]) + (vb[j][2] * vb[j][2] + vb[j][3] * vb[j][3]); }
                const float ra = 1.0f / sqrtf(wave_sum(sa) * (1.f / D) + EPS), rb = 1.0f / sqrtf(wave_sum(sb) * (1.f / D) + EPS);
                unsigned long long* oa = (unsigned long long*)(XN + (size_t)ma * D) + F.lane; unsigned long long* ob = (unsigned long long*)(XN + (size_t)mb * D) + F.lane;
#pragma unroll
                for (int j = 0; j < 4; ++j) {
                    oa[64 * j] = (unsigned long long)pk2(va[j][0] * ra * gg[j][0], va[j][1] * ra * gg[j][1]) | ((unsigned long long)pk2(va[j][2] * ra * gg[j][2], va[j][3] * ra * gg[j][3]) << 32);
                    ob[64 * j] = (unsigned long long)pk2(vb[j][0] * rb * gg[j][0], vb[j][1] * rb * gg[j][1]) | ((unsigned long long)pk2(vb[j][2] * rb * gg[j][2], vb[j][3] * rb * gg[j][3]) << 32); }
            }
        }
        SEAM(0);
    }

    if (IN(1)) {
        pg8::Gemm g{XN, WIN, T, 3072, D, D, 0}; pg8::StaticOrder S; S.init(T, 3072, F.G, (int)blockIdx.x);
        pg8::EpiQKVG E{BIG, COS, SIN};
        pg8::gemm_phase<pg8::EpiQKVG, pg8::StaticOrder, true>(ldsl, g, S, E);
        SEAM(1);
    }

    if (IN(2)) {
        constexpr int KS = 160;
        bf16* kt = (bf16*)lds;
        bf16* vt = kt + 128 * KS;
        LAS const unsigned char* kt3 = (LAS const unsigned char*)lds; LAS const unsigned char* vt3 = kt3 + 128 * KS * 2;
        constexpr int PS = 136;
        bf16* pt = vt + 128 * KS;
        const int r32 = F.lane & 31, hg = F.lane >> 5;
        const int tq = (F.lane & 15) >> 2, tp = F.lane & 3, tcs = (F.lane >> 4) & 1;
        for (int cid = blockIdx.x; cid < BATCH * RH * 8; cid += F.G) {
            const int xg = cid & 7, yg = cid >> 3; const int chn = ((xg * 4 + (yg >> 3)) << 3) | (yg & 7);
            const int es = chn & 7, h = (chn >> 3) & 3, b = chn >> 5;
            const float gam = gamma_of(h), lg = logf(gam), cd = powf(gam, (float)RC);
            v4u kb0[4], kb1[4], kb2[4], kb3[4], vb0, vb1, vb2, vb3;
#define R1_LOAD(kreg, vreg, nn) do { const size_t t0_ = (size_t)b * SEQ + (size_t)(nn) * RC; \
            _Pragma("unroll") for (int q = 0; q < 4; ++q) { const int c = F.tid + q * NTHREADS, j = c >> 4, c8 = c & 15; kreg[q] = *(const v4u*)(BIG + (t0_ + j) * 3072 + RQK + h * RDK + c8 * 8); } \
            { const int j = F.tid >> 2, c8 = F.tid & 3; vreg = *(const v4u*)(BIG + (t0_ + j) * 3072 + 2 * RQK + h * RDV + es * 32 + c8 * 8); } } while (0)
#define R1_STEP(kreg, vreg, knext, vnext, n) do { \
                __syncthreads(); \
                _Pragma("unroll") for (int q = 0; q < 4; ++q) { const int c = F.tid + q * NTHREADS, j = c >> 4, c8 = c & 15; *(v4u*)(kt + j * KS + c8 * 8) = kreg[q]; } \
                { const int j = F.tid >> 2, c8 = F.tid & 3; float f[8]; unpack8(vreg, f);        \
                    v4u z1; z1.x = pk2(f[0] * zv, f[1] * zv); z1.y = pk2(f[2] * zv, f[3] * zv); z1.z = pk2(f[4] * zv, f[5] * zv); z1.w = pk2(f[6] * zv, f[7] * zv); \
                    *(v4u*)(vt + j * KS + c8 * 8) = z1; } \
                if ((n) > 0) { const int up = b * 128 + ((n) - 1) * 4 + h; const int e_ = F.tid >> 4, c8 = F.tid & 15;        \
                    *(v4u*)(PREV + ((size_t)up * 256 + es * 32 + e_) * 128 + c8 * 8) = *(const v4u*)(pt + e_ * PS + c8 * 8); } \
                __syncthreads(); \
                R1_LOAD(knext, vnext, ((n) + 3 < NCH ? (n) + 3 : NCH - 1));        \
                if (F.wave < 4) { \
                    _Pragma("unroll") for (int g = 0; g < 4; ++g) { const int d0 = 32 * F.wave + 8 * g + 4 * hg; v2u o; o.x = pk2(st[4 * g], st[4 * g + 1]); o.y = pk2(st[4 * g + 2], st[4 * g + 3]); \
                        *(v2u*)(pt + r32 * PS + d0) = o; } \
                    f32x16 acc; \
                    _Pragma("unroll") for (int z = 0; z < 16; ++z) acc[z] = 0.f; \
                    _Pragma("unroll") for (int ks = 0; ks < 8; ++ks) { \
                        LAS const unsigned char* ka = kt3 + ((16 * ks + 8 * hg + tq) * KS + 32 * F.wave + 16 * tcs + 4 * tp) * 2; \
                        LAS const unsigned char* va = vt3 + ((16 * ks + 8 * hg + tq) * KS + 16 * tcs + 4 * tp) * 2; \
                        const bf16x8v af = cat8(ds_tr4(ka), ds_tr4(ka + 4 * KS * 2)), bfr = cat8(ds_tr4(va), ds_tr4(va + 4 * KS * 2)); \
                        acc = __builtin_amdgcn_mfma_f32_32x32x16_bf16(af, bfr, acc, 0, 0, 0); } \
                    _Pragma("unroll") for (int z = 0; z < 16; ++z) st[z] = st[z] * cd + acc[z]; \
                } } while (0)
            const float zv = __expf(lg * (float)(RC - 1 - (F.tid >> 2)));
            R1_LOAD(kb0, vb0, 0); R1_LOAD(kb1, vb1, 1); R1_LOAD(kb2, vb2, 2);
            f32x16 st;
#pragma unroll
            for (int z = 0; z < 16; ++z) st[z] = 0.f;
#pragma unroll 1
            for (int n4 = 0; n4 < NCH; n4 += 4) {
                R1_STEP(kb0, vb0, kb3, vb3, n4);
                R1_STEP(kb1, vb1, kb0, vb0, n4 + 1);
                R1_STEP(kb2, vb2, kb1, vb1, n4 + 2);
                R1_STEP(kb3, vb3, kb2, vb2, n4 + 3);
            }
            __syncthreads();
            { const int up = b * 128 + (NCH - 1) * 4 + h; const int e_ = F.tid >> 4, c8 = F.tid & 15;
              *(v4u*)(PREV + ((size_t)up * 256 + es * 32 + e_) * 128 + c8 * 8) = *(const v4u*)(pt + e_ * PS + c8 * 8); }
#undef R1_STEP
#undef R1_LOAD
        }
        SEAM(2);
    }


    if (IN(4)) {
        constexpr int LS = 136;
        bf16* ksN = (bf16*)lds;
        constexpr int VS = 288;
        bf16* vt = ksN + 128 * LS;
        LAS const unsigned char* vt3 = (LAS const unsigned char*)lds + 128 * LS * 2;
        float* stx = (float*)(vt + 128 * VS);
        const int tq = (F.lane & 15) >> 2, tp = F.lane & 3, tcs = (F.lane >> 4) & 1;
        const int r32 = F.lane & 31, hg = F.lane >> 5, iw = F.wave & 3, eh = F.wave >> 2;
        const int i = 32 * iw + r32;
        for (int u = blockIdx.x; u < NUNITS_R; u += F.G) {
            const int h = u & 3, n = (u >> 2) & 31, b = u >> 7; const size_t t0 = (size_t)b * SEQ + (size_t)n * RC;
            const float lg = logf(gamma_of(h));
            __syncthreads();
            bf16* pt = vt;
            for (int c = F.tid; c < 128 * 16; c += NTHREADS) { const int j = c >> 4, c8 = c & 15;
                *(v4u*)(ksN + j * LS + c8 * 8) = *(const v4u*)(BIG + (t0 + j) * 3072 + RQK + h * RDK + c8 * 8); }
            for (int c = F.tid; c < 256 * 16; c += NTHREADS) { const int e_ = c >> 4, c8 = c & 15;
                *(v4u*)(pt + e_ * LS + c8 * 8) = *(const v4u*)(PREV + ((size_t)u * 256 + e_) * 128 + c8 * 8); }
            bf16x8v qf[8];
            { const bf16* qrow = BIG + (t0 + i) * 3072 + h * RDK + 8 * hg;
#pragma unroll
              for (int ks = 0; ks < 8; ++ks) qf[ks] = *(const bf16x8v*)(qrow + 16 * ks); }
            v4u vst[8];
#pragma unroll
            for (int q = 0; q < 8; ++q) { const int c = F.tid + q * NTHREADS, j = c >> 5, c8 = c & 31; vst[q] = *(const v4u*)(BIG + (t0 + j) * 3072 + 2 * RQK + h * RDV + c8 * 8); }
            f32x16 acc[4];
#pragma unroll
            for (int eb = 0; eb < 4; ++eb)
#pragma unroll
                for (int z = 0; z < 16; ++z) acc[eb][z] = 0.f;
            __syncthreads();
            {
                const bf16* pp = pt + (128 * eh + r32) * LS + 8 * hg;
#pragma unroll
                for (int ks = 0; ks < 8; ++ks)
#pragma unroll
                    for (int eb = 0; eb < 4; ++eb) { const bf16x8v a = *(const bf16x8v*)(pp + (32 * eb) * LS + 16 * ks); acc[eb] = __builtin_amdgcn_mfma_f32_32x32x16_bf16(a, qf[ks], acc[eb], 0, 0, 0); }
                const float xi = __expf(lg * (float)(i + 1));
#pragma unroll
                for (int eb = 0; eb < 4; ++eb)
#pragma unroll
                    for (int z = 0; z < 16; ++z) acc[eb][z] *= xi;
            }
            __syncthreads();
#pragma unroll
            for (int q = 0; q < 8; ++q) { const int c = F.tid + q * NTHREADS, j = c >> 5, c8 = c & 31; *(v4u*)(vt + j * VS + c8 * 8) = vst[q]; }
            __syncthreads();
#pragma unroll 1
            for (int jb = 0; jb <= iw; ++jb) {
                f32x16 X;
#pragma unroll
                for (int z = 0; z < 16; ++z) X[z] = 0.f;
#pragma unroll
                for (int ks = 0; ks < 8; ++ks) { const bf16x8v a = *(const bf16x8v*)(ksN + (32 * jb + r32) * LS + 16 * ks + 8 * hg); X = __builtin_amdgcn_mfma_f32_32x32x16_bf16(a, qf[ks], X, 0, 0, 0); }
#pragma unroll
                for (int z = 0; z < 16; ++z) { const int j = 32 * jb + (z & 3) + 8 * (z >> 2) + 4 * hg; const int df = i - j; X[z] = df >= 0 ? X[z] * __expf(lg * (float)df) : 0.f; }
#pragma unroll
                for (int s2 = 0; s2 < 2; ++s2) {
                    v4u pw; pw.x = pk2(X[8 * s2 + 0], X[8 * s2 + 1]); pw.y = pk2(X[8 * s2 + 2], X[8 * s2 + 3]); pw.z = pk2(X[8 * s2 + 4], X[8 * s2 + 5]); pw.w = pk2(X[8 * s2 + 6], X[8 * s2 + 7]);
                    const bf16x8v pf = __builtin_bit_cast(bf16x8v, pw);
#pragma unroll
                    for (int eb = 0; eb < 4; ++eb) {
                        LAS const unsigned char* va = vt3 + ((32 * jb + 16 * s2 + 4 * hg + tq) * VS + 128 * eh + 32 * eb + 16 * tcs + 4 * tp) * 2;
                        acc[eb] = __builtin_amdgcn_mfma_f32_32x32x16_bf16(cat8(ds_tr4(va), ds_tr4(va + 8 * VS * 2)), pf, acc[eb], 0, 0, 0); }
                }
            }
            float s1 = 0.f, s2 = 0.f;
#pragma unroll
            for (int eb = 0; eb < 4; ++eb)
#pragma unroll
                for (int z = 0; z < 16; ++z) { const float v = acc[eb][z]; s1 += v; s2 += v * v; }
            { auto r1 = __builtin_amdgcn_permlane32_swap(__float_as_uint(s1), __float_as_uint(s1), false, false); s1 = __uint_as_float(r1[0]) + __uint_as_float(r1[1]);
              auto r2 = __builtin_amdgcn_permlane32_swap(__float_as_uint(s2), __float_as_uint(s2), false, false); s2 = __uint_as_float(r2[0]) + __uint_as_float(r2[1]); }
            if (hg == 0) { stx[(eh * 128 + i) * 2] = s1; stx[(eh * 128 + i) * 2 + 1] = s2; }
            __syncthreads();
            { const float o1 = stx[((eh ^ 1) * 128 + i) * 2], o2 = stx[((eh ^ 1) * 128 + i) * 2 + 1]; s1 += o1; s2 += o2; }
            const float mu = s1 * (1.f / 256.f); const float var = fmaxf(s2 * (1.f / 256.f) - mu * mu, 0.f); const float rstd = 1.0f / sqrtf(var + EPS);
            {
                constexpr int YS = 264;
                bf16* ys = vt;
#pragma unroll
                for (int eb = 0; eb < 4; ++eb)
#pragma unroll
                    for (int g = 0; g < 4; ++g) { const int ec = 128 * eh + 32 * eb + 8 * g + 4 * hg;
                        v2u o; o.x = pk2((acc[eb][4 * g] - mu) * rstd, (acc[eb][4 * g + 1] - mu) * rstd); o.y = pk2((acc[eb][4 * g + 2] - mu) * rstd, (acc[eb][4 * g + 3] - mu) * rstd);
                        *(v2u*)(ys + i * YS + ec) = o; }
                __syncthreads();
#pragma unroll
                for (int q = 0; q < 8; ++q) { const int c = F.tid + q * NTHREADS, tkn = c >> 5, c8 = c & 31;
                    float yf[8], gf[8]; unpack8(*(const v4u*)(ys + tkn * YS + c8 * 8), yf); unpack8(*(const v4u*)(BIG + (t0 + tkn) * 3072 + 2 * RQK + RV + h * RDV + c8 * 8), gf);
                    float o[8];
#pragma unroll
                    for (int z = 0; z < 8; ++z) o[z] = yf[z] * gf[z] / (1.0f + __expf(-gf[z]));
                    v4u w; w.x = pk2(o[0], o[1]); w.y = pk2(o[2], o[3]); w.z = pk2(o[4], o[5]); w.w = pk2(o[6], o[7]);
                    *(v4u*)(ARET + (t0 + tkn) * 1024 + h * RDV + c8 * 8) = w; }
            }
        }
        SEAM(4);
    }

    if (IN(5)) {
        pg8::Gemm g{XN, WIN + (size_t)3072 * D, T, 5120, D, D, 0}; pg8::StaticOrder S; S.init(T, 5120, F.G, (int)blockIdx.x);
        pg8::EpiConvGates E{CB, UU, GATES};
        pg8::gemm_phase<pg8::EpiConvGates, pg8::StaticOrder, true>(ldsl, g, S, E);
        SEAM(5);
    }

    if (IN(6)) {
        for (int it = F.gt; it < (T / 8) * 128; it += F.NGT) {
            const int c8 = it & 127, t0 = (it >> 7) * 8, s0 = t0 & (SEQ - 1); const int col = c8 * 8;
            v4u uw[10], cw[8];
#pragma unroll
            for (int r = 0; r < 8; ++r) { uw[r + 2] = *(const v4u*)(UU + (size_t)(t0 + r) * 1024 + col); cw[r] = *(const v4u*)(CB + (size_t)(t0 + r) * 1024 + col); }
            if (s0 != 0) { uw[0] = *(const v4u*)(UU + (size_t)(t0 - 2) * 1024 + col); uw[1] = *(const v4u*)(UU + (size_t)(t0 - 1) * 1024 + col); }
            else { uw[0] = (v4u){0u, 0u, 0u, 0u}; uw[1] = (v4u){0u, 0u, 0u, 0u}; }
            float w0[8], w1[8], w2[8], bs[8];
            *(f32x4*)w0 = *(const f32x4*)(conv_w + col); *(f32x4*)(w0 + 4) = *(const f32x4*)(conv_w + col + 4);
            *(f32x4*)w1 = *(const f32x4*)(conv_w + 1024 + col); *(f32x4*)(w1 + 4) = *(const f32x4*)(conv_w + 1024 + col + 4);
            *(f32x4*)w2 = *(const f32x4*)(conv_w + 2048 + col); *(f32x4*)(w2 + 4) = *(const f32x4*)(conv_w + 2048 + col + 4);
            *(f32x4*)bs = *(const f32x4*)(conv_b + col); *(f32x4*)(bs + 4) = *(const f32x4*)(conv_b + col + 4);
            float ua[8], ub[8], uc[8];
            unpack8(uw[0], ua); unpack8(uw[1], ub);
#pragma unroll
            for (int r = 0; r < 8; ++r) {
                float cb[8], o[8]; unpack8(uw[r + 2], uc); unpack8(cw[r], cb);
#pragma unroll
                for (int z = 0; z < 8; ++z) { o[z] = cb[z] * (w0[z] * ua[z] + w1[z] * ub[z] + w2[z] * uc[z] + bs[z]); ua[z] = ub[z]; ub[z] = uc[z]; }
                v4u w; w.x = pk2(o[0], o[1]); w.y = pk2(o[2], o[3]); w.z = pk2(o[4], o[5]); w.w = pk2(o[6], o[7]);
                *(v4u*)(ACONV + (size_t)(t0 + r) * 1024 + col) = w;
            }
        }
        SEAM(6);
    }


    if (IN(8)) {
        pg8::StaticOrder S; S.init(T, D, F.G, (int)blockIdx.x);
        { pg8::Gemm g{ARET, WRU, T, D, D, D, 0}; pg8::EpiGate<false> E{M1, D, GATES, 2048, 0};
          pg8::gemm_phase<pg8::EpiGate<false>, pg8::StaticOrder, true>(ldsl, g, S, E); }
        asm volatile("s_waitcnt vmcnt(0)" ::: "memory"); __syncthreads();
        { pg8::Gemm g{ACONV, WCU, T, D, D, D, 0}; pg8::EpiGate<true> E{M1, D, GATES, 2048, 1024};
          pg8::gemm_phase<pg8::EpiGate<true>, pg8::StaticOrder, true>(ldsl, g, S, E); }
        SEAM(8);
    }

    if (IN(9)) {
        pg8::Gemm g{M1, WOUT, T, D, D, D, 0}; pg8::StaticOrder S; S.init(T, D, F.G, (int)blockIdx.x);
        pg8::EpiResBf16SS E{x, HB, SS1, D};
        pg8::gemm_phase<pg8::EpiResBf16SS, pg8::StaticOrder, true>(ldsl, g, S, E);
        SEAM(9);
    }


    if (IN(11)) {
        { pg8::Gemm g{HB, WPQ, T, 2048, D, D, 0}; pg8::StaticOrder S; S.init(T, 2048, F.G, (int)blockIdx.x);
          pg8::EpiBf16 E{QP, 2048};
          pg8::gemm_phase<pg8::EpiBf16, pg8::StaticOrder, true>(ldsl, g, S, E); }
        { pg8::Gemm g{PB, WPP, T, D, PLE, PLE, 0}; pg8::StaticOrder S; S.init(T, D, F.G, (int)blockIdx.x);
          pg8::EpiBf16 E{PLEB, D};
          pg8::gemm_phase<pg8::EpiBf16, pg8::StaticOrder, true>(ldsl, g, S, E); }
        SEAM(11);
    }

    if (IN(12)) {
        constexpr int LS = 136;
        bf16* k1s = (bf16*)lds; bf16* k2s = k1s + 128 * LS;
        const int h = blockIdx.x & 7;
        __syncthreads();
        for (int c = F.tid; c < 128 * 16; c += NTHREADS) { const int j = c >> 4, c8 = c & 15;
            *(v4u*)(k1s + j * LS + c8 * 8) = *(const v4u*)(K1 + ((size_t)h * 128 + j) * 128 + c8 * 8);
            *(v4u*)(k2s + j * LS + c8 * 8) = *(const v4u*)(K2 + ((size_t)h * 128 + j) * 128 + c8 * 8); }
        __syncthreads();
        const int r32 = F.lane & 31, hg = F.lane >> 5;
        const int nwv = (F.G >> 3) * NWAVES;
        for (int tt = (blockIdx.x >> 3) * NWAVES + F.wave; tt < T / 32; tt += nwv) {
            const int t0 = tt * 32;
            unsigned V1[16], V2[16];
            peer_half_topk(QP + (size_t)(t0 + r32) * 2048 + h * 256 + 8 * hg, k1s + r32 * 136 + 8 * hg, hg, V1);
            __builtin_amdgcn_sched_barrier(0);
            peer_half_topk(QP + (size_t)(t0 + r32) * 2048 + h * 256 + 128 + 8 * hg, k2s + r32 * 136 + 8 * hg, hg, V2);
            __builtin_amdgcn_sched_barrier(0);
            float v1[16], v2[16];
#pragma unroll
            for (int z = 0; z < 16; ++z) { v1[z] = ord_val(V1[z] & ~0x7Fu); v2[z] = ord_val(V2[z] & ~0x7Fu); }
#define CKEY(a, b) ((ord_key(v1[a] + v2[b]) & ~0xFFu) | (unsigned)(255 - ((a) * 16 + (b))))
            unsigned g0[16], g1[16], g2[16], g3[16];
#pragma unroll
            for (int b = 0; b < 16; ++b) g0[b] = CKEY(0, b);
#pragma unroll
            for (int b = 0; b < 8; ++b) g1[b] = CKEY(1, b);
#pragma unroll
            for (int b = 0; b < 5; ++b) g1[8 + b] = CKEY(2, b);
#pragma unroll
            for (int b = 0; b < 3; ++b) g1[13 + b] = CKEY(3, b);
            g2[0] = CKEY(3, 3);
#pragma unroll
            for (int b = 0; b < 3; ++b) g2[1 + b] = CKEY(4, b);
#pragma unroll
            for (int b = 0; b < 2; ++b) { g2[4 + b] = CKEY(5, b); g2[6 + b] = CKEY(6, b); g2[8 + b] = CKEY(7, b); }
#pragma unroll
            for (int a = 8; a < 14; ++a) g2[10 + (a - 8)] = CKEY(a, 0);
            { const unsigned c14 = CKEY(14, 0), c15 = CKEY(15, 0); g3[0] = max(c14, c15); g3[1] = min(c14, c15); }
#pragma unroll
            for (int z = 2; z < 16; ++z) g3[z] = 0u;
#undef CKEY
            sort16_desc(g1); sort16_desc(g2); merge16_desc(g1, g2); merge16_desc(g1, g3); merge16_desc(g0, g1);
            float ts[16], ex[16]; float den = 0.f;
            float rs1;
            { const f32x4* sp = (const f32x4*)(SS1 + (size_t)(t0 + r32) * 16); const f32x4 s0 = sp[0], s1 = sp[1], s2 = sp[2], s3 = sp[3];
              const float ssum = ((s0[0] + s0[1]) + (s0[2] + s0[3])) + ((s1[0] + s1[1]) + (s1[2] + s1[3])) + ((s2[0] + s2[1]) + (s2[2] + s2[3])) + ((s3[0] + s3[1]) + (s3[2] + s3[3]));
              rs1 = 1.0f / sqrtf(ssum * (1.f / D) + EPS); }
#pragma unroll
            for (int z = 0; z < 16; ++z) ts[z] = ord_val(g0[z] & ~0xFFu) * rs1;
#pragma unroll
            for (int z = 0; z < 16; ++z) { ex[z] = __expf(ts[z] - ts[0]); den += ex[z]; }
            const float inv = 1.0f / den;
            int oi[8]; float og[8];
#pragma unroll
            for (int rr = 0; rr < 8; ++rr) {
                unsigned klo = g0[rr], khi = g0[8 + rr]; float elo = ex[rr], ehi = ex[8 + rr];
                asm volatile("" : "+v"(klo), "+v"(khi), "+v"(elo), "+v"(ehi));
                const unsigned key = hg ? khi : klo; const int c = 255 - (int)(key & 0xFFu); const int a = c >> 4, b = c & 15;
                unsigned ka = V1[0], kb2 = V2[0];
#pragma unroll
                for (int z = 1; z < 16; ++z) { ka = (a == z) ? V1[z] : ka; kb2 = (b == z) ? V2[z] : kb2; }
                oi[rr] = (127 - (int)(ka & 0x7Fu)) * PNK + (127 - (int)(kb2 & 0x7Fu));
                og[rr] = (hg ? ehi : elo) * inv;
            }
            int* ip = IDX + (size_t)(t0 + r32) * NSEL + h * PTOPK + 8 * hg; float* gp = GATE + (size_t)(t0 + r32) * NSEL + h * PTOPK + 8 * hg;
            *(v4u*)ip = (v4u){(unsigned)oi[0], (unsigned)oi[1], (unsigned)oi[2], (unsigned)oi[3]}; *(v4u*)(ip + 4) = (v4u){(unsigned)oi[4], (unsigned)oi[5], (unsigned)oi[6], (unsigned)oi[7]};
            *(f32x4*)gp = (f32x4){og[0], og[1], og[2], og[3]}; *(f32x4*)(gp + 4) = (f32x4){og[4], og[5], og[6], og[7]};
        }
        SEAM(12);
    }

    if (IN(13)) {
        volatile int* item_w = (volatile int*)(lds + 1024);
        const int s8 = F.lane & 7, r8 = F.lane >> 3; const int xcc = (int)(xb_xcc_id() & 7u);
        for (;;) {
            __syncthreads();
            if (F.tid == 0) { int it = -1;
                for (int k = 0; k < 8 && it < 0; ++k) { const int jj = (xcc + k) & 7; const unsigned cc = __hip_atomic_fetch_add(WCNT + jj, 1u, __ATOMIC_RELAXED, __HIP_MEMORY_SCOPE_AGENT); if (cc < (unsigned)(T / 64)) it = (jj << 16) | (int)cc; }
                item_w[0] = it; }
            __syncthreads();
            const int item = item_w[0];
            if (item < 0) break;
            const int j = item >> 16, ch = item & 0xffff;
            const unsigned char* tabj = U8 + (size_t)j * PNE_ROWS * 128 + s8 * 16;
            const int tb = ch * 64 + F.wave * 8;
            int ida[8], idb[8]; v4u xa[8], xb[8];
#pragma unroll
            for (int tt = 0; tt < 8; ++tt) { ida[tt] = IDX[(size_t)(tb + tt) * NSEL + F.lane]; idb[tt] = IDX[(size_t)(tb + tt) * NSEL + 64 + F.lane];
                const bf16* xp = HB + (size_t)(tb + tt) * D + 128 * j + 16 * s8; xa[tt] = *(const v4u*)xp; xb[tt] = *(const v4u*)(xp + 8); }
            v4u rowsA[8], rowsB[8];
#define P13_ROWS(buf, tt, hh) do { _Pragma("unroll") for (int g = 0; g < 8; ++g) { const int id = __shfl((hh) ? idb[tt] : ida[tt], 8 * g + r8); buf[g] = *(const v4u*)(tabj + (size_t)id * 128); } } while (0)
#define P13_DOT(buf, hh, xq, sx, pp) do { \
                _Pragma("unroll") for (int g = 0; g < 8; ++g) { int d_ = __builtin_amdgcn_sdot4((int)buf[g].x, xq[0], 0, false); d_ = __builtin_amdgcn_sdot4((int)buf[g].y, xq[1], d_, false); \
                    d_ = __builtin_amdgcn_sdot4((int)buf[g].z, xq[2], d_, false); d_ = __builtin_amdgcn_sdot4((int)buf[g].w, xq[3], d_, false); \
                    pp[8 * (hh) + g] = (float)d_ * sx; } } while (0)
            const bool b4_ = (s8 & 4) != 0, b2_ = (s8 & 2) != 0, b1_ = (s8 & 1) != 0;
            P13_ROWS(rowsA, 0, 0);
#pragma unroll
            for (int tt = 0; tt < 8; ++tt) {
                float xf[16]; unpack8(xa[tt], xf); unpack8(xb[tt], xf + 8); float pp[16];
                P13_ROWS(rowsB, tt, 1);
                float am = 0.f;
#pragma unroll
                for (int z = 0; z < 16; ++z) am = fmaxf(am, fabsf(xf[z]));
                am = fmaxf(am, __shfl_xor(am, 1)); am = fmaxf(am, __shfl_xor(am, 2)); am = fmaxf(am, __shfl_xor(am, 4));
                const float qs = am > 0.f ? 127.0f / am : 0.f, sx = am * (1.0f / 127.0f);
                int xq[4];
#pragma unroll
                for (int q = 0; q < 4; ++q) { const int q0 = (int)rintf(xf[4 * q] * qs), q1 = (int)rintf(xf[4 * q + 1] * qs), q2 = (int)rintf(xf[4 * q + 2] * qs), q3 = (int)rintf(xf[4 * q + 3] * qs);
                    xq[q] = (int)((unsigned)(q0 & 0xff) | ((unsigned)(q1 & 0xff) << 8) | ((unsigned)(q2 & 0xff) << 16) | ((unsigned)(q3 & 0xff) << 24)); }
                P13_DOT(rowsA, 0, xq, sx, pp); __builtin_amdgcn_sched_barrier(0);
                if (tt < 7) P13_ROWS(rowsA, tt + 1, 0);
                P13_DOT(rowsB, 1, xq, sx, pp);
                float a8[8], a4[4], a2[2];
#pragma unroll
                for (int g = 0; g < 8; ++g) { const float keep = b4_ ? pp[g + 8] : pp[g], give = b4_ ? pp[g] : pp[g + 8]; a8[g] = keep + __shfl_xor(give, 4); }
#pragma unroll
                for (int g = 0; g < 4; ++g) { const float keep = b2_ ? a8[g + 4] : a8[g], give = b2_ ? a8[g] : a8[g + 4]; a4[g] = keep + __shfl_xor(give, 2); }
#pragma unroll
                for (int g = 0; g < 2; ++g) { const float keep = b1_ ? a4[g + 2] : a4[g], give = b1_ ? a4[g] : a4[g + 2]; a2[g] = keep + __shfl_xor(give, 1); }
                float* pa = PACT + ((size_t)j * T + (tb + tt)) * NSEL + 16 * s8 + r8; pa[0] = a2[0]; pa[8] = a2[1];
                __builtin_amdgcn_sched_barrier(0);
            }
#undef P13_ROWS
#undef P13_DOT
        }
        SEAM(13);
    }

    if (IN(14)) {
        unsigned* tl = (unsigned*)lds;
        for (int ch = blockIdx.x; ch < T / 64; ch += F.G) {
            __syncthreads();
#pragma unroll 1
            for (int tt = 0; tt < 8; ++tt) {
                const int tloc = F.wave * 8 + tt, t = ch * 64 + tloc;
                float ssum = 0.f;
                if (F.lane < 16) ssum = SS1[(size_t)t * 16 + F.lane];
                ssum = wave_sum(ssum);
                const float rs1 = 1.0f / sqrtf(ssum * (1.f / D) + EPS);
                float a0 = 0.f, a1 = 0.f;
#pragma unroll
                for (int j = 0; j < 8; ++j) { const float* pa = PACT + ((size_t)j * T + t) * NSEL + F.lane; a0 += pa[0]; a1 += pa[64]; }
                const int id0 = IDX[(size_t)t * NSEL + F.lane], id1 = IDX[(size_t)t * NSEL + 64 + F.lane];
                const float g0 = GATE[(size_t)t * NSEL + F.lane], g1 = GATE[(size_t)t * NSEL + 64 + F.lane];
                const float w0 = g0 * gelu_f(a0 * rs1 * SU[id0]) * SV[id0], w1 = g1 * gelu_f(a1 * rs1 * SU[id1]) * SV[id1];
                const float am = wave_max(fmaxf(fabsf(w0), fabsf(w1))); const float qs = am > 0.f ? 127.0f / am : 0.f;
                tl[F.lane * 65 + tloc] = ((unsigned)id0 << 11) | ((unsigned)((int)rintf(w0 * qs)) & 0xffu);
                tl[(64 + F.lane) * 65 + tloc] = ((unsigned)id1 << 11) | ((unsigned)((int)rintf(w1 * qs)) & 0xffu);
                if (F.lane == 0) WSC[t] = am * (1.0f / 127.0f);
            }
            __syncthreads();
#pragma unroll
            for (int q = 0; q < 16; ++q) { const int c = F.tid + q * NTHREADS, e_ = c >> 6, tl_ = c & 63; KK[(size_t)e_ * T + ch * 64 + tl_] = tl[e_ * 65 + tl_]; }
        }
        SEAM(14);
    }

    if (IN(7)) {
        LAS const unsigned char* vl3 = (LAS const unsigned char*)lds;
        const __amdgpu_buffer_rsrc_t rsK = __builtin_amdgcn_make_buffer_rsrc((void*)KK, 0, NSEL * T * 4, 0x00020000);
        for (int work = blockIdx.x; work < 256; work += F.G) {
            const int sl = work >> 1, tbase = (work & 1) * (T / 2);
            __syncthreads();
            for (int c = F.tid; c < PNE_ROWS * 8 / 16; c += NTHREADS) *((v4u*)lds + c) = *((const v4u*)(V8 + (size_t)sl * PNE_ROWS * 8) + c);
            __syncthreads();
#pragma unroll 1
            for (int grp = F.wave; grp < T / 2 / 64; grp += NWAVES) {
                const int t = tbase + grp * 64 + F.lane;
                const int kvo = t * 4;
                int acci[8];
#pragma unroll
                for (int z = 0; z < 8; ++z) acci[z] = 0;
                unsigned kc[2][32];
#pragma unroll
                for (int q = 0; q < 32; ++q) kc[0][q] = __builtin_amdgcn_raw_buffer_load_b32(rsK, kvo, q * (T * 4), 0);
#pragma unroll
                for (int ck = 0; ck < 4; ++ck) {
                    if (ck < 3) {
#pragma unroll
                        for (int q = 0; q < 32; ++q) kc[(ck + 1) & 1][q] = __builtin_amdgcn_raw_buffer_load_b32(rsK, kvo, (32 * (ck + 1) + q) * (T * 4), 0);
                    }
#pragma unroll
                    for (int e8 = 0; e8 < 4; ++e8) {
                        v2u vr[8];
#pragma unroll
                        for (int q = 0; q < 8; ++q) vr[q] = *(const LAS v2u*)(vl3 + (kc[ck & 1][8 * e8 + q] >> 8));
#pragma unroll
                        for (int g4 = 0; g4 < 2; ++g4) {
                            const unsigned k0 = kc[ck & 1][8 * e8 + 4 * g4], k1 = kc[ck & 1][8 * e8 + 4 * g4 + 1], k2 = kc[ck & 1][8 * e8 + 4 * g4 + 2], k3 = kc[ck & 1][8 * e8 + 4 * g4 + 3];
                            const unsigned w01_ = __builtin_amdgcn_perm(k1, k0, 0x0c0c0400u), w23_ = __builtin_amdgcn_perm(k3, k2, 0x0c0c0400u); const int w4_ = (int)__builtin_amdgcn_perm(w23_, w01_, 0x05040100u);
#pragma unroll
                            for (int c4 = 0; c4 < 2; ++c4) { const unsigned a_ = vr[4 * g4][c4], b_ = vr[4 * g4 + 1][c4], c_ = vr[4 * g4 + 2][c4], d_ = vr[4 * g4 + 3][c4];
                                const unsigned t0_ = __builtin_amdgcn_perm(b_, a_, 0x05010400u), t1_ = __builtin_amdgcn_perm(b_, a_, 0x07030602u), t2_ = __builtin_amdgcn_perm(d_, c_, 0x05010400u), t3_ = __builtin_amdgcn_perm(d_, c_, 0x07030602u);
                                acci[4 * c4 + 0] = __builtin_amdgcn_sdot4((int)__builtin_amdgcn_perm(t2_, t0_, 0x05040100u), w4_, acci[4 * c4 + 0], false);
                                acci[4 * c4 + 1] = __builtin_amdgcn_sdot4((int)__builtin_amdgcn_perm(t2_, t0_, 0x07060302u), w4_, acci[4 * c4 + 1], false);
                                acci[4 * c4 + 2] = __builtin_amdgcn_sdot4((int)__builtin_amdgcn_perm(t3_, t1_, 0x05040100u), w4_, acci[4 * c4 + 2], false);
                                acci[4 * c4 + 3] = __builtin_amdgcn_sdot4((int)__builtin_amdgcn_perm(t3_, t1_, 0x07060302u), w4_, acci[4 * c4 + 3], false); }
                        }
                    }
                }
                const float wsc = WSC[t];
                v4u* hp = (v4u*)(HB + (size_t)t * D + 8 * sl);
                float hf[8]; unpack8(*hp, hf);
                float ssq = 0.f;
#pragma unroll
                for (int z = 0; z < 8; ++z) { hf[z] += (float)acci[z] * wsc; ssq += hf[z] * hf[z]; }
                v4u o; o.x = pk2(hf[0], hf[1]); o.y = pk2(hf[2], hf[3]); o.z = pk2(hf[4], hf[5]); o.w = pk2(hf[6], hf[7]);
                *hp = o;
                SSP[(size_t)sl * T + t] = ssq;
            }
        }
        SEAM(7);
    }

    if (IN(10)) {
        for (int t = F.gt; t < T; t += F.NGT) { float s_ = 0.f;
#pragma unroll 16
            for (int sl = 0; sl < 128; ++sl) s_ += SSP[(size_t)sl * T + t];
            RS2[t] = 1.0f / sqrtf(s_ * (1.f / D) + EPS); }
        SEAM(10);
    }


    if (IN(15)) {
        pg8::Gemm g{HB, WPG, T, D, D, D, 0}; pg8::StaticOrder S; S.init(T, D, F.G, (int)blockIdx.x);
        pg8::EpiPleBf16SS E{HB, PLEB, H3B, RS2, SS3, D};
        pg8::gemm_phase<pg8::EpiPleBf16SS, pg8::StaticOrder, true>(ldsl, g, S, E);
        SEAM(15);
    }

    if (IN(16)) {
        const f32x4* gr = (const f32x4*)g_final + F.lane;
        f32x4 gg[4];
#pragma unroll
        for (int j = 0; j < 4; ++j) gg[j] = gr[64 * j];
        for (int m = F.gw; m < T / 2; m += F.NGW) {
            const int ma = m, mb = m + T / 2;
            float sa = 0.f, sb = 0.f;
            if (F.lane < 16) { sa = SS3[(size_t)ma * 16 + F.lane]; sb = SS3[(size_t)mb * 16 + F.lane]; }
            const v2u* ha = (const v2u*)(H3B + (size_t)ma * D) + F.lane; const v2u* hb = (const v2u*)(H3B + (size_t)mb * D) + F.lane;
            v2u wa[4], wb[4];
#pragma unroll
            for (int j = 0; j < 4; ++j) { wa[j] = ha[64 * j]; wb[j] = hb[64 * j]; }
            sa = wave_sum(sa); sb = wave_sum(sb);
            const float ra = 1.0f / sqrtf(sa * (1.f / D) + EPS), rb = 1.0f / sqrtf(sb * (1.f / D) + EPS);
            f32x4* oa = (f32x4*)(out + (size_t)ma * D) + F.lane; f32x4* ob = (f32x4*)(out + (size_t)mb * D) + F.lane;
#pragma unroll
            for (int j = 0; j < 4; ++j) {
                oa[64 * j] = (f32x4){bflo(wa[j].x) * ra * gg[j][0], bfhi(wa[j].x) * ra * gg[j][1], bflo(wa[j].y) * ra * gg[j][2], bfhi(wa[j].y) * ra * gg[j][3]};
                ob[64 * j] = (f32x4){bflo(wb[j].x) * rb * gg[j][0], bfhi(wb[j].x) * rb * gg[j][1], bflo(wb[j].y) * rb * gg[j][2], bfhi(wb[j].y) * rb * gg[j][3]}; }
        }
    }
#undef IN
#undef SEAM
}

constexpr int N_PHASES = 17;

extern "C" void kernel_launch(void* const* d_in, const int* in_sizes, int n_in, void* d_out, int out_size, void* d_ws, size_t ws_size, hipStream_t stream) {
    static int grid = 0;
    if (grid == 0) {
        if (n_in != 19 || out_size != T * D || ws_size < WS_END) { fprintf(stderr, "kernel_launch: unexpected shapes: n_in %d out %d ws %zu\n", n_in, out_size, ws_size); grid = -1; return; }
        int dev = 0, cus = 0, per_cu = 0;
        hipGetDevice(&dev); hipDeviceGetAttribute(&cus, hipDeviceAttributeMultiprocessorCount, dev);
        if (hipFuncSetAttribute((const void*)mega, hipFuncAttributeMaxDynamicSharedMemorySize, LDS_BYTES) != hipSuccess) { fprintf(stderr, "kernel_launch: hipFuncSetAttribute failed\n"); grid = -1; return; }
        if (hipOccupancyMaxActiveBlocksPerMultiprocessor(&per_cu, (const void*)mega, NTHREADS, LDS_BYTES) != hipSuccess || per_cu < 1) { fprintf(stderr, "kernel_launch: occupancy query says %d\n", per_cu); per_cu = 1; }
        (void)hipGetLastError();
        grid = cus;
        if (grid % 8 != 0) fprintf(stderr, "kernel_launch: grid %d not a multiple of 8\n", grid);
    }
    if (grid < 0) return;
    Args a{};
    for (int i = 0; i < 19; ++i) a.in[i] = (const float*)d_in[i];
    a.out = (float*)d_out; a.ws = (unsigned char*)d_ws;
#if MK_ONE_LAUNCH
    a.ph_lo = 0; a.ph_hi = N_PHASES;
    if (hipMemsetAsync((char*)d_ws + WS_CTL, 0, CTL_ZERO_BYTES, stream) != hipSuccess) { fprintf(stderr, "kernel_launch: memset failed\n"); return; }
    void* kargs[] = {&a};
    hipError_t e = hipLaunchCooperativeKernel((const void*)mega, dim3(grid), dim3(NTHREADS), kargs, LDS_BYTES, stream);
    if (e != hipSuccess) fprintf(stderr, "cooperative launch failed: %s (grid %d)\n", hipGetErrorString(e), grid);
#else
    for (int ph = 0; ph < N_PHASES; ++ph) {
        a.ph_lo = ph; a.ph_hi = ph + 1;
        hipLaunchKernelGGL(mega, dim3(grid), dim3(NTHREADS), LDS_BYTES, stream, a);
    }
#endif
}
```

```cpp
#include <hip/hip_runtime.h>
#include <hip/hip_cooperative_groups.h>
#include <cstdio>
#include <cstdint>
#include <cmath>
namespace cg = cooperative_groups;

#ifndef MK_ONE_LAUNCH
#define MK_ONE_LAUNCH 1
#endif

namespace pg8 {
#define PG8_LAS __attribute__((address_space(3)))
typedef unsigned short bf16_t;
typedef short bf16x8 __attribute__((ext_vector_type(8)));
typedef float f32x4 __attribute__((ext_vector_type(4)));
typedef unsigned u32x4 __attribute__((ext_vector_type(4)));
typedef unsigned u32x2 __attribute__((ext_vector_type(2)));
constexpr int BM = 256, BK = 64, HALF = 128, HTB = HALF * BK * 2, STAGE_BYTES = 8 * HTB, NXCD = 8, WGM = 8;

__host__ __device__ __forceinline__ int lds_byte(int r, int c) { const int st = (r >> 4) * 2 + (c >> 5), rr = r & 15, cc = c & 31, ob = rr * 64 + cc * 2; return st * 1024 + (ob ^ (((ob >> 9) & 1) << 5)); }
__host__ __device__ __forceinline__ void stage_rc(int b, int& R, int& C) { const int st = b / 1024, sb = b % 1024, swz = sb ^ (((sb >> 9) & 1) << 5); R = (st >> 1) * 16 + swz / 64; C = (st & 1) * 32 + (swz % 64) / 2; }
__host__ __device__ __forceinline__ int perm32(int rho) { const int n = rho >> 4, i = rho & 15; return 8 * (i >> 2) + 4 * n + (i & 3); }

struct Unit { int pm, pn; };
struct Gemm { const bf16_t* A; const bf16_t* Bt; int M, N, K, lda, a_pn_cols, a_slices = 0; };

struct StaticOrder {
    int nM, nN, nwg, G, c;
    __host__ __device__ void init(int M, int N, int G_, int c_) { nM = M / BM; nN = N / BM; nwg = nM * nN; G = G_; c = c_; }
    __host__ __device__ bool next(int i, Unit& u) const {
        const long L = (long)i * G + c; if (L >= nwg) return false;
        int wgid = (int)L; { const int q = nwg / NXCD, r = nwg % NXCD, xcd = wgid % NXCD, off = wgid / NXCD; wgid = (xcd < r ? xcd * (q + 1) : r * (q + 1) + (xcd - r) * q) + off; }
        const int nig = WGM * nN, gid = wgid / nig, fm = gid * WGM, gsz = (nM - fm) < WGM ? (nM - fm) : WGM;
        u.pm = fm + ((wgid % nig) % gsz); u.pn = (wgid % nig) / gsz; return true;
    }
    __device__ __forceinline__ void a_ready(const Unit&) const {}
    __device__ __forceinline__ void done(const Unit&) const {}
};

__device__ __forceinline__ unsigned cvt_pk_bf16(float lo, float hi) { unsigned r; asm volatile("v_cvt_pk_bf16_f32 %0, %1, %2" : "=v"(r) : "v"(lo), "v"(hi)); return r; }
__device__ __forceinline__ float bf_lo(unsigned w) { return __uint_as_float(w << 16); }
__device__ __forceinline__ float bf_hi(unsigned w) { return __uint_as_float(w & 0xffff0000u); }
__device__ __forceinline__ float sigmoidf_(float x) { return 1.0f / (1.0f + __expf(-x)); }

struct EpiBf16 {
    static constexpr bool PERM = true, AFTER_DRAIN = false;
    bf16_t* O; int ldc;
    __device__ __forceinline__ void operator()(const f32x4 (&acc)[2][2][4][2], const Unit& u, int wr, int wc, int fr, int fq) const {
        const int row0 = u.pm * BM + wr * 64 + fr; const int col0 = u.pn * BM + wc * 32 + 8 * fq;
#pragma unroll
        for (int ai = 0; ai < 2; ++ai)
#pragma unroll
            for (int m = 0; m < 4; ++m) { bf16_t* rowp = O + (size_t)(row0 + ai * HALF + m * 16) * ldc + col0;
#pragma unroll
                for (int bj = 0; bj < 2; ++bj) { const f32x4 v0 = acc[ai][bj][m][0], v1 = acc[ai][bj][m][1];
                    u32x4 w; w.x = cvt_pk_bf16(v0[0], v0[1]); w.y = cvt_pk_bf16(v0[2], v0[3]); w.z = cvt_pk_bf16(v1[0], v1[1]); w.w = cvt_pk_bf16(v1[2], v1[3]);
                    *(u32x4*)(rowp + bj * HALF) = w; } }
    }
};
template <bool ACCUM> struct EpiGate {
    static constexpr bool PERM = true, AFTER_DRAIN = false;
    bf16_t* O; int ldc; const bf16_t* G; int ldg; int gcol;
    __device__ __forceinline__ void operator()(const f32x4 (&acc)[2][2][4][2], const Unit& u, int wr, int wc, int fr, int fq) const {
        const int row0 = u.pm * BM + wr * 64 + fr; const int col0 = u.pn * BM + wc * 32 + 8 * fq;
#pragma unroll
        for (int ai = 0; ai < 2; ++ai) {
            u32x2 gpre[4][2]; u32x4 opre[4][2];
#pragma unroll
            for (int m = 0; m < 4; ++m)
#pragma unroll
                for (int bj = 0; bj < 2; ++bj) { const size_t r = (size_t)(row0 + ai * HALF + m * 16); gpre[m][bj] = *(const u32x2*)((const unsigned char*)G + r * ldg + gcol + col0 + bj * HALF);
                    if (ACCUM) opre[m][bj] = *(const u32x4*)(O + r * ldc + col0 + bj * HALF); }
            asm volatile("" ::: "memory");
#pragma unroll
            for (int m = 0; m < 4; ++m) { const size_t r = (size_t)(row0 + ai * HALF + m * 16);
#pragma unroll
                for (int bj = 0; bj < 2; ++bj) { const f32x4 v0 = acc[ai][bj][m][0], v1 = acc[ai][bj][m][1];
                    const u32x2 g = gpre[m][bj]; constexpr float k255 = 1.0f / 255.0f;
                    float o[8];
                    o[0] = (float)(g.x & 0xffu) * k255 * v0[0]; o[1] = (float)((g.x >> 8) & 0xffu) * k255 * v0[1]; o[2] = (float)((g.x >> 16) & 0xffu) * k255 * v0[2]; o[3] = (float)(g.x >> 24) * k255 * v0[3];
                    o[4] = (float)(g.y & 0xffu) * k255 * v1[0]; o[5] = (float)((g.y >> 8) & 0xffu) * k255 * v1[1]; o[6] = (float)((g.y >> 16) & 0xffu) * k255 * v1[2]; o[7] = (float)(g.y >> 24) * k255 * v1[3];
                    bf16_t* op = O + r * ldc + col0 + bj * HALF;
                    if (ACCUM) { const u32x4 p = opre[m][bj];
                        o[0] += bf_lo(p.x); o[1] += bf_hi(p.x); o[2] += bf_lo(p.y); o[3] += bf_hi(p.y); o[4] += bf_lo(p.z); o[5] += bf_hi(p.z); o[6] += bf_lo(p.w); o[7] += bf_hi(p.w); }
                    u32x4 w; w.x = cvt_pk_bf16(o[0], o[1]); w.y = cvt_pk_bf16(o[2], o[3]); w.z = cvt_pk_bf16(o[4], o[5]); w.w = cvt_pk_bf16(o[6], o[7]);
                    *(u32x4*)op = w; } }
        }
    }
};
struct EpiResF32 {
    static constexpr bool PERM = false, AFTER_DRAIN = false;
    const float* base; float* out; int ldc;
    __device__ __forceinline__ void operator()(const f32x4 (&acc)[2][2][4][2], const Unit& u, int wr, int wc, int fr, int fq) const {
        const int row0 = u.pm * BM + wr * 64 + fr; const int col0 = u.pn * BM + wc * 32 + 4 * fq;
#pragma unroll
        for (int ai = 0; ai < 2; ++ai)
#pragma unroll
            for (int m = 0; m < 4; ++m) { const size_t off = (size_t)(row0 + ai * HALF + m * 16) * ldc + col0;
#pragma unroll
                for (int bj = 0; bj < 2; ++bj)
#pragma unroll
                    for (int n = 0; n < 2; ++n) { const f32x4 b = *(const f32x4*)(base + off + bj * HALF + n * 16); *(f32x4*)(out + off + bj * HALF + n * 16) = b + acc[ai][bj][m][n]; } }
    }
};
struct EpiQKVG {
    static constexpr bool PERM = true, AFTER_DRAIN = false;
    bf16_t* O; const float* COS; const float* SIN;
    __device__ __forceinline__ void operator()(const f32x4 (&acc)[2][2][4][2], const Unit& u, int wr, int wc, int fr, int fq) const {
        const int row0 = u.pm * BM + wr * 64 + fr; const int col0 = u.pn * BM + wc * 32 + 8 * fq;
        const bool rot = u.pn < 4; const float sc = (u.pn >= 2 && u.pn < 4) ? 0.08838834764831845f : 1.0f; const int i0 = 4 * (wc * 4 + fq);
#pragma unroll
        for (int ai = 0; ai < 2; ++ai)
#pragma unroll
            for (int m = 0; m < 4; ++m) { const int row = row0 + ai * HALF + m * 16; bf16_t* rowp = O + (size_t)row * 3072 + col0;
                f32x4 c = (f32x4){1.f, 1.f, 1.f, 1.f}, s = (f32x4){0.f, 0.f, 0.f, 0.f};
                if (rot) { const size_t ti = (size_t)(row & 4095) * 64 + i0; c = *(const f32x4*)(COS + ti) * sc; s = *(const f32x4*)(SIN + ti) * sc; }
#pragma unroll
                for (int bj = 0; bj < 2; ++bj) { f32x4 v0 = acc[ai][bj][m][0], v1 = acc[ai][bj][m][1];
                    if (rot) { const f32x4 r1 = v0 * c - v1 * s, r2 = v0 * s + v1 * c; v0 = r1; v1 = r2; }
                    u32x4 w; w.x = cvt_pk_bf16(v0[0], v0[1]); w.y = cvt_pk_bf16(v0[2], v0[3]); w.z = cvt_pk_bf16(v1[0], v1[1]); w.w = cvt_pk_bf16(v1[2], v1[3]);
                    *(u32x4*)(rowp + bj * HALF) = w; } }
    }
};
struct EpiConvGates {
    static constexpr bool PERM = true, AFTER_DRAIN = false;
    bf16_t* CB; bf16_t* UU; bf16_t* GT;
    __device__ __forceinline__ void operator()(const f32x4 (&acc)[2][2][4][2], const Unit& u, int wr, int wc, int fr, int fq) const {
        const int row0 = u.pm * BM + wr * 64 + fr;
        if (u.pn >= 4 && u.pn < 12) {
            const int col0 = (u.pn - 4) * 128 + wc * 32 + 8 * fq;
#pragma unroll
            for (int ai = 0; ai < 2; ++ai)
#pragma unroll
                for (int m = 0; m < 4; ++m) { const f32x4 v0 = acc[ai][0][m][0] * acc[ai][1][m][0], v1 = acc[ai][0][m][1] * acc[ai][1][m][1];
                    u32x4 w; w.x = cvt_pk_bf16(v0[0], v0[1]); w.y = cvt_pk_bf16(v0[2], v0[3]); w.z = cvt_pk_bf16(v1[0], v1[1]); w.w = cvt_pk_bf16(v1[2], v1[3]);
                    *(u32x4*)(UU + (size_t)(row0 + ai * HALF + m * 16) * 1024 + col0) = w; }
        } else if (u.pn >= 12) {
            unsigned char* G8 = (unsigned char*)GT; const int col0 = (u.pn - 12) * BM + wc * 32 + 8 * fq;
#pragma unroll
            for (int ai = 0; ai < 2; ++ai)
#pragma unroll
                for (int m = 0; m < 4; ++m) { unsigned char* rowp = G8 + (size_t)(row0 + ai * HALF + m * 16) * 2048 + col0;
#pragma unroll
                    for (int bj = 0; bj < 2; ++bj) { const f32x4 v0 = acc[ai][bj][m][0], v1 = acc[ai][bj][m][1];
                        unsigned q[8];
#pragma unroll
                        for (int z = 0; z < 4; ++z) { q[z] = (unsigned)(sigmoidf_(v0[z]) * 255.0f + 0.5f); q[4 + z] = (unsigned)(sigmoidf_(v1[z]) * 255.0f + 0.5f); }
                        u32x2 w; w.x = q[0] | (q[1] << 8) | (q[2] << 16) | (q[3] << 24); w.y = q[4] | (q[5] << 8) | (q[6] << 16) | (q[7] << 24);
                        *(u32x2*)(rowp + bj * HALF) = w; } }
        } else {
            bf16_t* O = CB; const int ldc = 1024; const int col0 = u.pn * BM + wc * 32 + 8 * fq;
#pragma unroll
            for (int ai = 0; ai < 2; ++ai)
#pragma unroll
                for (int m = 0; m < 4; ++m) { bf16_t* rowp = O + (size_t)(row0 + ai * HALF + m * 16) * ldc + col0;
#pragma unroll
                    for (int bj = 0; bj < 2; ++bj) { const f32x4 v0 = acc[ai][bj][m][0], v1 = acc[ai][bj][m][1];
                        u32x4 w; w.x = cvt_pk_bf16(v0[0], v0[1]); w.y = cvt_pk_bf16(v0[2], v0[3]); w.z = cvt_pk_bf16(v1[0], v1[1]); w.w = cvt_pk_bf16(v1[2], v1[3]);
                        *(u32x4*)(rowp + bj * HALF) = w; } }
        }
    }
};
struct EpiResBf16SS {
    static constexpr bool PERM = true, AFTER_DRAIN = false;
    const float* base; bf16_t* O; float* SS; int ldc; int orows;
    unsigned char* XQ; float* XS;
    __device__ __forceinline__ void operator()(const f32x4 (&acc)[2][2][4][2], const Unit& u, int wr, int wc, int fr, int fq) const {
        const int row0 = u.pm * BM + wr * 64 + fr; const int col0 = u.pn * BM + wc * 32 + 8 * fq;
#pragma unroll
        for (int ai = 0; ai < 2; ++ai) {
            f32x4 pre[4][2][2];
#pragma unroll
            for (int m = 0; m < 4; ++m)
#pragma unroll
                for (int bj = 0; bj < 2; ++bj) { const size_t o = (size_t)(row0 + ai * HALF + m * 16) * ldc + col0 + bj * HALF; pre[m][bj][0] = *(const f32x4*)(base + o); pre[m][bj][1] = *(const f32x4*)(base + o + 4); }
            asm volatile("" ::: "memory");
#pragma unroll
            for (int m = 0; m < 4; ++m) { const size_t r = (size_t)(row0 + ai * HALF + m * 16); float ssq = 0.f;
#pragma unroll
                for (int bj = 0; bj < 2; ++bj) { const size_t o = r * ldc + col0 + bj * HALF;
                    const f32x4 h0 = pre[m][bj][0] + acc[ai][bj][m][0], h1 = pre[m][bj][1] + acc[ai][bj][m][1];
                    ssq += (h0[0] * h0[0] + h0[1] * h0[1]) + (h0[2] * h0[2] + h0[3] * h0[3]) + (h1[0] * h1[0] + h1[1] * h1[1]) + (h1[2] * h1[2] + h1[3] * h1[3]);
                    u32x4 w; w.x = cvt_pk_bf16(h0[0], h0[1]); w.y = cvt_pk_bf16(h0[2], h0[3]); w.z = cvt_pk_bf16(h1[0], h1[1]); w.w = cvt_pk_bf16(h1[2], h1[3]);
                    *(u32x4*)(O + ((size_t)((col0 + bj * HALF) >> 3) * orows + r) * 8) = w;
                    float am = fmaxf(fmaxf(fmaxf(fabsf(h0[0]), fabsf(h0[1])), fmaxf(fabsf(h0[2]), fabsf(h0[3]))), fmaxf(fmaxf(fabsf(h1[0]), fabsf(h1[1])), fmaxf(fabsf(h1[2]), fabsf(h1[3]))));
                    am = fmaxf(am, __shfl_xor(am, 16)); am = fmaxf(am, __shfl_xor(am, 32));
                    const float qs = am > 0.f ? 127.0f / am : 0.f;
                    u32x2 qw;
                    qw.x = ((unsigned)(int)rintf(h0[0] * qs) & 0xffu) | (((unsigned)(int)rintf(h0[1] * qs) & 0xffu) << 8) | (((unsigned)(int)rintf(h0[2] * qs) & 0xffu) << 16) | (((unsigned)(int)rintf(h0[3] * qs) & 0xffu) << 24);
                    qw.y = ((unsigned)(int)rintf(h1[0] * qs) & 0xffu) | (((unsigned)(int)rintf(h1[1] * qs) & 0xffu) << 8) | (((unsigned)(int)rintf(h1[2] * qs) & 0xffu) << 16) | (((unsigned)(int)rintf(h1[3] * qs) & 0xffu) << 24);
                    *(u32x2*)(XQ + o) = qw;
                    if (fq == 0) XS[r * (ldc / 32) + ((col0 + bj * HALF) >> 5)] = am * (1.0f / 127.0f); }
                ssq += __shfl_xor(ssq, 16); ssq += __shfl_xor(ssq, 32);
                if (fq == 0) SS[r * 16 + u.pn * 4 + wc] = ssq; }
        }
    }
};
struct EpiPleBf16SS {
    static constexpr bool PERM = true, AFTER_DRAIN = false;
    const bf16_t* H; const bf16_t* P; bf16_t* O; const float* RS; float* SS; int ldc;
    __device__ __forceinline__ void operator()(const f32x4 (&acc)[2][2][4][2], const Unit& u, int wr, int wc, int fr, int fq) const {
        const int row0 = u.pm * BM + wr * 64 + fr; const int col0 = u.pn * BM + wc * 32 + 8 * fq;
#pragma unroll
        for (int ai = 0; ai < 2; ++ai) {
            float rsv[4];
#pragma unroll
            for (int m = 0; m < 4; ++m) { const size_t r = (size_t)(row0 + ai * HALF + m * 16); rsv[m] = RS[r]; }
            asm volatile("" : "+v"(rsv[0]), "+v"(rsv[1]), "+v"(rsv[2]), "+v"(rsv[3]) :: "memory");
            u32x4 hpre[4][2], ppre[4][2];
#pragma unroll
            for (int m = 0; m < 4; ++m) { const size_t r = (size_t)(row0 + ai * HALF + m * 16);
#pragma unroll
                for (int bj = 0; bj < 2; ++bj) { const size_t o = r * ldc + col0 + bj * HALF; hpre[m][bj] = *(const u32x4*)(H + ((size_t)((col0 + bj * HALF) >> 3) * 32768 + r) * 8); ppre[m][bj] = *(const u32x4*)(P + o); } }
            asm volatile("" ::: "memory");
#pragma unroll
            for (int m = 0; m < 4; ++m) { const size_t r = (size_t)(row0 + ai * HALF + m * 16); float ssq = 0.f; const float rs = rsv[m];
#pragma unroll
                for (int bj = 0; bj < 2; ++bj) { const size_t o = r * ldc + col0 + bj * HALF;
                    const u32x4 hw = hpre[m][bj], pw = ppre[m][bj]; const f32x4 a0 = acc[ai][bj][m][0], a1 = acc[ai][bj][m][1];
                    float h[8];
                    h[0] = bf_lo(hw.x) + sigmoidf_(rs * a0[0]) * bf_lo(pw.x); h[1] = bf_hi(hw.x) + sigmoidf_(rs * a0[1]) * bf_hi(pw.x);
                    h[2] = bf_lo(hw.y) + sigmoidf_(rs * a0[2]) * bf_lo(pw.y); h[3] = bf_hi(hw.y) + sigmoidf_(rs * a0[3]) * bf_hi(pw.y);
                    h[4] = bf_lo(hw.z) + sigmoidf_(rs * a1[0]) * bf_lo(pw.z); h[5] = bf_hi(hw.z) + sigmoidf_(rs * a1[1]) * bf_hi(pw.z);
                    h[6] = bf_lo(hw.w) + sigmoidf_(rs * a1[2]) * bf_lo(pw.w); h[7] = bf_hi(hw.w) + sigmoidf_(rs * a1[3]) * bf_hi(pw.w);
#pragma unroll
                    for (int z = 0; z < 8; ++z) ssq += h[z] * h[z];
                    u32x4 w; w.x = cvt_pk_bf16(h[0], h[1]); w.y = cvt_pk_bf16(h[2], h[3]); w.z = cvt_pk_bf16(h[4], h[5]); w.w = cvt_pk_bf16(h[6], h[7]);
                    *(u32x4*)(O + o) = w; }
                ssq += __shfl_xor(ssq, 16); ssq += __shfl_xor(ssq, 32);
                if (fq == 0) SS[r * 16 + u.pn * 4 + wc] = ssq; }
        }
    }
};
struct EpiPle {
    static constexpr bool PERM = false, AFTER_DRAIN = false;
    const float* base; float* out; const bf16_t* P; int ldc;
    __device__ __forceinline__ void operator()(const f32x4 (&acc)[2][2][4][2], const Unit& u, int wr, int wc, int fr, int fq) const {
        const int row0 = u.pm * BM + wr * 64 + fr; const int col0 = u.pn * BM + wc * 32 + 4 * fq;
#pragma unroll
        for (int ai = 0; ai < 2; ++ai)
#pragma unroll
            for (int m = 0; m < 4; ++m) { const size_t off = (size_t)(row0 + ai * HALF + m * 16) * ldc + col0;
#pragma unroll
                for (int bj = 0; bj < 2; ++bj)
#pragma unroll
                    for (int n = 0; n < 2; ++n) { const size_t o = off + bj * HALF + n * 16; const f32x4 b = *(const f32x4*)(base + o); const u32x2 p = *(const u32x2*)(P + o); const f32x4 a = acc[ai][bj][m][n];
                        f32x4 r; r[0] = b[0] + sigmoidf_(a[0]) * bf_lo(p.x); r[1] = b[1] + sigmoidf_(a[1]) * bf_hi(p.x); r[2] = b[2] + sigmoidf_(a[2]) * bf_lo(p.y); r[3] = b[3] + sigmoidf_(a[3]) * bf_hi(p.y);
                        *(f32x4*)(out + o) = r; } }
    }
};

template <class Epi, class Sched, bool ALIGN_EPI>
__device__ __forceinline__ void gemm_phase(PG8_LAS unsigned char* lds, const Gemm g, const Sched& S, const Epi& E) {
    const int tid = threadIdx.x, wid = __builtin_amdgcn_readfirstlane(tid >> 6), lane = tid & 63, wr = wid >> 2, wc = wid & 3, fr = lane & 15, fq = lane >> 4;
    const int K = g.K, nt = K / BK, lda = g.lda;
    const size_t a_rs = g.a_slices ? 16 : (size_t)lda * 2, a_cs = g.a_slices ? (size_t)g.M * 16 : 16, kstepA = g.a_slices ? (size_t)g.M * 128 : (size_t)(BK * 2);
    unsigned voffA[2], voffB[2];
#pragma unroll
    for (int i = 0; i < 2; ++i) { int R, C; stage_rc(tid * 16 + i * 8192, R, C); const int Rb = Epi::PERM ? ((R & ~31) + perm32(R & 31)) : R;
        voffA[i] = (unsigned)((size_t)R * a_rs + (size_t)(C >> 3) * a_cs); voffB[i] = (unsigned)(Rb * K + C) * 2u; }
    const size_t kstep = (size_t)(BK * 2);
    const size_t hstepA = (size_t)HALF * a_rs, hstepB = (size_t)HALF * K * 2;
    const size_t tstepA = 2 * hstepA, tstepB = 2 * hstepB;
    const size_t pnstepA = (size_t)g.a_pn_cols * 2;
    const unsigned ldsw = (unsigned)wid * 1024u;
    const int aoff = lds_byte(wr * 64 + fr, fq * 8), boff = lds_byte(wc * 32 + fr, fq * 8);
#define PG8_SA(b, h) (((b) * 2 + (h)) * HTB)
#define PG8_SB(b, h) ((4 + (b) * 2 + (h)) * HTB)
#define PG8_STAGE(bufoff, gbase, voff) do { _Pragma("unroll") for (int _i = 0; _i < 2; ++_i) \
        __builtin_amdgcn_global_load_lds((const unsigned*)((const char*)(gbase) + (voff)[_i]), (PG8_LAS unsigned*)(lds + (bufoff) + ldsw + _i * 8192), 16, 0, 0); } while (0)
#define PG8_LDA(dst, b, h) do { _Pragma("unroll") for (int m = 0; m < 4; ++m) _Pragma("unroll") for (int k = 0; k < 2; ++k) dst[m][k] = *(const PG8_LAS bf16x8*)(lds + PG8_SA(b, h) + aoff + m * 2048 + k * 1024); } while (0)
#define PG8_LDB(dst, b, h) do { _Pragma("unroll") for (int n = 0; n < 2; ++n) _Pragma("unroll") for (int k = 0; k < 2; ++k) dst[n][k] = *(const PG8_LAS bf16x8*)(lds + PG8_SB(b, h) + boff + n * 2048 + k * 1024); } while (0)
#define PG8_MMA(ai, bj, At, Bt) do { __builtin_amdgcn_s_setprio(1); _Pragma("unroll") for (int m = 0; m < 4; ++m) _Pragma("unroll") for (int n = 0; n < 2; ++n) _Pragma("unroll") for (int k = 0; k < 2; ++k) \
        acc[ai][bj][m][n] = __builtin_amdgcn_mfma_f32_16x16x32_bf16(Bt[n][k], At[m][k], acc[ai][bj][m][n], 0, 0, 0); __builtin_amdgcn_s_setprio(0); } while (0)
#define PG8_WAIT_V(n) asm volatile("s_waitcnt vmcnt(" #n ")" ::: "memory")
#define PG8_WAIT_L(n) asm volatile("s_waitcnt lgkmcnt(" #n ")" ::: "memory")
#define PG8_BAR __builtin_amdgcn_s_barrier()
#define PG8_SCHED __builtin_amdgcn_sched_barrier(0)
    Unit cur, nxt; int ui = 0;
    if (!S.next(0, cur)) return;
    f32x4 acc[2][2][4][2];
#pragma unroll
    for (int a = 0; a < 2; ++a)
#pragma unroll
        for (int b = 0; b < 2; ++b)
#pragma unroll
            for (int m = 0; m < 4; ++m)
#pragma unroll
                for (int n = 0; n < 2; ++n) acc[a][b][m][n] = (f32x4){0.f, 0.f, 0.f, 0.f};
    bf16x8 At[4][2], B0[2][2], B1[2][2];
    const char* cA = (const char*)g.A + (size_t)cur.pm * tstepA + (size_t)cur.pn * pnstepA; const char* cB = (const char*)g.Bt + (size_t)cur.pn * tstepB;
    S.a_ready(cur);
    PG8_STAGE(PG8_SB(0, 0), cB, voffB); PG8_STAGE(PG8_SB(0, 1), cB + hstepB, voffB); PG8_STAGE(PG8_SA(0, 0), cA, voffA); PG8_STAGE(PG8_SA(0, 1), cA + hstepA, voffA);
    if (wr == 1) PG8_BAR;
    PG8_WAIT_V(2); PG8_BAR;
    PG8_STAGE(PG8_SB(1, 0), cB + kstep, voffB); PG8_STAGE(PG8_SA(1, 0), cA + kstepA, voffA); PG8_STAGE(PG8_SB(1, 1), cB + hstepB + kstep, voffB);
    PG8_WAIT_V(6); PG8_BAR;
    for (;;) {
        const bool has_next = S.next(ui + 1, nxt);
        const char* nA = has_next ? (const char*)g.A + (size_t)nxt.pm * tstepA + (size_t)nxt.pn * pnstepA : cA; const char* nB = has_next ? (const char*)g.Bt + (size_t)nxt.pn * tstepB : cB;
        for (int t = 0; t < nt; t += 2) {
            const bool last = (t == nt - 2);
            const char* a1 = cA + (size_t)(t + 1) * kstepA;
            const char* a2 = last ? nA : cA + (size_t)(t + 2) * kstepA; const char* b2 = last ? nB : cB + (size_t)(t + 2) * kstep;
            const char* a3 = a2 + kstepA; const char* b3 = b2 + kstep;
            if (last && has_next) S.a_ready(nxt);
            PG8_LDB(B0, 0, 0); PG8_LDB(B1, 0, 1); PG8_SCHED; PG8_LDA(At, 0, 0); PG8_STAGE(PG8_SA(1, 1), a1 + hstepA, voffA);
            PG8_WAIT_V(8); PG8_WAIT_L(0); PG8_BAR; PG8_MMA(0, 0, At, B0); PG8_MMA(0, 1, At, B1); PG8_BAR; PG8_SCHED;
            PG8_LDA(At, 0, 1); PG8_STAGE(PG8_SB(0, 0), b2, voffB); PG8_STAGE(PG8_SB(0, 1), b2 + hstepB, voffB); PG8_STAGE(PG8_SA(0, 0), a2, voffA);
            PG8_WAIT_V(8); PG8_WAIT_L(0); PG8_BAR; PG8_MMA(1, 0, At, B0); PG8_MMA(1, 1, At, B1); PG8_BAR; PG8_SCHED;
            PG8_LDB(B0, 1, 0); PG8_LDB(B1, 1, 1); PG8_SCHED; PG8_LDA(At, 1, 0); PG8_STAGE(PG8_SA(0, 1), a2 + hstepA, voffA);
            PG8_WAIT_V(8); PG8_WAIT_L(0); PG8_BAR; PG8_MMA(0, 0, At, B0); PG8_MMA(0, 1, At, B1); PG8_BAR; PG8_SCHED;
            PG8_LDA(At, 1, 1); PG8_STAGE(PG8_SB(1, 0), b3, voffB); PG8_STAGE(PG8_SB(1, 1), b3 + hstepB, voffB); PG8_STAGE(PG8_SA(1, 0), a3, voffA);
            PG8_WAIT_V(8); PG8_WAIT_L(0); PG8_BAR; PG8_MMA(1, 0, At, B0); PG8_MMA(1, 1, At, B1); PG8_BAR; PG8_SCHED;
        }
        if constexpr (ALIGN_EPI) { if (wr == 0) PG8_BAR; }
        E(acc, cur, wr, wc, fr, fq); S.done(cur);
        if (!has_next) break;
#pragma unroll
        for (int a = 0; a < 2; ++a)
#pragma unroll
            for (int b = 0; b < 2; ++b)
#pragma unroll
                for (int m = 0; m < 4; ++m)
#pragma unroll
                    for (int n = 0; n < 2; ++n) acc[a][b][m][n] = (f32x4){0.f, 0.f, 0.f, 0.f};
        cur = nxt; cA = nA; cB = nB; ++ui;
        if constexpr (ALIGN_EPI) { if (wr == 1) PG8_BAR; }
    }
    PG8_WAIT_V(0);
    if constexpr (!ALIGN_EPI) { if (wr == 0) PG8_BAR; }
    PG8_BAR;
#undef PG8_SA
#undef PG8_SB
#undef PG8_STAGE
#undef PG8_LDA
#undef PG8_LDB
#undef PG8_MMA
#undef PG8_WAIT_V
#undef PG8_WAIT_L
#undef PG8_BAR
#undef PG8_SCHED
}
}

constexpr int NWAVES = 8, NTHREADS = NWAVES * 64;
constexpr int BATCH = 8, SEQ = 4096, D = 1024, T = BATCH * SEQ;
constexpr int RH = 4, RDK = 128, RDV = 256, RC = 128, NCH = SEQ / RC;
constexpr int RQK = RH * RDK, RV = RH * RDV;
constexpr int INW = 8192;
constexpr int PH = 8, PNK = 128, PNE = PNK * PNK, PQD = 256, PHALF = 128, PTOPK = 16, NSEL = PH * PTOPK;
constexpr int PLE = 256;
constexpr float EPS = 1e-6f;
constexpr int NUNITS_R = BATCH * NCH * RH;

constexpr size_t MiB = 1u << 20;
constexpr size_t WS_CTL = 0, CTL_ZERO_BYTES = 64 * 1024;
constexpr size_t WS_COS = 1 * MiB, WS_SIN = 2 * MiB;
constexpr size_t WS_WIN = 3 * MiB;
constexpr size_t WS_WRU = 19 * MiB, WS_WCU = 21 * MiB, WS_WOUT = 23 * MiB;
constexpr size_t WS_WPQ = 25 * MiB;
constexpr size_t WS_WPP = 29 * MiB;
constexpr size_t WS_K1 = 29 * MiB + 512 * 1024, WS_K2 = 29 * MiB + 768 * 1024;
constexpr size_t WS_WPG = 30 * MiB;
constexpr size_t WS_UB = 32 * MiB, WS_VB = 64 * MiB;
constexpr size_t WS_XN = 96 * MiB;
constexpr size_t WS_BIG = 160 * MiB;
constexpr size_t WS_PREV = 352 * MiB;
constexpr size_t WS_ARET = 416 * MiB;
constexpr size_t WS_IDX = 480 * MiB, WS_GATE = 496 * MiB;
constexpr size_t WS_END = 512 * MiB;

constexpr int LDS_BYTES = 160 * 1024;

constexpr int PNE_ROWS = 16384;
typedef unsigned short bf16;
typedef unsigned v4u __attribute__((ext_vector_type(4)));
typedef unsigned v2u __attribute__((ext_vector_type(2)));
typedef float f32x4 __attribute__((ext_vector_type(4)));
#define LAS __attribute__((address_space(3)))

__device__ __forceinline__ unsigned f2bf(float f) { unsigned u = __float_as_uint(f); return (u + 0x7fffu + ((u >> 16) & 1u)) >> 16; }
__device__ __forceinline__ unsigned pk2(float lo, float hi) { return f2bf(lo) | (f2bf(hi) << 16); }
__device__ __forceinline__ float bflo(unsigned w) { return __uint_as_float(w << 16); }
__device__ __forceinline__ float bfhi(unsigned w) { return __uint_as_float(w & 0xffff0000u); }
__device__ __forceinline__ float bf2f(bf16 h) { return __uint_as_float(((unsigned)h) << 16); }
__device__ __forceinline__ float wave_sum(float v) {
#pragma unroll
    for (int o = 1; o < 64; o <<= 1) v += __shfl_xor(v, o);
    return v;
}
__device__ __forceinline__ float wave_max(float v) {
#pragma unroll
    for (int o = 1; o < 64; o <<= 1) v = fmaxf(v, __shfl_xor(v, o));
    return v;
}
__device__ __forceinline__ void unpack8(const v4u w, float* f) { f[0] = bflo(w.x); f[1] = bfhi(w.x); f[2] = bflo(w.y); f[3] = bfhi(w.y); f[4] = bflo(w.z); f[5] = bfhi(w.z); f[6] = bflo(w.w); f[7] = bfhi(w.w); }


typedef float f32x16 __attribute__((ext_vector_type(16)));
typedef short bf16x8v __attribute__((ext_vector_type(8)));
__device__ __forceinline__ unsigned ord_key(float f) { const unsigned u = __float_as_uint(f); return u ^ ((unsigned)((int)u >> 31) | 0x80000000u); }
__device__ __forceinline__ float ord_val(unsigned k) { return __uint_as_float(k ^ (~(unsigned)((int)k >> 31) | 0x80000000u)); }
__device__ __forceinline__ void sort16_desc(unsigned (&x)[16]) {
#pragma unroll
    for (int ks = 1; ks <= 4; ++ks) {
#pragma unroll
        for (int js = ks - 1; js >= 0; --js) {
#pragma unroll
            for (int i = 0; i < 16; ++i) { const int k = 1 << ks, j = 1 << js, l = i ^ j;
                if (l > i) { const unsigned hi = max(x[i], x[l]), lo = min(x[i], x[l]); if ((i & k) == 0) { x[i] = hi; x[l] = lo; } else { x[i] = lo; x[l] = hi; } } }
        }
    }
}
__device__ __forceinline__ void merge16_desc(unsigned (&a)[16], const unsigned (&b)[16]) {
#pragma unroll
    for (int i = 0; i < 16; ++i) a[i] = max(a[i], b[15 - i]);
#pragma unroll
    for (int js = 3; js >= 0; --js) {
#pragma unroll
        for (int i = 0; i < 16; ++i) { const int j = 1 << js, l = i ^ j;
            if (l > i) { const unsigned hi = max(a[i], a[l]), lo = min(a[i], a[l]); a[i] = hi; a[l] = lo; } }
    }
}

__device__ __forceinline__ void peer_half_topk(const bf16* qrow, const bf16* kb, int hg, unsigned (&V)[16]) {
    constexpr int LS = 136;
    bf16x8v qf[8];
#pragma unroll
    for (int ks = 0; ks < 8; ++ks) qf[ks] = *(const bf16x8v*)(qrow + 16 * ks);
    f32x16 acc[4];
#pragma unroll
    for (int b = 0; b < 4; ++b)
#pragma unroll
        for (int z = 0; z < 16; ++z) acc[b][z] = 0.f;
#pragma unroll
    for (int ks = 0; ks < 8; ++ks)
#pragma unroll
        for (int b = 0; b < 4; ++b) { const bf16x8v a = *(const bf16x8v*)(kb + b * 32 * LS + 16 * ks); acc[b] = __builtin_amdgcn_mfma_f32_32x32x16_bf16(a, qf[ks], acc[b], 0, 0, 0); }
    unsigned x0[16], x1[16], x2[16], x3[16];
#pragma unroll
    for (int z = 0; z < 16; ++z) { const int nb = (z & 3) + 8 * (z >> 2) + 4 * hg;
        x0[z] = (ord_key(acc[0][z]) & ~0x7Fu) | (unsigned)(127 - nb);
        x1[z] = (ord_key(acc[1][z]) & ~0x7Fu) | (unsigned)(127 - (32 + nb));
        x2[z] = (ord_key(acc[2][z]) & ~0x7Fu) | (unsigned)(127 - (64 + nb));
        x3[z] = (ord_key(acc[3][z]) & ~0x7Fu) | (unsigned)(127 - (96 + nb)); }
    sort16_desc(x0); sort16_desc(x1); merge16_desc(x0, x1);
    sort16_desc(x2); sort16_desc(x3); merge16_desc(x2, x3);
    merge16_desc(x0, x2);
    unsigned pz[16];
#pragma unroll
    for (int z = 0; z < 16; ++z) { auto rr = __builtin_amdgcn_permlane32_swap(x0[z], x0[z], false, false); pz[z] = hg ? rr[0] : rr[1]; }
    merge16_desc(x0, pz);
#pragma unroll
    for (int z = 0; z < 16; ++z) V[z] = x0[z];
}

typedef short v4i16_t __attribute__((ext_vector_type(4)));
__device__ __forceinline__ v4i16_t ds_tr4(LAS const unsigned char* p) { return __builtin_amdgcn_ds_read_tr16_b64_v4i16((LAS v4i16_t*)p); }
__device__ __forceinline__ bf16x8v cat8(v4i16_t a, v4i16_t b) { return __builtin_shufflevector(a, b, 0, 1, 2, 3, 4, 5, 6, 7); }

__device__ __forceinline__ void sort128_asc(unsigned& k0, unsigned& k1, int lane) {
#pragma unroll
    for (int ks = 1; ks <= 7; ++ks) {
#pragma unroll
        for (int js = ks - 1; js >= 0; --js) {
            const int K = 1 << ks, J = 1 << js;
            if (J == 64) { const unsigned lo = min(k0, k1), hi = max(k0, k1); k0 = lo; k1 = hi; }
            else {
                const bool lower = (lane & J) == 0;
                const bool up0 = (K <= 32) ? ((lane & K) == 0) : true;
                const bool up1 = (K <= 32) ? ((lane & K) == 0) : (K == 128);
                const unsigned o0 = __shfl_xor(k0, J), o1 = __shfl_xor(k1, J);
                k0 = (lower == up0) ? min(k0, o0) : max(k0, o0);
                k1 = (lower == up1) ? min(k1, o1) : max(k1, o1);
            }
        }
    }
}

#define XB_TMO      128
#define XB_XCNT(j)  (256  + 64 * (j))
#define XB_XSUB(j)  (1280 + 64 * (j))
#define XB_XGEN(j)  (2304 + 64 * (j))
#define XB_TOP      3328
#define XB_TOPGEN   3392
#define XCD_BAR_WORDS 3456
#define XB_SPIN_CAP (1u << 20)
__device__ __forceinline__ unsigned xb_ld(unsigned* p)              { return __hip_atomic_load(p, __ATOMIC_RELAXED, __HIP_MEMORY_SCOPE_AGENT); }
__device__ __forceinline__ unsigned xb_add(unsigned* p, unsigned v) { return __hip_atomic_fetch_add(p, v, __ATOMIC_RELAXED, __HIP_MEMORY_SCOPE_AGENT); }
__device__ __forceinline__ unsigned xb_xcc_id() { return (unsigned)__builtin_amdgcn_s_getreg((3 << 11) | 20) & 0xFu; }
#define XB_SPIN(cond, bar) do { unsigned _sp = 0; while (cond) { __builtin_amdgcn_s_sleep(1); \
    if ((++_sp & 255u) == 0u) { if (xb_ld(&(bar)[XB_TMO])) break; if (_sp > XB_SPIN_CAP) { atomicAdd(&(bar)[XB_TMO], 1u); break; } } } } while (0)
struct XcdBarrier { unsigned* bar; unsigned x; volatile LAS unsigned* st; };
__device__ __forceinline__ XcdBarrier xcd_barrier_post(unsigned* bar, volatile LAS unsigned* st) {
    XcdBarrier b; b.bar = bar; b.x = xb_xcc_id(); b.st = st;
    if (threadIdx.x == 0) (void)xb_add(&bar[XB_XCNT(b.x)], 1u);
    return b;
}
__device__ __forceinline__ void xcd_barrier_complete(unsigned* bar, unsigned x, unsigned& nloc, unsigned& nx) {
    const unsigned G = gridDim.x * gridDim.y * gridDim.z;
    unsigned sum, cnt, mine, sp = 0u;
    for (;;) {
        sum = 0u; cnt = 0u; mine = 0u;
#pragma unroll
        for (unsigned j = 0; j < 16; ++j) { const unsigned c = xb_ld(&bar[XB_XCNT(j)]); sum += c; cnt += (c > 0u) ? 1u : 0u; mine = (j == x) ? c : mine; }
        if (sum == G) break;
        __builtin_amdgcn_s_sleep(1);
        if ((++sp & 255u) == 0u) { if (xb_ld(&bar[XB_TMO])) break; if (sp > XB_SPIN_CAP) { atomicAdd(&bar[XB_TMO], 1u); break; } }
    }
    nloc = mine > 0u ? mine : 1u; nx = cnt > 0u ? cnt : 1u;
}
__device__ __forceinline__ void xcd_barrier(const XcdBarrier& b) {
    asm volatile("s_waitcnt vmcnt(0)" ::: "memory");
    __syncthreads();
    if (threadIdx.x == 0) {
        unsigned* bar = b.bar;
        __builtin_amdgcn_s_waitcnt(0);
        unsigned nloc = b.st[0], nx = b.st[1];
        if (nloc == 0u) { xcd_barrier_complete(bar, b.x, nloc, nx); b.st[0] = nloc; b.st[1] = nx; }
        const unsigned old = xb_add(&bar[XB_XSUB(b.x)], 1u);
        const unsigned gen = old / nloc;
        if (old + 1u == (gen + 1u) * nloc) {
            __builtin_amdgcn_fence(__ATOMIC_RELEASE, "agent");
            asm volatile("s_waitcnt vmcnt(0)" ::: "memory");
            const unsigned og = xb_add(&bar[XB_TOP], 1u);
            const unsigned tg = og / nx;
            if (og + 1u == (tg + 1u) * nx) xb_add(&bar[XB_TOPGEN], 1u);
            else XB_SPIN(xb_ld(&bar[XB_TOPGEN]) == tg, bar);
            __builtin_amdgcn_fence(__ATOMIC_ACQUIRE, "agent");
            xb_add(&bar[XB_XGEN(b.x)], 1u);
            asm volatile("s_waitcnt vmcnt(0)" ::: "memory");
        } else {
            XB_SPIN(xb_ld(&bar[XB_XGEN(b.x)]) == gen, bar);
            __builtin_amdgcn_fence(__ATOMIC_ACQUIRE, "agent");
            asm volatile("s_waitcnt vmcnt(0)" ::: "memory");
        }
    }
    __syncthreads();
}

struct Args {
    const float* in[19]; float* out; unsigned char* ws; int ph_lo, ph_hi;
};

struct Frame {
    unsigned char* lds;
    int tid, lane, wave, G, gw, NGW, gt, NGT;
};

__device__ __forceinline__ void p0_transpose_item(const float* W, int K, int N, bf16* WT, float* scr, int item, int lane, const float* gk = nullptr, bool win_remap = false) {
    const int nblk = N / 32, kb = item / nblk, nb = item % nblk, k0 = 64 * kb, n0 = 32 * nb;

#pragma unroll 8
    for (int i = 0; i < 32; ++i) { const int kk = 2 * i + (lane >> 5); scr[kk * 33 + (lane & 31)] = W[(size_t)(k0 + kk) * N + n0 + (lane & 31)] * (gk ? gk[k0 + kk] : 1.0f); }
    asm volatile("s_waitcnt lgkmcnt(0)" ::: "memory");
    const int c = lane & 7;
#pragma unroll
    for (int j = 0; j < 4; ++j) { const int n = (lane >> 3) + 8 * j; const float* s = scr + (8 * c) * 33 + n;
        v4u o; o.x = pk2(s[0 * 33], s[1 * 33]); o.y = pk2(s[2 * 33], s[3 * 33]); o.z = pk2(s[4 * 33], s[5 * 33]); o.w = pk2(s[6 * 33], s[7 * 33]);
        int dn = n0 + n;
        if (win_remap) {
            if (dn < 1024) { const int hc = dn & 127, i = hc & 63; dn = (dn & ~127) + 8 * (i >> 2) + ((hc >> 6) << 2) + (i & 3); }
            else if (dn >= 4096 && dn < 6144) { const int cc = dn - 4096; dn = cc < 1024 ? 4096 + (cc >> 7) * 256 + (cc & 127) : 4096 + ((cc - 1024) >> 7) * 256 + 128 + ((cc - 1024) & 127); } }
        *(v4u*)(WT + (size_t)dn * K + k0 + 8 * c) = o; }
    asm volatile("s_waitcnt lgkmcnt(0)" ::: "memory");
}
__device__ __forceinline__ void cvt_f32_bf16(const Frame& F, const float* src, bf16* dst, size_t count) {
    const size_t n4 = count / 4, st = (size_t)F.NGT;
    size_t i = F.gt;
    for (; i + 3 * st < n4; i += 4 * st) { f32x4 v[4];
#pragma unroll
        for (int q = 0; q < 4; ++q) v[q] = ((const f32x4*)src)[i + q * st];
#pragma unroll
        for (int q = 0; q < 4; ++q) { v2u o; o.x = pk2(v[q][0], v[q][1]); o.y = pk2(v[q][2], v[q][3]); ((v2u*)dst)[i + q * st] = o; } }
    for (; i < n4; i += st) { const f32x4 v = ((const f32x4*)src)[i]; v2u o; o.x = pk2(v[0], v[1]); o.y = pk2(v[2], v[3]); ((v2u*)dst)[i] = o; }
}
__device__ __forceinline__ void rms_row_to_bf16(const float* xrow, const float* g, bf16* orow, int lane) {
    const f32x4* xr = (const f32x4*)xrow + lane; const f32x4* gr = (const f32x4*)g + lane;
    f32x4 v[4]; float s = 0.f;
#pragma unroll
    for (int j = 0; j < 4; ++j) { v[j] = xr[64 * j]; s += (v[j][0] * v[j][0] + v[j][1] * v[j][1]) + (v[j][2] * v[j][2] + v[j][3] * v[j][3]); }
    const float rs = 1.0f / sqrtf(wave_sum(s) * (1.f / D) + EPS);
    unsigned long long* o8 = (unsigned long long*)orow + lane;
#pragma unroll
    for (int j = 0; j < 4; ++j) { const f32x4 gg = gr[64 * j]; o8[64 * j] = (unsigned long long)pk2(v[j][0] * rs * gg[0], v[j][1] * rs * gg[1]) | ((unsigned long long)pk2(v[j][2] * rs * gg[2], v[j][3] * rs * gg[3]) << 32); }
}


__device__ __forceinline__ void quant_row_fp8(const float* srow, unsigned char* drow, float* inv_scale, int lane, const float* gcol = nullptr) {
    const f32x4* xr = (const f32x4*)srow + lane;
    f32x4 v[4]; float am = 0.f;
#pragma unroll
    for (int j = 0; j < 4; ++j) { v[j] = xr[64 * j]; if (gcol) v[j] = v[j] * ((const f32x4*)gcol + lane)[64 * j]; am = fmaxf(am, fmaxf(fmaxf(fabsf(v[j][0]), fabsf(v[j][1])), fmaxf(fabsf(v[j][2]), fabsf(v[j][3])))); }
    am = wave_max(am);
    int k = 0;
    if (am > 0.f) { k = (int)floorf(log2f(224.0f / am)); k = k < -100 ? -100 : (k > 100 ? 100 : k); }
    const float sc = ldexpf(1.0f, k), isc = ldexpf(1.0f, -k);
    v4u o;
    { int w = __builtin_amdgcn_cvt_pk_fp8_f32(v[0][0] * sc, v[0][1] * sc, 0, false); w = __builtin_amdgcn_cvt_pk_fp8_f32(v[0][2] * sc, v[0][3] * sc, w, true); o.x = (unsigned)w; }
    { int w = __builtin_amdgcn_cvt_pk_fp8_f32(v[1][0] * sc, v[1][1] * sc, 0, false); w = __builtin_amdgcn_cvt_pk_fp8_f32(v[1][2] * sc, v[1][3] * sc, w, true); o.y = (unsigned)w; }
    { int w = __builtin_amdgcn_cvt_pk_fp8_f32(v[2][0] * sc, v[2][1] * sc, 0, false); w = __builtin_amdgcn_cvt_pk_fp8_f32(v[2][2] * sc, v[2][3] * sc, w, true); o.z = (unsigned)w; }
    { int w = __builtin_amdgcn_cvt_pk_fp8_f32(v[3][0] * sc, v[3][1] * sc, 0, false); w = __builtin_amdgcn_cvt_pk_fp8_f32(v[3][2] * sc, v[3][3] * sc, w, true); o.w = (unsigned)w; }
    *((v4u*)drow + lane) = o;
    if (lane == 0) *inv_scale = isc;
}
__device__ __forceinline__ void quant_row_fp8_cp(const float* srow, unsigned char* tab, int e, float* inv_scale, int lane, const float* gcol = nullptr) {
    const f32x4* xr = (const f32x4*)(srow + 16 * lane);
    f32x4 v[4]; float am = 0.f;
#pragma unroll
    for (int q = 0; q < 4; ++q) { v[q] = xr[q]; if (gcol) v[q] = v[q] * ((const f32x4*)(gcol + 16 * lane))[q]; am = fmaxf(am, fmaxf(fmaxf(fabsf(v[q][0]), fabsf(v[q][1])), fmaxf(fabsf(v[q][2]), fabsf(v[q][3])))); }
    am = wave_max(am);
    int k = 0;
    if (am > 0.f) { k = (int)floorf(log2f(224.0f / am)); k = k < -100 ? -100 : (k > 100 ? 100 : k); }
    const float sc = ldexpf(1.0f, k), isc = ldexpf(1.0f, -k);
    v4u o;
    { int w = __builtin_amdgcn_cvt_pk_fp8_f32(v[0][0] * sc, v[0][1] * sc, 0, false); w = __builtin_amdgcn_cvt_pk_fp8_f32(v[0][2] * sc, v[0][3] * sc, w, true); o.x = (unsigned)w; }
    { int w = __builtin_amdgcn_cvt_pk_fp8_f32(v[1][0] * sc, v[1][1] * sc, 0, false); w = __builtin_amdgcn_cvt_pk_fp8_f32(v[1][2] * sc, v[1][3] * sc, w, true); o.y = (unsigned)w; }
    { int w = __builtin_amdgcn_cvt_pk_fp8_f32(v[2][0] * sc, v[2][1] * sc, 0, false); w = __builtin_amdgcn_cvt_pk_fp8_f32(v[2][2] * sc, v[2][3] * sc, w, true); o.z = (unsigned)w; }
    { int w = __builtin_amdgcn_cvt_pk_fp8_f32(v[3][0] * sc, v[3][1] * sc, 0, false); w = __builtin_amdgcn_cvt_pk_fp8_f32(v[3][2] * sc, v[3][3] * sc, w, true); o.w = (unsigned)w; }
    *(v4u*)(tab + ((size_t)(lane >> 3) * PNE_ROWS + e) * 128 + (lane & 7) * 16) = o;
    if (lane == 0) *inv_scale = isc;
}
__device__ __forceinline__ void quant_row_i8_cp_fin(f32x4 (&v)[4], unsigned char* tab, int e, float* inv_scale, int lane, const float* gcol) {
    float am = 0.f;
#pragma unroll
    for (int q = 0; q < 4; ++q) { if (gcol) v[q] = v[q] * ((const f32x4*)(gcol + 16 * lane))[q]; am = fmaxf(am, fmaxf(fmaxf(fabsf(v[q][0]), fabsf(v[q][1])), fmaxf(fabsf(v[q][2]), fabsf(v[q][3])))); }
    am = wave_max(am);
    const float sc = am > 0.f ? 127.0f / am : 0.f;
    unsigned w[4];
#pragma unroll
    for (int q = 0; q < 4; ++q) { const int q0 = (int)rintf(v[q][0] * sc), q1 = (int)rintf(v[q][1] * sc), q2 = (int)rintf(v[q][2] * sc), q3 = (int)rintf(v[q][3] * sc);
        w[q] = (unsigned)(q0 & 0xff) | ((unsigned)(q1 & 0xff) << 8) | ((unsigned)(q2 & 0xff) << 16) | ((unsigned)(q3 & 0xff) << 24); }
    *(v4u*)(tab + ((size_t)(lane >> 3) * PNE_ROWS + e) * 128 + (lane & 7) * 16) = (v4u){w[0], w[1], w[2], w[3]};
    if (lane == 0) *inv_scale = am * (1.0f / 127.0f);
}
__device__ __forceinline__ void quant_row_i8_slices(f32x4 (&v)[4], unsigned char* tab, int e, float* inv_scale, int lane) {
    float am = 0.f;
#pragma unroll
    for (int q = 0; q < 4; ++q) am = fmaxf(am, fmaxf(fmaxf(fabsf(v[q][0]), fabsf(v[q][1])), fmaxf(fabsf(v[q][2]), fabsf(v[q][3]))));
    am = wave_max(am);
    const float sc = am > 0.f ? 127.0f / am : 0.f;
    unsigned w[4];
#pragma unroll
    for (int q = 0; q < 4; ++q) { const int q0 = (int)rintf(v[q][0] * sc), q1 = (int)rintf(v[q][1] * sc), q2 = (int)rintf(v[q][2] * sc), q3 = (int)rintf(v[q][3] * sc);
        w[q] = (unsigned)(q0 & 0xff) | ((unsigned)(q1 & 0xff) << 8) | ((unsigned)(q2 & 0xff) << 16) | ((unsigned)(q3 & 0xff) << 24); }
    *(v2u*)(tab + ((size_t)(2 * lane) * PNE_ROWS + e) * 8) = (v2u){w[0], w[1]};
    *(v2u*)(tab + ((size_t)(2 * lane + 1) * PNE_ROWS + e) * 8) = (v2u){w[2], w[3]};
    if (lane == 0) *inv_scale = am * (1.0f / 127.0f);
}
typedef float f32x2 __attribute__((ext_vector_type(2)));
typedef unsigned v4u_raw __attribute__((__vector_size__(16)));
typedef unsigned v2u_raw __attribute__((__vector_size__(8)));
__device__ __forceinline__ void fp8x16_to_f32(const v4u w, float* f) {
    f32x2 t;
    t = __builtin_amdgcn_cvt_pk_f32_fp8((int)w.x, false); f[0] = t.x; f[1] = t.y; t = __builtin_amdgcn_cvt_pk_f32_fp8((int)w.x, true); f[2] = t.x; f[3] = t.y;
    t = __builtin_amdgcn_cvt_pk_f32_fp8((int)w.y, false); f[4] = t.x; f[5] = t.y; t = __builtin_amdgcn_cvt_pk_f32_fp8((int)w.y, true); f[6] = t.x; f[7] = t.y;
    t = __builtin_amdgcn_cvt_pk_f32_fp8((int)w.z, false); f[8] = t.x; f[9] = t.y; t = __builtin_amdgcn_cvt_pk_f32_fp8((int)w.z, true); f[10] = t.x; f[11] = t.y;
    t = __builtin_amdgcn_cvt_pk_f32_fp8((int)w.w, false); f[12] = t.x; f[13] = t.y; t = __builtin_amdgcn_cvt_pk_f32_fp8((int)w.w, true); f[14] = t.x; f[15] = t.y;
}

__device__ __forceinline__ float gelu_f(float v) {
    const float av = fabsf(v), t = __builtin_amdgcn_rcpf(av * 0.2316418882f + 1.0f);
    float q = t * 0.5307027145f + (-0.7265760135f); q = q * t + 0.7107068705f; q = q * t + (-0.142248368f); q = q * t + 0.127414796f; q = q * t;
    const float e = __builtin_amdgcn_exp2f((v * v) * (-0.72134752044f));
    const float m = v * (q * e);
    return v < 0.f ? m : v - m;
}
__device__ __forceinline__ float gamma_of(int h) { return 1.0f - exp2f(-5.0f - (float)h); }

__global__ void __launch_bounds__(NTHREADS, 2) mega(Args args) {
    extern __shared__ __attribute__((aligned(16))) unsigned char lds[];
    Frame F;
    F.lds = lds; F.tid = threadIdx.x; F.lane = F.tid & 63; F.wave = __builtin_amdgcn_readfirstlane(F.tid >> 6);
    F.G = gridDim.x; F.gw = blockIdx.x * NWAVES + F.wave; F.NGW = F.G * NWAVES; F.gt = blockIdx.x * NTHREADS + F.tid; F.NGT = F.G * NTHREADS;
    unsigned char* ws = args.ws;
    const float* x = args.in[0]; const float* p = args.in[1]; const float* g_mix = args.in[2]; const float* w_in = args.in[3];
    const float* conv_w = args.in[4]; const float* conv_b = args.in[5]; const float* w_ret_up = args.in[6]; const float* w_conv_up = args.in[7];
    const float* w_out = args.in[8]; const float* g_ffn = args.in[9]; const float* w_peer_q = args.in[10]; const float* peer_k1 = args.in[11];
    const float* peer_k2 = args.in[12]; const float* peer_u = args.in[13]; const float* peer_v = args.in[14]; const float* g_ple = args.in[15];
    const float* w_ple_proj = args.in[16]; const float* w_ple_gate = args.in[17]; const float* g_final = args.in[18];
    float* out = args.out;
    float* COS = (float*)(ws + WS_COS); float* SIN = (float*)(ws + WS_SIN);
    bf16* WIN = (bf16*)(ws + WS_WIN); bf16* WRU = (bf16*)(ws + WS_WRU); bf16* WCU = (bf16*)(ws + WS_WCU); bf16* WOUT = (bf16*)(ws + WS_WOUT);
    bf16* WPQ = (bf16*)(ws + WS_WPQ); bf16* WPP = (bf16*)(ws + WS_WPP); bf16* K1 = (bf16*)(ws + WS_K1); bf16* K2 = (bf16*)(ws + WS_K2); bf16* WPG = (bf16*)(ws + WS_WPG);
    unsigned char* U8 = ws + WS_UB; unsigned char* V8 = ws + WS_VB;
    float* SU = (float*)(ws + 128 * 1024); float* SV = (float*)(ws + 256 * 1024);
    float* SS2 = (float*)(ws + 80 * MiB);
    unsigned char* XQ = ws + WS_BIG + 128 * MiB; float* XS = (float*)(ws + WS_BIG + 160 * MiB);
    float* RS2 = (float*)(ws + 512 * 1024);
    unsigned* KK = (unsigned*)(ws + WS_BIG + 64 * MiB);
    float* SSP = (float*)(ws + WS_BIG + 80 * MiB);
    float* WSC = (float*)(ws + 82 * MiB);
    unsigned* WCNT = (unsigned*)(ws + 32 * 1024);
    float* PACT = (float*)(ws + WS_PREV);
    float* SS1 = (float*)(ws + WS_COS);
    float* SS3 = (float*)(ws + WS_IDX);
    bf16* XN = (bf16*)(ws + WS_XN); bf16* BIG = (bf16*)(ws + WS_BIG); bf16* PREV = (bf16*)(ws + WS_PREV); bf16* ARET = (bf16*)(ws + WS_ARET);
    int* IDX = (int*)(ws + WS_IDX); float* GATE = (float*)(ws + WS_GATE);
    bf16* CB = BIG;
    bf16* UU = BIG + (size_t)T * 1024;
    bf16* ACONV = CB;
    bf16* GATES = BIG + (size_t)T * 2048;
    bf16* M1 = UU;
    bf16* HB = XN;
    bf16* PB = (bf16*)(ws + 48 * MiB);
    bf16* QP = PREV;
    bf16* PLEB = BIG;
    bf16* H3B = BIG + (size_t)T * 1024;
    PG8_LAS unsigned char* ldsl = (PG8_LAS unsigned char*)lds;

    const int lo = args.ph_lo, hi = args.ph_hi;
#if MK_ONE_LAUNCH
    cg::grid_group grid = cg::this_grid();
    volatile LAS unsigned* lctl = (volatile LAS unsigned*)((LAS unsigned char*)lds + LDS_BYTES - 64);
    if (F.tid < 16) lctl[F.tid] = 0u;
    __syncthreads();
    const XcdBarrier xbar = xcd_barrier_post((unsigned*)(ws + WS_CTL), lctl);
#define SEAM(k) do { if ((k) + 1 < hi) { if ((k) == 0) grid.sync(); else xcd_barrier(xbar); } } while (0)
#else
#define SEAM(k) do { } while (0)
#endif
#define IN(k) (lo <= (k) && (k) < hi)

    if (IN(0)) {
        float* scr = (float*)(lds + F.wave * 16384);
        constexpr int I_IN = (D / 64) * (INW / 32), I_SQ = (D / 64) * (D / 32), I_PQ = (D / 64) * (2048 / 32), I_PP = (PLE / 64) * (D / 32);
        constexpr int NITEMS = I_IN + 4 * I_SQ + I_PQ + I_PP;
        for (int it = F.gw; it < NITEMS; it += F.NGW) {
            int r = it;
            if (r < I_IN) { p0_transpose_item(w_in, D, INW, WIN, scr, r, F.lane, nullptr, true); continue; } r -= I_IN;
            if (r < I_SQ) { p0_transpose_item(w_ret_up, D, D, WRU, scr, r, F.lane); continue; } r -= I_SQ;
            if (r < I_SQ) { p0_transpose_item(w_conv_up, D, D, WCU, scr, r, F.lane); continue; } r -= I_SQ;
            if (r < I_SQ) { p0_transpose_item(w_out, D, D, WOUT, scr, r, F.lane); continue; } r -= I_SQ;
            if (r < I_SQ) { p0_transpose_item(w_ple_gate, D, D, WPG, scr, r, F.lane, g_ple); continue; } r -= I_SQ;
            if (r < I_PQ) { p0_transpose_item(w_peer_q, D, 2048, WPQ, scr, r, F.lane, g_ffn); continue; } r -= I_PQ;
            p0_transpose_item(w_ple_proj, PLE, D, WPP, scr, r, F.lane);
        }
        cvt_f32_bf16(F, p, PB, (size_t)T * PLE);
        cvt_f32_bf16(F, peer_k1, K1, (size_t)PH * PNK * PHALF);
        cvt_f32_bf16(F, peer_k2, K2, (size_t)PH * PNK * PHALF);
        for (int r = F.gw; r < PNE; r += F.NGW) {
            f32x4 vu[4], vv[4];
#pragma unroll
            for (int q = 0; q < 4; ++q) { vu[q] = ((const f32x4*)(peer_u + (size_t)r * D + 16 * F.lane))[q]; vv[q] = ((const f32x4*)(peer_v + (size_t)r * D + 16 * F.lane))[q]; }
            quant_row_i8_cp_fin(vu, U8, r, SU + r, F.lane, g_ffn);
            quant_row_i8_slices(vv, V8, r, SV + r, F.lane);
        }
        for (int e = F.gt; e < SEQ * 64; e += F.NGT) { const int s = e >> 6, i = e & 63; const double inv = pow(10000.0, -(double)i / 64.0); const double ang = (double)s * inv; COS[e] = (float)cos(ang); SIN[e] = (float)sin(ang); }
        {
            const f32x4* gr = (const f32x4*)g_mix + F.lane; f32x4 gg[4];
#pragma unroll
            for (int j = 0; j < 4; ++j) gg[j] = gr[64 * j];
            for (int m = F.gw; m < T / 2; m += F.NGW) {
                const int ma = m, mb = m + T / 2;
                const f32x4* xa_ = (const f32x4*)(x + (size_t)ma * D) + F.lane; const f32x4* xb_ = (const f32x4*)(x + (size_t)mb * D) + F.lane;
                f32x4 va[4], vb[4]; float sa = 0.f, sb = 0.f;
#pragma unroll
                for (int j = 0; j < 4; ++j) { va[j] = xa_[64 * j]; vb[j] = xb_[64 * j]; }
#pragma unroll
                for (int j = 0; j < 4; ++j) { sa += (va[j][0] * va[j][0] + va[j][1] * va[j][1]) + (va[j][2] * va[j][2] + va[j][3] * va[j][3]); sb += (vb[j][0] * vb[j][0] + vb[j][1] * vb[j][1]) + (vb[j][2] * vb[j][2] + vb[j][3] * vb[j][3]); }
                const float ra = 1.0f / sqrtf(wave_sum(sa) * (1.f / D) + EPS), rb = 1.0f / sqrtf(wave_sum(sb) * (1.f / D) + EPS);
                unsigned long long* oa = (unsigned long long*)(XN + (size_t)ma * D) + F.lane; unsigned long long* ob = (unsigned long long*)(XN + (size_t)mb * D) + F.lane;
#pragma unroll
                for (int j = 0; j < 4; ++j) {
                    oa[64 * j] = (unsigned long long)pk2(va[j][0] * ra * gg[j][0], va[j][1] * ra * gg[j][1]) | ((unsigned long long)pk2(va[j][2] * ra * gg[j][2], va[j][3] * ra * gg[j][3]) << 32);
                    ob[64 * j] = (unsigned long long)pk2(vb[j][0] * rb * gg[j][0], vb[j][1] * rb * gg[j][1]) | ((unsigned long long)pk2(vb[j][2] * rb * gg[j][2], vb[j][3] * rb * gg[j][3]) << 32); }
            }
        }
        SEAM(0);
    }

    if (IN(1)) {
        pg8::Gemm g{XN, WIN, T, 3072, D, D, 0}; pg8::StaticOrder S; S.init(T, 3072, F.G, (int)blockIdx.x);
        pg8::EpiQKVG E{BIG, COS, SIN};
        pg8::gemm_phase<pg8::EpiQKVG, pg8::StaticOrder, true>(ldsl, g, S, E);
        SEAM(1);
    }

    if (IN(2)) {
        constexpr int KS = 160;
        bf16* kt = (bf16*)lds;
        bf16* vt = kt + 128 * KS;
        LAS const unsigned char* kt3 = (LAS const unsigned char*)lds; LAS const unsigned char* vt3 = kt3 + 128 * KS * 2;
        constexpr int PS = 136;
        bf16* pt = vt + 128 * KS;
        const int r32 = F.lane & 31, hg = F.lane >> 5;
        const int tq = (F.lane & 15) >> 2, tp = F.lane & 3, tcs = (F.lane >> 4) & 1;
        for (int cid = blockIdx.x; cid < BATCH * RH * 8; cid += F.G) {
            const int xg = cid & 7, yg = cid >> 3; const int chn = ((xg * 4 + (yg >> 3)) << 3) | (yg & 7);
            const int es = chn & 7, h = (chn >> 3) & 3, b = chn >> 5;
            const float gam = gamma_of(h), lg = logf(gam), cd = powf(gam, (float)RC);
            v4u kb0[4], kb1[4], kb2[4], kb3[4], vb0, vb1, vb2, vb3;
#define R1_LOAD(kreg, vreg, nn) do { const size_t t0_ = (size_t)b * SEQ + (size_t)(nn) * RC; \
            _Pragma("unroll") for (int q = 0; q < 4; ++q) { const int c = F.tid + q * NTHREADS, j = c >> 4, c8 = c & 15; kreg[q] = *(const v4u*)(BIG + (t0_ + j) * 3072 + RQK + h * RDK + c8 * 8); } \
            { const int j = F.tid >> 2, c8 = F.tid & 3; vreg = *(const v4u*)(BIG + (t0_ + j) * 3072 + 2 * RQK + h * RDV + es * 32 + c8 * 8); } } while (0)
#define R1_STEP(kreg, vreg, knext, vnext, n) do { \
                __syncthreads(); \
                _Pragma("unroll") for (int q = 0; q < 4; ++q) { const int c = F.tid + q * NTHREADS, j = c >> 4, c8 = c & 15; *(v4u*)(kt + j * KS + c8 * 8) = kreg[q]; } \
                { const int j = F.tid >> 2, c8 = F.tid & 3; float f[8]; unpack8(vreg, f);        \
                    v4u z1; z1.x = pk2(f[0] * zv, f[1] * zv); z1.y = pk2(f[2] * zv, f[3] * zv); z1.z = pk2(f[4] * zv, f[5] * zv); z1.w = pk2(f[6] * zv, f[7] * zv); \
                    *(v4u*)(vt + j * KS + c8 * 8) = z1; } \
                if ((n) > 0) { const int up = b * 128 + ((n) - 1) * 4 + h; const int e_ = F.tid >> 4, c8 = F.tid & 15;        \
                    *(v4u*)(PREV + ((size_t)up * 256 + es * 32 + e_) * 128 + c8 * 8) = *(const v4u*)(pt + e_ * PS + c8 * 8); } \
                __syncthreads(); \
                R1_LOAD(knext, vnext, ((n) + 3 < NCH ? (n) + 3 : NCH - 1));        \
                if (F.wave < 4) { \
                    _Pragma("unroll") for (int g = 0; g < 4; ++g) { const int d0 = 32 * F.wave + 8 * g + 4 * hg; v2u o; o.x = pk2(st[4 * g], st[4 * g + 1]); o.y = pk2(st[4 * g + 2], st[4 * g + 3]); \
                        *(v2u*)(pt + r32 * PS + d0) = o; } \
                    f32x16 acc; \
                    _Pragma("unroll") for (int z = 0; z < 16; ++z) acc[z] = 0.f; \
                    _Pragma("unroll") for (int ks = 0; ks < 8; ++ks) { \
                        LAS const unsigned char* ka = kt3 + ((16 * ks + 8 * hg + tq) * KS + 32 * F.wave + 16 * tcs + 4 * tp) * 2; \
                        LAS const unsigned char* va = vt3 + ((16 * ks + 8 * hg + tq) * KS + 16 * tcs + 4 * tp) * 2; \
                        const bf16x8v af = cat8(ds_tr4(ka), ds_tr4(ka + 4 * KS * 2)), bfr = cat8(ds_tr4(va), ds_tr4(va + 4 * KS * 2)); \
                        acc = __builtin_amdgcn_mfma_f32_32x32x16_bf16(af, bfr, acc, 0, 0, 0); } \
                    _Pragma("unroll") for (int z = 0; z < 16; ++z) st[z] = st[z] * cd + acc[z]; \
                } } while (0)
            const float zv = __expf(lg * (float)(RC - 1 - (F.tid >> 2)));
            R1_LOAD(kb0, vb0, 0); R1_LOAD(kb1, vb1, 1); R1_LOAD(kb2, vb2, 2);
            f32x16 st;
#pragma unroll
            for (int z = 0; z < 16; ++z) st[z] = 0.f;
#pragma unroll 1
            for (int n4 = 0; n4 < NCH; n4 += 4) {
                R1_STEP(kb0, vb0, kb3, vb3, n4);
                R1_STEP(kb1, vb1, kb0, vb0, n4 + 1);
                R1_STEP(kb2, vb2, kb1, vb1, n4 + 2);
                R1_STEP(kb3, vb3, kb2, vb2, n4 + 3);
            }
            __syncthreads();
            { const int up = b * 128 + (NCH - 1) * 4 + h; const int e_ = F.tid >> 4, c8 = F.tid & 15;
              *(v4u*)(PREV + ((size_t)up * 256 + es * 32 + e_) * 128 + c8 * 8) = *(const v4u*)(pt + e_ * PS + c8 * 8); }
#undef R1_STEP
#undef R1_LOAD
        }
        SEAM(2);
    }


    if (IN(4)) {
        constexpr int LS = 136;
        bf16* ksN = (bf16*)lds;
        constexpr int VS = 288;
        bf16* vt = ksN + 128 * LS;
        LAS const unsigned char* vt3 = (LAS const unsigned char*)lds + 128 * LS * 2;
        float* stx = (float*)(vt + 128 * VS);
        const int tq = (F.lane & 15) >> 2, tp = F.lane & 3, tcs = (F.lane >> 4) & 1;
        const int r32 = F.lane & 31, hg = F.lane >> 5, iw = F.wave & 3, eh = F.wave >> 2;
        const int i = 32 * iw + r32;
        for (int u = blockIdx.x; u < NUNITS_R; u += F.G) {
            const int h = u & 3, n = (u >> 2) & 31, b = u >> 7; const size_t t0 = (size_t)b * SEQ + (size_t)n * RC;
            const float lg = logf(gamma_of(h));
            __syncthreads();
            bf16* pt = vt;
            for (int c = F.tid; c < 128 * 16; c += NTHREADS) { const int j = c >> 4, c8 = c & 15;
                *(v4u*)(ksN + j * LS + c8 * 8) = *(const v4u*)(BIG + (t0 + j) * 3072 + RQK + h * RDK + c8 * 8); }
            for (int c = F.tid; c < 256 * 16; c += NTHREADS) { const int e_ = c >> 4, c8 = c & 15;
                *(v4u*)(pt + e_ * LS + c8 * 8) = *(const v4u*)(PREV + ((size_t)u * 256 + e_) * 128 + c8 * 8); }
            bf16x8v qf[8];
            { const bf16* qrow = BIG + (t0 + i) * 3072 + h * RDK + 8 * hg;
#pragma unroll
              for (int ks = 0; ks < 8; ++ks) qf[ks] = *(const bf16x8v*)(qrow + 16 * ks); }
            v4u vst[8];
#pragma unroll
            for (int q = 0; q < 8; ++q) { const int c = F.tid + q * NTHREADS, j = c >> 5, c8 = c & 31; vst[q] = *(const v4u*)(BIG + (t0 + j) * 3072 + 2 * RQK + h * RDV + c8 * 8); }
            f32x16 acc[4];
#pragma unroll
            for (int eb = 0; eb < 4; ++eb)
#pragma unroll
                for (int z = 0; z < 16; ++z) acc[eb][z] = 0.f;
            __syncthreads();
            {
                const bf16* pp = pt + (128 * eh + r32) * LS + 8 * hg;
#pragma unroll
                for (int ks = 0; ks < 8; ++ks)
#pragma unroll
                    for (int eb = 0; eb < 4; ++eb) { const bf16x8v a = *(const bf16x8v*)(pp + (32 * eb) * LS + 16 * ks); acc[eb] = __builtin_amdgcn_mfma_f32_32x32x16_bf16(a, qf[ks], acc[eb], 0, 0, 0); }
                const float xi = __expf(lg * (float)(i + 1));
#pragma unroll
                for (int eb = 0; eb < 4; ++eb)
#pragma unroll
                    for (int z = 0; z < 16; ++z) acc[eb][z] *= xi;
            }
            __syncthreads();
#pragma unroll
            for (int q = 0; q < 8; ++q) { const int c = F.tid + q * NTHREADS, j = c >> 5, c8 = c & 31; *(v4u*)(vt + j * VS + c8 * 8) = vst[q]; }
            __syncthreads();
#pragma unroll 1
            for (int jb = 0; jb <= iw; ++jb) {
                f32x16 X;
#pragma unroll
                for (int z = 0; z < 16; ++z) X[z] = 0.f;
#pragma unroll
                for (int ks = 0; ks < 8; ++ks) { const bf16x8v a = *(const bf16x8v*)(ksN + (32 * jb + r32) * LS + 16 * ks + 8 * hg); X = __builtin_amdgcn_mfma_f32_32x32x16_bf16(a, qf[ks], X, 0, 0, 0); }
#pragma unroll
                for (int z = 0; z < 16; ++z) { const int j = 32 * jb + (z & 3) + 8 * (z >> 2) + 4 * hg; const int df = i - j; X[z] = df >= 0 ? X[z] * __expf(lg * (float)df) : 0.f; }
#pragma unroll
                for (int s2 = 0; s2 < 2; ++s2) {
                    v4u pw; pw.x = pk2(X[8 * s2 + 0], X[8 * s2 + 1]); pw.y = pk2(X[8 * s2 + 2], X[8 * s2 + 3]); pw.z = pk2(X[8 * s2 + 4], X[8 * s2 + 5]); pw.w = pk2(X[8 * s2 + 6], X[8 * s2 + 7]);
                    const bf16x8v pf = __builtin_bit_cast(bf16x8v, pw);
#pragma unroll
                    for (int eb = 0; eb < 4; ++eb) {
                        LAS const unsigned char* va = vt3 + ((32 * jb + 16 * s2 + 4 * hg + tq) * VS + 128 * eh + 32 * eb + 16 * tcs + 4 * tp) * 2;
                        acc[eb] = __builtin_amdgcn_mfma_f32_32x32x16_bf16(cat8(ds_tr4(va), ds_tr4(va + 8 * VS * 2)), pf, acc[eb], 0, 0, 0); }
                }
            }
            float s1 = 0.f, s2 = 0.f;
#pragma unroll
            for (int eb = 0; eb < 4; ++eb)
#pragma unroll
                for (int z = 0; z < 16; ++z) { const float v = acc[eb][z]; s1 += v; s2 += v * v; }
            { auto r1 = __builtin_amdgcn_permlane32_swap(__float_as_uint(s1), __float_as_uint(s1), false, false); s1 = __uint_as_float(r1[0]) + __uint_as_float(r1[1]);
              auto r2 = __builtin_amdgcn_permlane32_swap(__float_as_uint(s2), __float_as_uint(s2), false, false); s2 = __uint_as_float(r2[0]) + __uint_as_float(r2[1]); }
            if (hg == 0) { stx[(eh * 128 + i) * 2] = s1; stx[(eh * 128 + i) * 2 + 1] = s2; }
            __syncthreads();
            { const float o1 = stx[((eh ^ 1) * 128 + i) * 2], o2 = stx[((eh ^ 1) * 128 + i) * 2 + 1]; s1 += o1; s2 += o2; }
            const float mu = s1 * (1.f / 256.f); const float var = fmaxf(s2 * (1.f / 256.f) - mu * mu, 0.f); const float rstd = 1.0f / sqrtf(var + EPS);
            {
                constexpr int YS = 264;
                bf16* ys = vt;
#pragma unroll
                for (int eb = 0; eb < 4; ++eb)
#pragma unroll
                    for (int g = 0; g < 4; ++g) { const int ec = 128 * eh + 32 * eb + 8 * g + 4 * hg;
                        v2u o; o.x = pk2((acc[eb][4 * g] - mu) * rstd, (acc[eb][4 * g + 1] - mu) * rstd); o.y = pk2((acc[eb][4 * g + 2] - mu) * rstd, (acc[eb][4 * g + 3] - mu) * rstd);
                        *(v2u*)(ys + i * YS + ec) = o; }
                __syncthreads();
#pragma unroll
                for (int q = 0; q < 8; ++q) { const int c = F.tid + q * NTHREADS, tkn = c >> 5, c8 = c & 31;
                    float yf[8], gf[8]; unpack8(*(const v4u*)(ys + tkn * YS + c8 * 8), yf); unpack8(*(const v4u*)(BIG + (t0 + tkn) * 3072 + 2 * RQK + RV + h * RDV + c8 * 8), gf);
                    float o[8];
#pragma unroll
                    for (int z = 0; z < 8; ++z) o[z] = yf[z] * gf[z] / (1.0f + __expf(-gf[z]));
                    v4u w; w.x = pk2(o[0], o[1]); w.y = pk2(o[2], o[3]); w.z = pk2(o[4], o[5]); w.w = pk2(o[6], o[7]);
                    *(v4u*)(ARET + (t0 + tkn) * 1024 + h * RDV + c8 * 8) = w; }
            }
        }
        SEAM(4);
    }

    if (IN(5)) {
        pg8::Gemm g{XN, WIN + (size_t)3072 * D, T, 5120, D, D, 0}; pg8::StaticOrder S; S.init(T, 5120, F.G, (int)blockIdx.x);
        pg8::EpiConvGates E{CB, UU, GATES};
        pg8::gemm_phase<pg8::EpiConvGates, pg8::StaticOrder, true>(ldsl, g, S, E);
        SEAM(5);
    }

    if (IN(6)) {
        for (int it = F.gt; it < (T / 8) * 128; it += F.NGT) {
            const int c8 = it & 127, t0 = (it >> 7) * 8, s0 = t0 & (SEQ - 1); const int col = c8 * 8;
            v4u uw[10], cw[8];
#pragma unroll
            for (int r = 0; r < 8; ++r) { uw[r + 2] = *(const v4u*)(UU + (size_t)(t0 + r) * 1024 + col); cw[r] = *(const v4u*)(CB + (size_t)(t0 + r) * 1024 + col); }
            if (s0 != 0) { uw[0] = *(const v4u*)(UU + (size_t)(t0 - 2) * 1024 + col); uw[1] = *(const v4u*)(UU + (size_t)(t0 - 1) * 1024 + col); }
            else { uw[0] = (v4u){0u, 0u, 0u, 0u}; uw[1] = (v4u){0u, 0u, 0u, 0u}; }
            float w0[8], w1[8], w2[8], bs[8];
            *(f32x4*)w0 = *(const f32x4*)(conv_w + col); *(f32x4*)(w0 + 4) = *(const f32x4*)(conv_w + col + 4);
            *(f32x4*)w1 = *(const f32x4*)(conv_w + 1024 + col); *(f32x4*)(w1 + 4) = *(const f32x4*)(conv_w + 1024 + col + 4);
            *(f32x4*)w2 = *(const f32x4*)(conv_w + 2048 + col); *(f32x4*)(w2 + 4) = *(const f32x4*)(conv_w + 2048 + col + 4);
            *(f32x4*)bs = *(const f32x4*)(conv_b + col); *(f32x4*)(bs + 4) = *(const f32x4*)(conv_b + col + 4);
            float ua[8], ub[8], uc[8];
            unpack8(uw[0], ua); unpack8(uw[1], ub);
#pragma unroll
            for (int r = 0; r < 8; ++r) {
                float cb[8], o[8]; unpack8(uw[r + 2], uc); unpack8(cw[r], cb);
#pragma unroll
                for (int z = 0; z < 8; ++z) { o[z] = cb[z] * (w0[z] * ua[z] + w1[z] * ub[z] + w2[z] * uc[z] + bs[z]); ua[z] = ub[z]; ub[z] = uc[z]; }
                v4u w; w.x = pk2(o[0], o[1]); w.y = pk2(o[2], o[3]); w.z = pk2(o[4], o[5]); w.w = pk2(o[6], o[7]);
                *(v4u*)(ACONV + (size_t)(t0 + r) * 1024 + col) = w;
            }
        }
        SEAM(6);
    }


    if (IN(8)) {
        pg8::StaticOrder S; S.init(T, D, F.G, (int)blockIdx.x);
        { pg8::Gemm g{ARET, WRU, T, D, D, D, 0}; pg8::EpiGate<false> E{M1, D, GATES, 2048, 0};
          pg8::gemm_phase<pg8::EpiGate<false>, pg8::StaticOrder, true>(ldsl, g, S, E); }
        asm volatile("s_waitcnt vmcnt(0)" ::: "memory"); __syncthreads();
        { pg8::Gemm g{ACONV, WCU, T, D, D, D, 0}; pg8::EpiGate<true> E{M1, D, GATES, 2048, 1024};
          pg8::gemm_phase<pg8::EpiGate<true>, pg8::StaticOrder, true>(ldsl, g, S, E); }
        SEAM(8);
    }

    if (IN(9)) {
        pg8::Gemm g{M1, WOUT, T, D, D, D, 0}; pg8::StaticOrder S; S.init(T, D, F.G, (int)blockIdx.x);
        pg8::EpiResBf16SS E{x, HB, SS1, D, T, XQ, XS};
        pg8::gemm_phase<pg8::EpiResBf16SS, pg8::StaticOrder, true>(ldsl, g, S, E);
        SEAM(9);
    }


    if (IN(11)) {
        { pg8::Gemm g{HB, WPQ, T, 2048, D, D, 0, 1}; pg8::StaticOrder S; S.init(T, 2048, F.G, (int)blockIdx.x);
          pg8::EpiBf16 E{QP, 2048};
          pg8::gemm_phase<pg8::EpiBf16, pg8::StaticOrder, true>(ldsl, g, S, E); }
        { pg8::Gemm g{PB, WPP, T, D, PLE, PLE, 0}; pg8::StaticOrder S; S.init(T, D, F.G, (int)blockIdx.x);
          pg8::EpiBf16 E{PLEB, D};
          pg8::gemm_phase<pg8::EpiBf16, pg8::StaticOrder, true>(ldsl, g, S, E); }
        SEAM(11);
    }

    if (IN(12)) {
        constexpr int LS = 136;
        bf16* k1s = (bf16*)lds; bf16* k2s = k1s + 128 * LS;
        const int h = blockIdx.x & 7;
        __syncthreads();
        for (int c = F.tid; c < 128 * 16; c += NTHREADS) { const int j = c >> 4, c8 = c & 15;
            *(v4u*)(k1s + j * LS + c8 * 8) = *(const v4u*)(K1 + ((size_t)h * 128 + j) * 128 + c8 * 8);
            *(v4u*)(k2s + j * LS + c8 * 8) = *(const v4u*)(K2 + ((size_t)h * 128 + j) * 128 + c8 * 8); }
        __syncthreads();
        const int r32 = F.lane & 31, hg = F.lane >> 5;
        const int nwv = (F.G >> 3) * NWAVES;
        for (int tt = (blockIdx.x >> 3) * NWAVES + F.wave; tt < T / 32; tt += nwv) {
            const int t0 = tt * 32;
            unsigned V1[16], V2[16];
            peer_half_topk(QP + (size_t)(t0 + r32) * 2048 + h * 256 + 8 * hg, k1s + r32 * 136 + 8 * hg, hg, V1);
            __builtin_amdgcn_sched_barrier(0);
            peer_half_topk(QP + (size_t)(t0 + r32) * 2048 + h * 256 + 128 + 8 * hg, k2s + r32 * 136 + 8 * hg, hg, V2);
            __builtin_amdgcn_sched_barrier(0);
            float v1[16], v2[16];
#pragma unroll
            for (int z = 0; z < 16; ++z) { v1[z] = ord_val(V1[z] & ~0x7Fu); v2[z] = ord_val(V2[z] & ~0x7Fu); }
#define CKEY(a, b) ((ord_key(v1[a] + v2[b]) & ~0xFFu) | (unsigned)(255 - ((a) * 16 + (b))))
            unsigned g0[16], g1[16], g2[16], g3[16];
#pragma unroll
            for (int b = 0; b < 16; ++b) g0[b] = CKEY(0, b);
#pragma unroll
            for (int b = 0; b < 8; ++b) g1[b] = CKEY(1, b);
#pragma unroll
            for (int b = 0; b < 5; ++b) g1[8 + b] = CKEY(2, b);
#pragma unroll
            for (int b = 0; b < 3; ++b) g1[13 + b] = CKEY(3, b);
            g2[0] = CKEY(3, 3);
#pragma unroll
            for (int b = 0; b < 3; ++b) g2[1 + b] = CKEY(4, b);
#pragma unroll
            for (int b = 0; b < 2; ++b) { g2[4 + b] = CKEY(5, b); g2[6 + b] = CKEY(6, b); g2[8 + b] = CKEY(7, b); }
#pragma unroll
            for (int a = 8; a < 14; ++a) g2[10 + (a - 8)] = CKEY(a, 0);
            { const unsigned c14 = CKEY(14, 0), c15 = CKEY(15, 0); g3[0] = max(c14, c15); g3[1] = min(c14, c15); }
#pragma unroll
            for (int z = 2; z < 16; ++z) g3[z] = 0u;
#undef CKEY
            sort16_desc(g1); sort16_desc(g2); merge16_desc(g1, g2); merge16_desc(g1, g3); merge16_desc(g0, g1);
            float ts[16], ex[16]; float den = 0.f;
            float rs1;
            { const f32x4* sp = (const f32x4*)(SS1 + (size_t)(t0 + r32) * 16); const f32x4 s0 = sp[0], s1 = sp[1], s2 = sp[2], s3 = sp[3];
              const float ssum = ((s0[0] + s0[1]) + (s0[2] + s0[3])) + ((s1[0] + s1[1]) + (s1[2] + s1[3])) + ((s2[0] + s2[1]) + (s2[2] + s2[3])) + ((s3[0] + s3[1]) + (s3[2] + s3[3]));
              rs1 = 1.0f / sqrtf(ssum * (1.f / D) + EPS); }
#pragma unroll
            for (int z = 0; z < 16; ++z) ts[z] = ord_val(g0[z] & ~0xFFu) * rs1;
#pragma unroll
            for (int z = 0; z < 16; ++z) { ex[z] = __expf(ts[z] - ts[0]); den += ex[z]; }
            const float inv = 1.0f / den;
            int oi[8]; float og[8];
#pragma unroll
            for (int rr = 0; rr < 8; ++rr) {
                unsigned klo = g0[rr], khi = g0[8 + rr]; float elo = ex[rr], ehi = ex[8 + rr];
                asm volatile("" : "+v"(klo), "+v"(khi), "+v"(elo), "+v"(ehi));
                const unsigned key = hg ? khi : klo; const int c = 255 - (int)(key & 0xFFu); const int a = c >> 4, b = c & 15;
                unsigned ka = V1[0], kb2 = V2[0];
#pragma unroll
                for (int z = 1; z < 16; ++z) { ka = (a == z) ? V1[z] : ka; kb2 = (b == z) ? V2[z] : kb2; }
                oi[rr] = (127 - (int)(ka & 0x7Fu)) * PNK + (127 - (int)(kb2 & 0x7Fu));
                og[rr] = (hg ? ehi : elo) * inv;
            }
            int* ip = IDX + (size_t)(t0 + r32) * NSEL + h * PTOPK + 8 * hg; float* gp = GATE + (size_t)(t0 + r32) * NSEL + h * PTOPK + 8 * hg;
            *(v4u*)ip = (v4u){(unsigned)oi[0], (unsigned)oi[1], (unsigned)oi[2], (unsigned)oi[3]}; *(v4u*)(ip + 4) = (v4u){(unsigned)oi[4], (unsigned)oi[5], (unsigned)oi[6], (unsigned)oi[7]};
            *(f32x4*)gp = (f32x4){og[0], og[1], og[2], og[3]}; *(f32x4*)(gp + 4) = (f32x4){og[4], og[5], og[6], og[7]};
        }
        SEAM(12);
    }

    if (IN(13)) {
        volatile int* item_w = (volatile int*)(lds + 1024);
        const int s8 = F.lane & 7, r8 = F.lane >> 3; const int xcc = (int)(xb_xcc_id() & 7u);
        for (;;) {
            __syncthreads();
            if (F.tid == 0) { int it = -1;
                for (int k = 0; k < 8 && it < 0; ++k) { const int jj = (xcc + k) & 7; const unsigned cc = __hip_atomic_fetch_add(WCNT + jj, 1u, __ATOMIC_RELAXED, __HIP_MEMORY_SCOPE_AGENT); if (cc < (unsigned)(T / 64)) it = (jj << 16) | (int)cc; }
                item_w[0] = it; }
            __syncthreads();
            const int item = item_w[0];
            if (item < 0) break;
            const int j = item >> 16, ch = item & 0xffff;
            const unsigned char* tabj = U8 + (size_t)j * PNE_ROWS * 128 + s8 * 16;
            const int tb = ch * 64 + F.wave * 8;
            int ida[8], idb[8]; v4u xa[8]; float xsc[8];
#pragma unroll
            for (int tt = 0; tt < 8; ++tt) { ida[tt] = IDX[(size_t)(tb + tt) * NSEL + F.lane]; idb[tt] = IDX[(size_t)(tb + tt) * NSEL + 64 + F.lane];
                xa[tt] = *(const v4u*)(XQ + (size_t)(tb + tt) * D + 128 * j + 16 * s8); xsc[tt] = XS[(size_t)(tb + tt) * 32 + 4 * j + (s8 >> 1)]; }
            v4u rowsA[8], rowsB[8];
#define P13_ROWS(buf, tt, hh) do { _Pragma("unroll") for (int g = 0; g < 8; ++g) { const int id = __shfl((hh) ? idb[tt] : ida[tt], 8 * g + r8); buf[g] = *(const v4u*)(tabj + (size_t)id * 128); } } while (0)
#define P13_DOT(buf, hh, xq, sx, pp) do { \
                _Pragma("unroll") for (int g = 0; g < 8; ++g) { int d_ = __builtin_amdgcn_sdot4((int)buf[g].x, xq[0], 0, false); d_ = __builtin_amdgcn_sdot4((int)buf[g].y, xq[1], d_, false); \
                    d_ = __builtin_amdgcn_sdot4((int)buf[g].z, xq[2], d_, false); d_ = __builtin_amdgcn_sdot4((int)buf[g].w, xq[3], d_, false); \
                    pp[8 * (hh) + g] = (float)d_ * sx; } } while (0)
            const bool b4_ = (s8 & 4) != 0, b2_ = (s8 & 2) != 0, b1_ = (s8 & 1) != 0;
            P13_ROWS(rowsA, 0, 0);
#pragma unroll
            for (int tt = 0; tt < 8; ++tt) {
                float pp[16];
                P13_ROWS(rowsB, tt, 1);
                const float sx = xsc[tt]; int xq[4]; xq[0] = (int)xa[tt].x; xq[1] = (int)xa[tt].y; xq[2] = (int)xa[tt].z; xq[3] = (int)xa[tt].w;
                P13_DOT(rowsA, 0, xq, sx, pp); __builtin_amdgcn_sched_barrier(0);
                if (tt < 7) P13_ROWS(rowsA, tt + 1, 0);
                P13_DOT(rowsB, 1, xq, sx, pp);
                float a8[8], a4[4], a2[2];
#pragma unroll
                for (int g = 0; g < 8; ++g) { const float keep = b4_ ? pp[g + 8] : pp[g], give = b4_ ? pp[g] : pp[g + 8]; a8[g] = keep + __shfl_xor(give, 4); }
#pragma unroll
                for (int g = 0; g < 4; ++g) { const float keep = b2_ ? a8[g + 4] : a8[g], give = b2_ ? a8[g] : a8[g + 4]; a4[g] = keep + __shfl_xor(give, 2); }
#pragma unroll
                for (int g = 0; g < 2; ++g) { const float keep = b1_ ? a4[g + 2] : a4[g], give = b1_ ? a4[g] : a4[g + 2]; a2[g] = keep + __shfl_xor(give, 1); }
                float* pa = PACT + ((size_t)j * T + (tb + tt)) * NSEL + 16 * s8 + r8; pa[0] = a2[0]; pa[8] = a2[1];
                __builtin_amdgcn_sched_barrier(0);
            }
#undef P13_ROWS
#undef P13_DOT
        }
        SEAM(13);
    }

    if (IN(14)) {
        unsigned* tl = (unsigned*)lds;
        for (int ch = blockIdx.x; ch < T / 64; ch += F.G) {
            __syncthreads();
#pragma unroll 1
            for (int tt = 0; tt < 8; ++tt) {
                const int tloc = F.wave * 8 + tt, t = ch * 64 + tloc;
                float ssum = 0.f;
                if (F.lane < 16) ssum = SS1[(size_t)t * 16 + F.lane];
                ssum = wave_sum(ssum);
                const float rs1 = 1.0f / sqrtf(ssum * (1.f / D) + EPS);
                float a0 = 0.f, a1 = 0.f;
#pragma unroll
                for (int j = 0; j < 8; ++j) { const float* pa = PACT + ((size_t)j * T + t) * NSEL + F.lane; a0 += pa[0]; a1 += pa[64]; }
                const int id0 = IDX[(size_t)t * NSEL + F.lane], id1 = IDX[(size_t)t * NSEL + 64 + F.lane];
                const float g0 = GATE[(size_t)t * NSEL + F.lane], g1 = GATE[(size_t)t * NSEL + 64 + F.lane];
                const float w0 = g0 * gelu_f(a0 * rs1 * SU[id0]) * SV[id0], w1 = g1 * gelu_f(a1 * rs1 * SU[id1]) * SV[id1];
                const float am = wave_max(fmaxf(fabsf(w0), fabsf(w1))); const float qs = am > 0.f ? 127.0f / am : 0.f;
                tl[F.lane * 65 + tloc] = ((unsigned)id0 << 11) | ((unsigned)((int)rintf(w0 * qs)) & 0xffu);
                tl[(64 + F.lane) * 65 + tloc] = ((unsigned)id1 << 11) | ((unsigned)((int)rintf(w1 * qs)) & 0xffu);
                if (F.lane == 0) WSC[t] = am * (1.0f / 127.0f);
            }
            __syncthreads();
#pragma unroll
            for (int q = 0; q < 16; ++q) { const int c = F.tid + q * NTHREADS, e_ = c >> 6, tl_ = c & 63; KK[(size_t)e_ * T + ch * 64 + tl_] = tl[e_ * 65 + tl_]; }
        }
        SEAM(14);
    }

    if (IN(7)) {
        LAS const unsigned char* vl3 = (LAS const unsigned char*)lds;
        const __amdgpu_buffer_rsrc_t rsK = __builtin_amdgcn_make_buffer_rsrc((void*)KK, 0, NSEL * T * 4, 0x00020000);
        for (int work = blockIdx.x; work < 256; work += F.G) {
            const int sl = work >> 1, tbase = (work & 1) * (T / 2);
            __syncthreads();
            for (int c = F.tid; c < PNE_ROWS * 8 / 16; c += NTHREADS) *((v4u*)lds + c) = *((const v4u*)(V8 + (size_t)sl * PNE_ROWS * 8) + c);
            __syncthreads();
#pragma unroll 1
            for (int grp = F.wave; grp < T / 2 / 64; grp += NWAVES) {
                const int t = tbase + grp * 64 + F.lane;
                const int kvo = t * 4;
                int acci[8];
#pragma unroll
                for (int z = 0; z < 8; ++z) acci[z] = 0;
                unsigned kc[2][32];
#pragma unroll
                for (int q = 0; q < 32; ++q) kc[0][q] = __builtin_amdgcn_raw_buffer_load_b32(rsK, kvo, q * (T * 4), 0);
#pragma unroll
                for (int ck = 0; ck < 4; ++ck) {
                    if (ck < 3) {
#pragma unroll
                        for (int q = 0; q < 32; ++q) kc[(ck + 1) & 1][q] = __builtin_amdgcn_raw_buffer_load_b32(rsK, kvo, (32 * (ck + 1) + q) * (T * 4), 0);
                    }
#pragma unroll
                    for (int e8 = 0; e8 < 4; ++e8) {
                        v2u vr[8];
#pragma unroll
                        for (int q = 0; q < 8; ++q) vr[q] = *(const LAS v2u*)(vl3 + (kc[ck & 1][8 * e8 + q] >> 8));
#pragma unroll
                        for (int g4 = 0; g4 < 2; ++g4) {
                            const unsigned k0 = kc[ck & 1][8 * e8 + 4 * g4], k1 = kc[ck & 1][8 * e8 + 4 * g4 + 1], k2 = kc[ck & 1][8 * e8 + 4 * g4 + 2], k3 = kc[ck & 1][8 * e8 + 4 * g4 + 3];
                            const unsigned w01_ = __builtin_amdgcn_perm(k1, k0, 0x0c0c0400u), w23_ = __builtin_amdgcn_perm(k3, k2, 0x0c0c0400u); const int w4_ = (int)__builtin_amdgcn_perm(w23_, w01_, 0x05040100u);
#pragma unroll
                            for (int c4 = 0; c4 < 2; ++c4) { const unsigned a_ = vr[4 * g4][c4], b_ = vr[4 * g4 + 1][c4], c_ = vr[4 * g4 + 2][c4], d_ = vr[4 * g4 + 3][c4];
                                const unsigned t0_ = __builtin_amdgcn_perm(b_, a_, 0x05010400u), t1_ = __builtin_amdgcn_perm(b_, a_, 0x07030602u), t2_ = __builtin_amdgcn_perm(d_, c_, 0x05010400u), t3_ = __builtin_amdgcn_perm(d_, c_, 0x07030602u);
                                acci[4 * c4 + 0] = __builtin_amdgcn_sdot4((int)__builtin_amdgcn_perm(t2_, t0_, 0x05040100u), w4_, acci[4 * c4 + 0], false);
                                acci[4 * c4 + 1] = __builtin_amdgcn_sdot4((int)__builtin_amdgcn_perm(t2_, t0_, 0x07060302u), w4_, acci[4 * c4 + 1], false);
                                acci[4 * c4 + 2] = __builtin_amdgcn_sdot4((int)__builtin_amdgcn_perm(t3_, t1_, 0x05040100u), w4_, acci[4 * c4 + 2], false);
                                acci[4 * c4 + 3] = __builtin_amdgcn_sdot4((int)__builtin_amdgcn_perm(t3_, t1_, 0x07060302u), w4_, acci[4 * c4 + 3], false); }
                        }
                    }
                }
                const float wsc = WSC[t];
                v4u* hp = (v4u*)(HB + ((size_t)sl * T + t) * 8);
                float hf[8]; unpack8(*hp, hf);
                float ssq = 0.f;
#pragma unroll
                for (int z = 0; z < 8; ++z) { hf[z] += (float)acci[z] * wsc; ssq += hf[z] * hf[z]; }
                v4u o; o.x = pk2(hf[0], hf[1]); o.y = pk2(hf[2], hf[3]); o.z = pk2(hf[4], hf[5]); o.w = pk2(hf[6], hf[7]);
                *hp = o;
                SSP[(size_t)sl * T + t] = ssq;
            }
        }
        SEAM(7);
    }

    if (IN(10)) {
        for (int t = F.gt; t < T; t += F.NGT) { float s_ = 0.f;
#pragma unroll 16
            for (int sl = 0; sl < 128; ++sl) s_ += SSP[(size_t)sl * T + t];
            RS2[t] = 1.0f / sqrtf(s_ * (1.f / D) + EPS); }
        SEAM(10);
    }


    if (IN(15)) {
        pg8::Gemm g{HB, WPG, T, D, D, D, 0, 1}; pg8::StaticOrder S; S.init(T, D, F.G, (int)blockIdx.x);
        pg8::EpiPleBf16SS E{HB, PLEB, H3B, RS2, SS3, D};
        pg8::gemm_phase<pg8::EpiPleBf16SS, pg8::StaticOrder, true>(ldsl, g, S, E);
        SEAM(15);
    }

    if (IN(16)) {
        const f32x4* gr = (const f32x4*)g_final + F.lane;
        f32x4 gg[4];
#pragma unroll
        for (int j = 0; j < 4; ++j) gg[j] = gr[64 * j];
        for (int m = F.gw; m < T / 2; m += F.NGW) {
            const int ma = m, mb = m + T / 2;
            float sa = 0.f, sb = 0.f;
            if (F.lane < 16) { sa = SS3[(size_t)ma * 16 + F.lane]; sb = SS3[(size_t)mb * 16 + F.lane]; }
            const v2u* ha = (const v2u*)(H3B + (size_t)ma * D) + F.lane; const v2u* hb = (const v2u*)(H3B + (size_t)mb * D) + F.lane;
            v2u wa[4], wb[4];
#pragma unroll
            for (int j = 0; j < 4; ++j) { wa[j] = ha[64 * j]; wb[j] = hb[64 * j]; }
            sa = wave_sum(sa); sb = wave_sum(sb);
            const float ra = 1.0f / sqrtf(sa * (1.f / D) + EPS), rb = 1.0f / sqrtf(sb * (1.f / D) + EPS);
            f32x4* oa = (f32x4*)(out + (size_t)ma * D) + F.lane; f32x4* ob = (f32x4*)(out + (size_t)mb * D) + F.lane;
#pragma unroll
            for (int j = 0; j < 4; ++j) {
                oa[64 * j] = (f32x4){bflo(wa[j].x) * ra * gg[j][0], bfhi(wa[j].x) * ra * gg[j][1], bflo(wa[j].y) * ra * gg[j][2], bfhi(wa[j].y) * ra * gg[j][3]};
                ob[64 * j] = (f32x4){bflo(wb[j].x) * rb * gg[j][0], bfhi(wb[j].x) * rb * gg[j][1], bflo(wb[j].y) * rb * gg[j][2], bfhi(wb[j].y) * rb * gg[j][3]}; }
        }
    }
#undef IN
#undef SEAM
}

constexpr int N_PHASES = 17;

extern "C" void kernel_launch(void* const* d_in, const int* in_sizes, int n_in, void* d_out, int out_size, void* d_ws, size_t ws_size, hipStream_t stream) {
    static int grid = 0;
    if (grid == 0) {
        if (n_in != 19 || out_size != T * D || ws_size < WS_END) { fprintf(stderr, "kernel_launch: unexpected shapes: n_in %d out %d ws %zu\n", n_in, out_size, ws_size); grid = -1; return; }
        int dev = 0, cus = 0, per_cu = 0;
        hipGetDevice(&dev); hipDeviceGetAttribute(&cus, hipDeviceAttributeMultiprocessorCount, dev);
        if (hipFuncSetAttribute((const void*)mega, hipFuncAttributeMaxDynamicSharedMemorySize, LDS_BYTES) != hipSuccess) { fprintf(stderr, "kernel_launch: hipFuncSetAttribute failed\n"); grid = -1; return; }
        if (hipOccupancyMaxActiveBlocksPerMultiprocessor(&per_cu, (const void*)mega, NTHREADS, LDS_BYTES) != hipSuccess || per_cu < 1) { fprintf(stderr, "kernel_launch: occupancy query says %d\n", per_cu); per_cu = 1; }
        (void)hipGetLastError();
        grid = cus;
        if (grid % 8 != 0) fprintf(stderr, "kernel_launch: grid %d not a multiple of 8\n", grid);
    }
    if (grid < 0) return;
    Args a{};
    for (int i = 0; i < 19; ++i) a.in[i] = (const float*)d_in[i];
    a.out = (float*)d_out; a.ws = (unsigned char*)d_ws;
#if MK_ONE_LAUNCH
    a.ph_lo = 0; a.ph_hi = N_PHASES;
    if (hipMemsetAsync((char*)d_ws + WS_CTL, 0, CTL_ZERO_BYTES, stream) != hipSuccess) { fprintf(stderr, "kernel_launch: memset failed\n"); return; }
    void* kargs[] = {&a};
    hipError_t e = hipLaunchCooperativeKernel((const void*)mega, dim3(grid), dim3(NTHREADS), kargs, LDS_BYTES, stream);
    if (e != hipSuccess) fprintf(stderr, "cooperative launch failed: %s (grid %d)\n", hipGetErrorString(e), grid);
#else
    for (int ph = 0; ph < N_PHASES; ++ph) {
        a.ph_lo = ph; a.ph_hi = ph + 1;
        hipLaunchKernelGGL(mega, dim3(grid), dim3(NTHREADS), LDS_BYTES, stream, a);
    }
#endif
}
```

```cpp
#include <hip/hip_runtime.h>
#include <hip/hip_cooperative_groups.h>
#include <cstdio>
#include <cstdint>
#include <cmath>
namespace cg = cooperative_groups;

#ifndef MK_ONE_LAUNCH
#define MK_ONE_LAUNCH 1
#endif

namespace pg8 {
#define PG8_LAS __attribute__((address_space(3)))
typedef unsigned short bf16_t;
typedef short bf16x8 __attribute__((ext_vector_type(8)));
typedef float f32x4 __attribute__((ext_vector_type(4)));
typedef unsigned u32x4 __attribute__((ext_vector_type(4)));
typedef unsigned u32x2 __attribute__((ext_vector_type(2)));
constexpr int BM = 256, BK = 64, HALF = 128, HTB = HALF * BK * 2, STAGE_BYTES = 8 * HTB, NXCD = 8, WGM = 8;

__host__ __device__ __forceinline__ int lds_byte(int r, int c) { const int st = (r >> 4) * 2 + (c >> 5), rr = r & 15, cc = c & 31, ob = rr * 64 + cc * 2; return st * 1024 + (ob ^ (((ob >> 9) & 1) << 5)); }
__host__ __device__ __forceinline__ void stage_rc(int b, int& R, int& C) { const int st = b / 1024, sb = b % 1024, swz = sb ^ (((sb >> 9) & 1) << 5); R = (st >> 1) * 16 + swz / 64; C = (st & 1) * 32 + (swz % 64) / 2; }
__host__ __device__ __forceinline__ int perm32(int rho) { const int n = rho >> 4, i = rho & 15; return 8 * (i >> 2) + 4 * n + (i & 3); }

struct Unit { int pm, pn; };
struct Gemm { const bf16_t* A; const bf16_t* Bt; int M, N, K, lda, a_pn_cols, a_slices = 0; };

struct StaticOrder {
    int nM, nN, nwg, G, c;
    __host__ __device__ void init(int M, int N, int G_, int c_) { nM = M / BM; nN = N / BM; nwg = nM * nN; G = G_; c = c_; }
    __host__ __device__ __forceinline__ bool next(int i, Unit& u) const {
        const long L = (long)i * G + c; if (L >= nwg) return false;
        int wgid = (int)L; { const int q = nwg / NXCD, r = nwg % NXCD, xcd = wgid % NXCD, off = wgid / NXCD; wgid = (xcd < r ? xcd * (q + 1) : r * (q + 1) + (xcd - r) * q) + off; }
        const int nig = WGM * nN, gid = wgid / nig, fm = gid * WGM, gsz = (nM - fm) < WGM ? (nM - fm) : WGM;
        u.pm = fm + ((wgid % nig) % gsz); u.pn = (wgid % nig) / gsz; return true;
    }
    __device__ __forceinline__ void a_ready(const Unit&) const {}
    __device__ __forceinline__ void done(const Unit&) const {}
};

__device__ __forceinline__ unsigned cvt_pk_bf16(float lo, float hi) { unsigned r; asm volatile("v_cvt_pk_bf16_f32 %0, %1, %2" : "=v"(r) : "v"(lo), "v"(hi)); return r; }
__device__ __forceinline__ float bf_lo(unsigned w) { return __uint_as_float(w << 16); }
__device__ __forceinline__ float bf_hi(unsigned w) { return __uint_as_float(w & 0xffff0000u); }
__device__ __forceinline__ float xsum_1632(float v) {
    { auto r = __builtin_amdgcn_permlane16_swap(__float_as_uint(v), __float_as_uint(v), false, false); v = __uint_as_float(r[0]) + __uint_as_float(r[1]); }
    { auto r = __builtin_amdgcn_permlane32_swap(__float_as_uint(v), __float_as_uint(v), false, false); v = __uint_as_float(r[0]) + __uint_as_float(r[1]); }
    return v;
}
__device__ __forceinline__ float xmax_1632(float v) {
    { auto r = __builtin_amdgcn_permlane16_swap(__float_as_uint(v), __float_as_uint(v), false, false); v = fmaxf(__uint_as_float(r[0]), __uint_as_float(r[1])); }
    { auto r = __builtin_amdgcn_permlane32_swap(__float_as_uint(v), __float_as_uint(v), false, false); v = fmaxf(__uint_as_float(r[0]), __uint_as_float(r[1])); }
    return v;
}
__device__ __forceinline__ float sigmoidf_(float x) { return __builtin_amdgcn_rcpf(1.0f + __expf(-x)); }

struct EpiBf16 {
    static constexpr bool PERM = true, AFTER_DRAIN = false;
    bf16_t* O; int ldc;
    __device__ __forceinline__ void operator()(const f32x4 (&acc)[2][2][4][2], const Unit& u, int wr, int wc, int fr, int fq) const {
        const int row0 = u.pm * BM + wr * 64 + fr; const int col0 = u.pn * BM + wc * 32 + 8 * fq;
#pragma unroll
        for (int ai = 0; ai < 2; ++ai)
#pragma unroll
            for (int m = 0; m < 4; ++m) { bf16_t* rowp = O + (size_t)(row0 + ai * HALF + m * 16) * ldc + col0;
#pragma unroll
                for (int bj = 0; bj < 2; ++bj) { const f32x4 v0 = acc[ai][bj][m][0], v1 = acc[ai][bj][m][1];
                    u32x4 w; w.x = cvt_pk_bf16(v0[0], v0[1]); w.y = cvt_pk_bf16(v0[2], v0[3]); w.z = cvt_pk_bf16(v1[0], v1[1]); w.w = cvt_pk_bf16(v1[2], v1[3]);
                    *(u32x4*)(rowp + bj * HALF) = w; } }
    }
};
template <bool ACCUM> struct EpiGate {
    static constexpr bool PERM = true, AFTER_DRAIN = false;
    bf16_t* O; int ldc; const bf16_t* G; int ldg; int gcol;
    __device__ __forceinline__ void operator()(const f32x4 (&acc)[2][2][4][2], const Unit& u, int wr, int wc, int fr, int fq) const {
        const int row0 = u.pm * BM + wr * 64 + fr; const int col0 = u.pn * BM + wc * 32 + 8 * fq;
#pragma unroll
        for (int ai = 0; ai < 2; ++ai) {
            u32x2 gpre[4][2]; u32x4 opre[4][2];
#pragma unroll
            for (int m = 0; m < 4; ++m)
#pragma unroll
                for (int bj = 0; bj < 2; ++bj) { const size_t r = (size_t)(row0 + ai * HALF + m * 16); gpre[m][bj] = *(const u32x2*)((const unsigned char*)G + r * ldg + gcol + col0 + bj * HALF);
                    if (ACCUM) opre[m][bj] = *(const u32x4*)(O + r * ldc + col0 + bj * HALF); }
            asm volatile("" ::: "memory");
#pragma unroll
            for (int m = 0; m < 4; ++m) { const size_t r = (size_t)(row0 + ai * HALF + m * 16);
#pragma unroll
                for (int bj = 0; bj < 2; ++bj) { const f32x4 v0 = acc[ai][bj][m][0], v1 = acc[ai][bj][m][1];
                    const u32x2 g = gpre[m][bj]; constexpr float k255 = 1.0f / 255.0f;
                    float o[8];
                    o[0] = (float)(g.x & 0xffu) * k255 * v0[0]; o[1] = (float)((g.x >> 8) & 0xffu) * k255 * v0[1]; o[2] = (float)((g.x >> 16) & 0xffu) * k255 * v0[2]; o[3] = (float)(g.x >> 24) * k255 * v0[3];
                    o[4] = (float)(g.y & 0xffu) * k255 * v1[0]; o[5] = (float)((g.y >> 8) & 0xffu) * k255 * v1[1]; o[6] = (float)((g.y >> 16) & 0xffu) * k255 * v1[2]; o[7] = (float)(g.y >> 24) * k255 * v1[3];
                    bf16_t* op = O + r * ldc + col0 + bj * HALF;
                    if (ACCUM) { const u32x4 p = opre[m][bj];
                        o[0] += bf_lo(p.x); o[1] += bf_hi(p.x); o[2] += bf_lo(p.y); o[3] += bf_hi(p.y); o[4] += bf_lo(p.z); o[5] += bf_hi(p.z); o[6] += bf_lo(p.w); o[7] += bf_hi(p.w); }
                    u32x4 w; w.x = cvt_pk_bf16(o[0], o[1]); w.y = cvt_pk_bf16(o[2], o[3]); w.z = cvt_pk_bf16(o[4], o[5]); w.w = cvt_pk_bf16(o[6], o[7]);
                    *(u32x4*)op = w; } }
        }
    }
};
struct EpiResF32 {
    static constexpr bool PERM = false, AFTER_DRAIN = false;
    const float* base; float* out; int ldc;
    __device__ __forceinline__ void operator()(const f32x4 (&acc)[2][2][4][2], const Unit& u, int wr, int wc, int fr, int fq) const {
        const int row0 = u.pm * BM + wr * 64 + fr; const int col0 = u.pn * BM + wc * 32 + 4 * fq;
#pragma unroll
        for (int ai = 0; ai < 2; ++ai)
#pragma unroll
            for (int m = 0; m < 4; ++m) { const size_t off = (size_t)(row0 + ai * HALF + m * 16) * ldc + col0;
#pragma unroll
                for (int bj = 0; bj < 2; ++bj)
#pragma unroll
                    for (int n = 0; n < 2; ++n) { const f32x4 b = *(const f32x4*)(base + off + bj * HALF + n * 16); *(f32x4*)(out + off + bj * HALF + n * 16) = b + acc[ai][bj][m][n]; } }
    }
};
struct EpiQKVG {
    static constexpr bool PERM = true, AFTER_DRAIN = false;
    bf16_t* O; const float* COS; const float* SIN;
    __device__ __forceinline__ void operator()(const f32x4 (&acc)[2][2][4][2], const Unit& u, int wr, int wc, int fr, int fq) const {
        const int row0 = u.pm * BM + wr * 64 + fr; const int col0 = u.pn * BM + wc * 32 + 8 * fq;
        const bool rot = u.pn < 4; const float sc = (u.pn >= 2 && u.pn < 4) ? 0.08838834764831845f : 1.0f; const int i0 = 4 * (wc * 4 + fq);
#pragma unroll
        for (int ai = 0; ai < 2; ++ai)
#pragma unroll
            for (int m = 0; m < 4; ++m) { const int row = row0 + ai * HALF + m * 16; bf16_t* rowp = O + (size_t)row * 3072 + col0;
                f32x4 c = (f32x4){1.f, 1.f, 1.f, 1.f}, s = (f32x4){0.f, 0.f, 0.f, 0.f};
                if (rot) { const size_t ti = (size_t)(row & 4095) * 64 + i0; c = *(const f32x4*)(COS + ti) * sc; s = *(const f32x4*)(SIN + ti) * sc; }
#pragma unroll
                for (int bj = 0; bj < 2; ++bj) { f32x4 v0 = acc[ai][bj][m][0], v1 = acc[ai][bj][m][1];
                    if (rot) { const f32x4 r1 = v0 * c - v1 * s, r2 = v0 * s + v1 * c; v0 = r1; v1 = r2; }
                    u32x4 w; w.x = cvt_pk_bf16(v0[0], v0[1]); w.y = cvt_pk_bf16(v0[2], v0[3]); w.z = cvt_pk_bf16(v1[0], v1[1]); w.w = cvt_pk_bf16(v1[2], v1[3]);
                    *(u32x4*)(rowp + bj * HALF) = w; } }
    }
};
struct EpiConvGates {
    static constexpr bool PERM = true, AFTER_DRAIN = false;
    bf16_t* CB; bf16_t* UU; bf16_t* GT;
    __device__ __forceinline__ void operator()(const f32x4 (&acc)[2][2][4][2], const Unit& u, int wr, int wc, int fr, int fq) const {
        const int row0 = u.pm * BM + wr * 64 + fr;
        if (u.pn >= 4 && u.pn < 12) {
            const int col0 = (u.pn - 4) * 128 + wc * 32 + 8 * fq;
#pragma unroll
            for (int ai = 0; ai < 2; ++ai)
#pragma unroll
                for (int m = 0; m < 4; ++m) { const f32x4 v0 = acc[ai][0][m][0] * acc[ai][1][m][0], v1 = acc[ai][0][m][1] * acc[ai][1][m][1];
                    u32x4 w; w.x = cvt_pk_bf16(v0[0], v0[1]); w.y = cvt_pk_bf16(v0[2], v0[3]); w.z = cvt_pk_bf16(v1[0], v1[1]); w.w = cvt_pk_bf16(v1[2], v1[3]);
                    *(u32x4*)(UU + (size_t)(row0 + ai * HALF + m * 16) * 1024 + col0) = w; }
        } else if (u.pn >= 12) {
            unsigned char* G8 = (unsigned char*)GT; const int col0 = (u.pn - 12) * BM + wc * 32 + 8 * fq;
#pragma unroll
            for (int ai = 0; ai < 2; ++ai)
#pragma unroll
                for (int m = 0; m < 4; ++m) { unsigned char* rowp = G8 + (size_t)(row0 + ai * HALF + m * 16) * 2048 + col0;
#pragma unroll
                    for (int bj = 0; bj < 2; ++bj) { const f32x4 v0 = acc[ai][bj][m][0], v1 = acc[ai][bj][m][1];
                        u32x2 w; w.x = 0u; w.y = 0u;
#pragma unroll
                        for (int z = 0; z < 4; ++z) { w.x = __builtin_amdgcn_cvt_pk_u8_f32(sigmoidf_(v0[z]) * 255.0f, z, w.x); w.y = __builtin_amdgcn_cvt_pk_u8_f32(sigmoidf_(v1[z]) * 255.0f, z, w.y); }
                        *(u32x2*)(rowp + bj * HALF) = w; } }
        } else {
            bf16_t* O = CB; const int ldc = 1024; const int col0 = u.pn * BM + wc * 32 + 8 * fq;
#pragma unroll
            for (int ai = 0; ai < 2; ++ai)
#pragma unroll
                for (int m = 0; m < 4; ++m) { bf16_t* rowp = O + (size_t)(row0 + ai * HALF + m * 16) * ldc + col0;
#pragma unroll
                    for (int bj = 0; bj < 2; ++bj) { const f32x4 v0 = acc[ai][bj][m][0], v1 = acc[ai][bj][m][1];
                        u32x4 w; w.x = cvt_pk_bf16(v0[0], v0[1]); w.y = cvt_pk_bf16(v0[2], v0[3]); w.z = cvt_pk_bf16(v1[0], v1[1]); w.w = cvt_pk_bf16(v1[2], v1[3]);
                        *(u32x4*)(rowp + bj * HALF) = w; } }
        }
    }
};
struct EpiResBf16SS {
    static constexpr bool PERM = true, AFTER_DRAIN = false;
    const float* base; bf16_t* O; float* SS; int ldc; int orows;
    unsigned char* XQ; float* XS;
    __device__ __forceinline__ void operator()(const f32x4 (&acc)[2][2][4][2], const Unit& u, int wr, int wc, int fr, int fq) const {
        const int row0 = u.pm * BM + wr * 64 + fr; const int col0 = u.pn * BM + wc * 32 + 8 * fq;
#pragma unroll
        for (int ai = 0; ai < 2; ++ai) {
            f32x4 pre[4][2][2];
#pragma unroll
            for (int m = 0; m < 4; ++m)
#pragma unroll
                for (int bj = 0; bj < 2; ++bj) { const size_t o = (size_t)(row0 + ai * HALF + m * 16) * ldc + col0 + bj * HALF; pre[m][bj][0] = *(const f32x4*)(base + o); pre[m][bj][1] = *(const f32x4*)(base + o + 4); }
            asm volatile("" ::: "memory");
#pragma unroll
            for (int m = 0; m < 4; ++m) { const size_t r = (size_t)(row0 + ai * HALF + m * 16); float ssq = 0.f;
#pragma unroll
                for (int bj = 0; bj < 2; ++bj) { const size_t o = r * ldc + col0 + bj * HALF;
                    const f32x4 h0 = pre[m][bj][0] + acc[ai][bj][m][0], h1 = pre[m][bj][1] + acc[ai][bj][m][1];
                    ssq += (h0[0] * h0[0] + h0[1] * h0[1]) + (h0[2] * h0[2] + h0[3] * h0[3]) + (h1[0] * h1[0] + h1[1] * h1[1]) + (h1[2] * h1[2] + h1[3] * h1[3]);
                    u32x4 w; w.x = cvt_pk_bf16(h0[0], h0[1]); w.y = cvt_pk_bf16(h0[2], h0[3]); w.z = cvt_pk_bf16(h1[0], h1[1]); w.w = cvt_pk_bf16(h1[2], h1[3]);
                    *(u32x4*)(O + ((size_t)((col0 + bj * HALF) >> 3) * orows + r) * 8) = w;
                    float am = fmaxf(fmaxf(fmaxf(fabsf(h0[0]), fabsf(h0[1])), fmaxf(fabsf(h0[2]), fabsf(h0[3]))), fmaxf(fmaxf(fabsf(h1[0]), fabsf(h1[1])), fmaxf(fabsf(h1[2]), fabsf(h1[3]))));
                    am = xmax_1632(am);
                    const float qs = am > 0.f ? 127.0f * __builtin_amdgcn_rcpf(am) : 0.f;
                    u32x2 qw; qw.x = 0u; qw.y = 0u;
#pragma unroll
                    for (int z = 0; z < 4; ++z) { qw.x = __builtin_amdgcn_cvt_pk_u8_f32(fmaf(h0[z], qs, 128.0f), z, qw.x); qw.y = __builtin_amdgcn_cvt_pk_u8_f32(fmaf(h1[z], qs, 128.0f), z, qw.y); }
                    qw.x ^= 0x80808080u; qw.y ^= 0x80808080u;
                    *(u32x2*)(XQ + o) = qw;
                    if (fq == 0) XS[r * (ldc / 32) + ((col0 + bj * HALF) >> 5)] = am * (1.0f / 127.0f); }
                ssq = xsum_1632(ssq);
                if (fq == 0) SS[r * 16 + u.pn * 4 + wc] = ssq; }
        }
    }
};
struct EpiPleBf16SS {
    static constexpr bool PERM = true, AFTER_DRAIN = false;
    const bf16_t* H; const bf16_t* P; bf16_t* O; PG8_LAS const float* RSL; PG8_LAS const int* RTAG; float* SS; int ldc;
    __device__ __forceinline__ void operator()(const f32x4 (&acc)[2][2][4][2], const Unit& u, int wr, int wc, int fr, int fq) const {
        const int row0 = u.pm * BM + wr * 64 + fr; const int col0 = u.pn * BM + wc * 32 + 8 * fq;
#pragma unroll
        for (int ai = 0; ai < 2; ++ai) {
            float rsv[4];
            const int kslot = (RTAG[0] == u.pm) ? 0 : ((RTAG[1] == u.pm) ? 1 : ((RTAG[2] == u.pm) ? 2 : 3));
#pragma unroll
            for (int m = 0; m < 4; ++m) rsv[m] = RSL[kslot * 256 + ai * HALF + wr * 64 + m * 16 + fr];
            asm volatile("" : "+v"(rsv[0]), "+v"(rsv[1]), "+v"(rsv[2]), "+v"(rsv[3]) :: "memory");
            u32x4 hpre[4][2], ppre[4][2];
#pragma unroll
            for (int m = 0; m < 4; ++m) { const size_t r = (size_t)(row0 + ai * HALF + m * 16);
#pragma unroll
                for (int bj = 0; bj < 2; ++bj) { const size_t o = r * ldc + col0 + bj * HALF; hpre[m][bj] = *(const u32x4*)(H + ((size_t)((col0 + bj * HALF) >> 3) * 32768 + r) * 8); ppre[m][bj] = *(const u32x4*)(P + o); } }
            asm volatile("" ::: "memory");
#pragma unroll
            for (int m = 0; m < 4; ++m) { const size_t r = (size_t)(row0 + ai * HALF + m * 16); float ssq = 0.f; const float rs = rsv[m];
#pragma unroll
                for (int bj = 0; bj < 2; ++bj) { const size_t o = r * ldc + col0 + bj * HALF;
                    const u32x4 hw = hpre[m][bj], pw = ppre[m][bj]; const f32x4 a0 = acc[ai][bj][m][0], a1 = acc[ai][bj][m][1];
                    float h[8];
                    h[0] = bf_lo(hw.x) + sigmoidf_(rs * a0[0]) * bf_lo(pw.x); h[1] = bf_hi(hw.x) + sigmoidf_(rs * a0[1]) * bf_hi(pw.x);
                    h[2] = bf_lo(hw.y) + sigmoidf_(rs * a0[2]) * bf_lo(pw.y); h[3] = bf_hi(hw.y) + sigmoidf_(rs * a0[3]) * bf_hi(pw.y);
                    h[4] = bf_lo(hw.z) + sigmoidf_(rs * a1[0]) * bf_lo(pw.z); h[5] = bf_hi(hw.z) + sigmoidf_(rs * a1[1]) * bf_hi(pw.z);
                    h[6] = bf_lo(hw.w) + sigmoidf_(rs * a1[2]) * bf_lo(pw.w); h[7] = bf_hi(hw.w) + sigmoidf_(rs * a1[3]) * bf_hi(pw.w);
#pragma unroll
                    for (int z = 0; z < 8; ++z) ssq += h[z] * h[z];
                    u32x4 w; w.x = cvt_pk_bf16(h[0], h[1]); w.y = cvt_pk_bf16(h[2], h[3]); w.z = cvt_pk_bf16(h[4], h[5]); w.w = cvt_pk_bf16(h[6], h[7]);
                    *(u32x4*)(O + o) = w; }
                ssq = xsum_1632(ssq);
                if (fq == 0) SS[r * 16 + u.pn * 4 + wc] = ssq; }
        }
    }
};
struct EpiPle {
    static constexpr bool PERM = false, AFTER_DRAIN = false;
    const float* base; float* out; const bf16_t* P; int ldc;
    __device__ __forceinline__ void operator()(const f32x4 (&acc)[2][2][4][2], const Unit& u, int wr, int wc, int fr, int fq) const {
        const int row0 = u.pm * BM + wr * 64 + fr; const int col0 = u.pn * BM + wc * 32 + 4 * fq;
#pragma unroll
        for (int ai = 0; ai < 2; ++ai)
#pragma unroll
            for (int m = 0; m < 4; ++m) { const size_t off = (size_t)(row0 + ai * HALF + m * 16) * ldc + col0;
#pragma unroll
                for (int bj = 0; bj < 2; ++bj)
#pragma unroll
                    for (int n = 0; n < 2; ++n) { const size_t o = off + bj * HALF + n * 16; const f32x4 b = *(const f32x4*)(base + o); const u32x2 p = *(const u32x2*)(P + o); const f32x4 a = acc[ai][bj][m][n];
                        f32x4 r; r[0] = b[0] + sigmoidf_(a[0]) * bf_lo(p.x); r[1] = b[1] + sigmoidf_(a[1]) * bf_hi(p.x); r[2] = b[2] + sigmoidf_(a[2]) * bf_lo(p.y); r[3] = b[3] + sigmoidf_(a[3]) * bf_hi(p.y);
                        *(f32x4*)(out + o) = r; } }
    }
};

template <class Epi, class Sched, bool ALIGN_EPI>
__device__ __forceinline__ void gemm_phase(PG8_LAS unsigned char* lds, const Gemm g, const Sched& S, const Epi& E) {
    const int tid = threadIdx.x, wid = __builtin_amdgcn_readfirstlane(tid >> 6), lane = tid & 63, wr = wid >> 2, wc = wid & 3, fr = lane & 15, fq = lane >> 4;
    const int K = g.K, nt = K / BK, lda = g.lda;
    const size_t a_rs = g.a_slices ? 16 : (size_t)lda * 2, a_cs = g.a_slices ? (size_t)g.M * 16 : 16, kstepA = g.a_slices ? (size_t)g.M * 128 : (size_t)(BK * 2);
    unsigned voffA[2], voffB[2];
#pragma unroll
    for (int i = 0; i < 2; ++i) { int R, C; stage_rc(tid * 16 + i * 8192, R, C); const int Rb = Epi::PERM ? ((R & ~31) + perm32(R & 31)) : R;
        voffA[i] = (unsigned)((size_t)R * a_rs + (size_t)(C >> 3) * a_cs); voffB[i] = (unsigned)(Rb * K + C) * 2u; }
    const size_t kstep = (size_t)(BK * 2);
    const size_t hstepA = (size_t)HALF * a_rs, hstepB = (size_t)HALF * K * 2;
    const size_t tstepA = 2 * hstepA, tstepB = 2 * hstepB;
    const size_t pnstepA = (size_t)g.a_pn_cols * 2;
    const unsigned ldsw = (unsigned)wid * 1024u;
    const int aoff = lds_byte(wr * 64 + fr, fq * 8), boff = lds_byte(wc * 32 + fr, fq * 8);
#define PG8_SA(b, h) (((b) * 2 + (h)) * HTB)
#define PG8_SB(b, h) ((4 + (b) * 2 + (h)) * HTB)
#define PG8_STAGE(bufoff, gbase, voff) do { _Pragma("unroll") for (int _i = 0; _i < 2; ++_i) \
        __builtin_amdgcn_global_load_lds((const unsigned*)((const char*)(gbase) + (voff)[_i]), (PG8_LAS unsigned*)(lds + (bufoff) + ldsw + _i * 8192), 16, 0, 0); } while (0)
#define PG8_LDA(dst, b, h) do { _Pragma("unroll") for (int m = 0; m < 4; ++m) _Pragma("unroll") for (int k = 0; k < 2; ++k) dst[m][k] = *(const PG8_LAS bf16x8*)(lds + PG8_SA(b, h) + aoff + m * 2048 + k * 1024); } while (0)
#define PG8_LDB(dst, b, h) do { _Pragma("unroll") for (int n = 0; n < 2; ++n) _Pragma("unroll") for (int k = 0; k < 2; ++k) dst[n][k] = *(const PG8_LAS bf16x8*)(lds + PG8_SB(b, h) + boff + n * 2048 + k * 1024); } while (0)
#define PG8_MMA(ai, bj, At, Bt) do { __builtin_amdgcn_s_setprio(1); _Pragma("unroll") for (int m = 0; m < 4; ++m) _Pragma("unroll") for (int n = 0; n < 2; ++n) _Pragma("unroll") for (int k = 0; k < 2; ++k) \
        acc[ai][bj][m][n] = __builtin_amdgcn_mfma_f32_16x16x32_bf16(Bt[n][k], At[m][k], acc[ai][bj][m][n], 0, 0, 0); __builtin_amdgcn_s_setprio(0); } while (0)
#define PG8_WAIT_V(n) asm volatile("s_waitcnt vmcnt(" #n ")" ::: "memory")
#define PG8_WAIT_L(n) asm volatile("s_waitcnt lgkmcnt(" #n ")" ::: "memory")
#define PG8_BAR __builtin_amdgcn_s_barrier()
#define PG8_SCHED __builtin_amdgcn_sched_barrier(0)
    Unit cur, nxt; int ui = 0;
    if (!S.next(0, cur)) return;
    f32x4 acc[2][2][4][2];
#pragma unroll
    for (int a = 0; a < 2; ++a)
#pragma unroll
        for (int b = 0; b < 2; ++b)
#pragma unroll
            for (int m = 0; m < 4; ++m)
#pragma unroll
                for (int n = 0; n < 2; ++n) acc[a][b][m][n] = (f32x4){0.f, 0.f, 0.f, 0.f};
    bf16x8 At[4][2], B0[2][2], B1[2][2];
    const char* cA = (const char*)g.A + (size_t)cur.pm * tstepA + (size_t)cur.pn * pnstepA; const char* cB = (const char*)g.Bt + (size_t)cur.pn * tstepB;
    S.a_ready(cur);
    PG8_STAGE(PG8_SB(0, 0), cB, voffB); PG8_STAGE(PG8_SB(0, 1), cB + hstepB, voffB); PG8_STAGE(PG8_SA(0, 0), cA, voffA); PG8_STAGE(PG8_SA(0, 1), cA + hstepA, voffA);
    if (wr == 1) PG8_BAR;
    PG8_WAIT_V(2); PG8_BAR;
    PG8_STAGE(PG8_SB(1, 0), cB + kstep, voffB); PG8_STAGE(PG8_SA(1, 0), cA + kstepA, voffA); PG8_STAGE(PG8_SB(1, 1), cB + hstepB + kstep, voffB);
    PG8_WAIT_V(6); PG8_BAR;
    for (;;) {
        const bool has_next = S.next(ui + 1, nxt);
        const char* nA = has_next ? (const char*)g.A + (size_t)nxt.pm * tstepA + (size_t)nxt.pn * pnstepA : cA; const char* nB = has_next ? (const char*)g.Bt + (size_t)nxt.pn * tstepB : cB;
        for (int t = 0; t < nt; t += 2) {
            const bool last = (t == nt - 2);
            const char* a1 = cA + (size_t)(t + 1) * kstepA;
            const char* a2 = last ? nA : cA + (size_t)(t + 2) * kstepA; const char* b2 = last ? nB : cB + (size_t)(t + 2) * kstep;
            const char* a3 = a2 + kstepA; const char* b3 = b2 + kstep;
            if (last && has_next) S.a_ready(nxt);
            PG8_LDB(B0, 0, 0); PG8_LDB(B1, 0, 1); PG8_SCHED; PG8_LDA(At, 0, 0); PG8_STAGE(PG8_SA(1, 1), a1 + hstepA, voffA);
            PG8_WAIT_V(8); PG8_WAIT_L(0); PG8_BAR; PG8_MMA(0, 0, At, B0); PG8_MMA(0, 1, At, B1); PG8_BAR; PG8_SCHED;
            PG8_LDA(At, 0, 1); PG8_STAGE(PG8_SB(0, 0), b2, voffB); PG8_STAGE(PG8_SB(0, 1), b2 + hstepB, voffB); PG8_STAGE(PG8_SA(0, 0), a2, voffA);
            PG8_WAIT_V(8); PG8_WAIT_L(0); PG8_BAR; PG8_MMA(1, 0, At, B0); PG8_MMA(1, 1, At, B1); PG8_BAR; PG8_SCHED;
            PG8_LDB(B0, 1, 0); PG8_LDB(B1, 1, 1); PG8_SCHED; PG8_LDA(At, 1, 0); PG8_STAGE(PG8_SA(0, 1), a2 + hstepA, voffA);
            PG8_WAIT_V(8); PG8_WAIT_L(0); PG8_BAR; PG8_MMA(0, 0, At, B0); PG8_MMA(0, 1, At, B1); PG8_BAR; PG8_SCHED;
            PG8_LDA(At, 1, 1); PG8_STAGE(PG8_SB(1, 0), b3, voffB); PG8_STAGE(PG8_SB(1, 1), b3 + hstepB, voffB); PG8_STAGE(PG8_SA(1, 0), a3, voffA);
            PG8_WAIT_V(8); PG8_WAIT_L(0); PG8_BAR; PG8_MMA(1, 0, At, B0); PG8_MMA(1, 1, At, B1); PG8_BAR; PG8_SCHED;
        }
        if constexpr (ALIGN_EPI) { if (wr == 0) PG8_BAR; }
        E(acc, cur, wr, wc, fr, fq); S.done(cur);
        if (!has_next) break;
#pragma unroll
        for (int a = 0; a < 2; ++a)
#pragma unroll
            for (int b = 0; b < 2; ++b)
#pragma unroll
                for (int m = 0; m < 4; ++m)
#pragma unroll
                    for (int n = 0; n < 2; ++n) acc[a][b][m][n] = (f32x4){0.f, 0.f, 0.f, 0.f};
        cur = nxt; cA = nA; cB = nB; ++ui;
        if constexpr (ALIGN_EPI) { if (wr == 1) PG8_BAR; }
    }
    PG8_WAIT_V(0);
    if constexpr (!ALIGN_EPI) { if (wr == 0) PG8_BAR; }
    PG8_BAR;
#undef PG8_SA
#undef PG8_SB
#undef PG8_STAGE
#undef PG8_LDA
#undef PG8_LDB
#undef PG8_MMA
#undef PG8_WAIT_V
#undef PG8_WAIT_L
#undef PG8_BAR
#undef PG8_SCHED
}
}

constexpr int NWAVES = 8, NTHREADS = NWAVES * 64;
constexpr int BATCH = 8, SEQ = 4096, D = 1024, T = BATCH * SEQ;
constexpr int RH = 4, RDK = 128, RDV = 256, RC = 128, NCH = SEQ / RC;
constexpr int RQK = RH * RDK, RV = RH * RDV;
constexpr int INW = 8192;
constexpr int PH = 8, PNK = 128, PNE = PNK * PNK, PQD = 256, PHALF = 128, PTOPK = 16, NSEL = PH * PTOPK;
constexpr int PLE = 256;
constexpr float EPS = 1e-6f;
constexpr int NUNITS_R = BATCH * NCH * RH;

constexpr size_t MiB = 1u << 20;
constexpr size_t WS_CTL = 0, CTL_ZERO_BYTES = 64 * 1024;
constexpr size_t WS_COS = 1 * MiB, WS_SIN = 2 * MiB;
constexpr size_t WS_WIN = 3 * MiB;
constexpr size_t WS_WRU = 19 * MiB, WS_WCU = 21 * MiB, WS_WOUT = 23 * MiB;
constexpr size_t WS_WPQ = 25 * MiB;
constexpr size_t WS_WPP = 29 * MiB;
constexpr size_t WS_K1 = 29 * MiB + 512 * 1024, WS_K2 = 29 * MiB + 768 * 1024;
constexpr size_t WS_WPG = 30 * MiB;
constexpr size_t WS_UB = 32 * MiB, WS_VB = 64 * MiB;
constexpr size_t WS_XN = 96 * MiB;
constexpr size_t WS_BIG = 160 * MiB;
constexpr size_t WS_PREV = 352 * MiB;
constexpr size_t WS_ARET = 416 * MiB;
constexpr size_t WS_IDX = 480 * MiB, WS_GATE = 496 * MiB;
constexpr size_t WS_END = 512 * MiB;

constexpr int LDS_BYTES = 160 * 1024;

constexpr int PNE_ROWS = 16384;
typedef unsigned short bf16;
typedef unsigned v4u __attribute__((ext_vector_type(4)));
typedef unsigned v2u __attribute__((ext_vector_type(2)));
typedef float f32x4 __attribute__((ext_vector_type(4)));
#define LAS __attribute__((address_space(3)))

__device__ __forceinline__ unsigned f2bf(float f) { unsigned u = __float_as_uint(f); return (u + 0x7fffu + ((u >> 16) & 1u)) >> 16; }
__device__ __forceinline__ unsigned pk2(float lo, float hi) { unsigned r; asm("v_cvt_pk_bf16_f32 %0, %1, %2" : "=v"(r) : "v"(lo), "v"(hi)); return r; }
__device__ __forceinline__ float bflo(unsigned w) { return __uint_as_float(w << 16); }
__device__ __forceinline__ float bfhi(unsigned w) { return __uint_as_float(w & 0xffff0000u); }
__device__ __forceinline__ float bf2f(bf16 h) { return __uint_as_float(((unsigned)h) << 16); }
#define WR_DPP(x, ctrl) __builtin_bit_cast(float, __builtin_amdgcn_update_dpp(0, __builtin_bit_cast(int, (x)), (ctrl), 0xF, 0xF, true))
__device__ __forceinline__ float wave_sum(float v) {
    v += WR_DPP(v, 0xB1);
    v += WR_DPP(v, 0x4E);
    v += WR_DPP(v, 0x141);
    v += WR_DPP(v, 0x140);
    const float r0 = __builtin_bit_cast(float, __builtin_amdgcn_readlane(__builtin_bit_cast(int, v), 0)), r1 = __builtin_bit_cast(float, __builtin_amdgcn_readlane(__builtin_bit_cast(int, v), 16));
    const float r2 = __builtin_bit_cast(float, __builtin_amdgcn_readlane(__builtin_bit_cast(int, v), 32)), r3 = __builtin_bit_cast(float, __builtin_amdgcn_readlane(__builtin_bit_cast(int, v), 48));
    return (r0 + r1) + (r2 + r3);
}
__device__ __forceinline__ float wave_max(float v) {
    v = fmaxf(v, WR_DPP(v, 0xB1));
    v = fmaxf(v, WR_DPP(v, 0x4E));
    v = fmaxf(v, WR_DPP(v, 0x141));
    v = fmaxf(v, WR_DPP(v, 0x140));
    const float r0 = __builtin_bit_cast(float, __builtin_amdgcn_readlane(__builtin_bit_cast(int, v), 0)), r1 = __builtin_bit_cast(float, __builtin_amdgcn_readlane(__builtin_bit_cast(int, v), 16));
    const float r2 = __builtin_bit_cast(float, __builtin_amdgcn_readlane(__builtin_bit_cast(int, v), 32)), r3 = __builtin_bit_cast(float, __builtin_amdgcn_readlane(__builtin_bit_cast(int, v), 48));
    return fmaxf(fmaxf(r0, r1), fmaxf(r2, r3));
}
__device__ __forceinline__ void unpack8(const v4u w, float* f) { f[0] = bflo(w.x); f[1] = bfhi(w.x); f[2] = bflo(w.y); f[3] = bfhi(w.y); f[4] = bflo(w.z); f[5] = bfhi(w.z); f[6] = bflo(w.w); f[7] = bfhi(w.w); }


typedef float f32x16 __attribute__((ext_vector_type(16)));
typedef short bf16x8v __attribute__((ext_vector_type(8)));
__device__ __forceinline__ unsigned ord_key(float f) { const unsigned u = __float_as_uint(f); return u ^ ((unsigned)((int)u >> 31) | 0x80000000u); }
__device__ __forceinline__ float ord_val(unsigned k) { return __uint_as_float(k ^ (~(unsigned)((int)k >> 31) | 0x80000000u)); }
__device__ __forceinline__ void sort16_desc(unsigned (&x)[16]) {
    constexpr unsigned char CE[60][2] = {
        {0,13},{1,12},{2,15},{3,14},{4,8},{5,6},{7,11},{9,10},
        {0,5},{1,7},{2,9},{3,4},{6,13},{8,14},{10,15},{11,12},
        {0,1},{2,3},{4,5},{6,8},{7,9},{10,11},{12,13},{14,15},
        {0,2},{1,3},{4,10},{5,11},{6,7},{8,9},{12,14},{13,15},
        {1,2},{3,12},{4,6},{5,7},{8,10},{9,11},{13,14},
        {1,4},{2,6},{5,8},{7,10},{9,13},{11,14},
        {2,4},{3,6},{9,12},{11,13},
        {3,5},{6,8},{7,9},{10,12},
        {3,4},{5,6},{7,8},{9,10},{11,12},
        {6,7},{8,9}};
#pragma unroll
    for (int c = 0; c < 60; ++c) { const int a = CE[c][0], b = CE[c][1]; const unsigned hi = max(x[a], x[b]), lo = min(x[a], x[b]); x[a] = hi; x[b] = lo; }
}
__device__ __forceinline__ void merge16_desc(unsigned (&a)[16], const unsigned (&b)[16]) {
#pragma unroll
    for (int i = 0; i < 16; ++i) a[i] = max(a[i], b[15 - i]);
#pragma unroll
    for (int js = 3; js >= 0; --js) {
#pragma unroll
        for (int i = 0; i < 16; ++i) { const int j = 1 << js, l = i ^ j;
            if (l > i) { const unsigned hi = max(a[i], a[l]), lo = min(a[i], a[l]); a[i] = hi; a[l] = lo; } }
    }
}

__device__ __forceinline__ void peer_half_topk(const bf16* qrow, const bf16* kb, int hg, unsigned (&V)[16]) {
    constexpr int LS = 136;
    bf16x8v qf[8];
#pragma unroll
    for (int ks = 0; ks < 8; ++ks) qf[ks] = *(const bf16x8v*)(qrow + 16 * ks);
    f32x16 acc[4];
#pragma unroll
    for (int b = 0; b < 4; ++b)
#pragma unroll
        for (int z = 0; z < 16; ++z) acc[b][z] = 0.f;
#pragma unroll
    for (int ks = 0; ks < 8; ++ks)
#pragma unroll
        for (int b = 0; b < 4; ++b) { const bf16x8v a = *(const bf16x8v*)(kb + b * 32 * LS + 16 * ks); acc[b] = __builtin_amdgcn_mfma_f32_32x32x16_bf16(a, qf[ks], acc[b], 0, 0, 0); }
    unsigned x0[16], x1[16], x2[16], x3[16];
#pragma unroll
    for (int z = 0; z < 16; ++z) { const int nb = (z & 3) + 8 * (z >> 2) + 4 * hg;
        x0[z] = (ord_key(acc[0][z]) & ~0x7Fu) | (unsigned)(127 - nb);
        x1[z] = (ord_key(acc[1][z]) & ~0x7Fu) | (unsigned)(127 - (32 + nb));
        x2[z] = (ord_key(acc[2][z]) & ~0x7Fu) | (unsigned)(127 - (64 + nb));
        x3[z] = (ord_key(acc[3][z]) & ~0x7Fu) | (unsigned)(127 - (96 + nb)); }
    sort16_desc(x0); sort16_desc(x1); merge16_desc(x0, x1);
    sort16_desc(x2); sort16_desc(x3); merge16_desc(x2, x3);
    merge16_desc(x0, x2);
    unsigned pz[16];
#pragma unroll
    for (int z = 0; z < 16; ++z) { auto rr = __builtin_amdgcn_permlane32_swap(x0[z], x0[z], false, false); pz[z] = hg ? rr[0] : rr[1]; }
    merge16_desc(x0, pz);
#pragma unroll
    for (int z = 0; z < 16; ++z) V[z] = x0[z];
}

typedef short v4i16_t __attribute__((ext_vector_type(4)));
__device__ __forceinline__ v4i16_t ds_tr4(LAS const unsigned char* p) { return __builtin_amdgcn_ds_read_tr16_b64_v4i16((LAS v4i16_t*)p); }
__device__ __forceinline__ bf16x8v cat8(v4i16_t a, v4i16_t b) { return __builtin_shufflevector(a, b, 0, 1, 2, 3, 4, 5, 6, 7); }

__device__ __forceinline__ void sort128_asc(unsigned& k0, unsigned& k1, int lane) {
#pragma unroll
    for (int ks = 1; ks <= 7; ++ks) {
#pragma unroll
        for (int js = ks - 1; js >= 0; --js) {
            const int K = 1 << ks, J = 1 << js;
            if (J == 64) { const unsigned lo = min(k0, k1), hi = max(k0, k1); k0 = lo; k1 = hi; }
            else {
                const bool lower = (lane & J) == 0;
                const bool up0 = (K <= 32) ? ((lane & K) == 0) : true;
                const bool up1 = (K <= 32) ? ((lane & K) == 0) : (K == 128);
                const unsigned o0 = __shfl_xor(k0, J), o1 = __shfl_xor(k1, J);
                k0 = (lower == up0) ? min(k0, o0) : max(k0, o0);
                k1 = (lower == up1) ? min(k1, o1) : max(k1, o1);
            }
        }
    }
}

#define XB_TMO      128
#define XB_XCNT(j)  (256  + 64 * (j))
#define XB_XSUB(j)  (1280 + 64 * (j))
#define XB_XGEN(j)  (2304 + 64 * (j))
#define XB_TOP      3328
#define XB_TOPGEN   3392
#define XCD_BAR_WORDS 3456
#define XB_SPIN_CAP (1u << 20)
__device__ __forceinline__ unsigned xb_ld(unsigned* p)              { return __hip_atomic_load(p, __ATOMIC_RELAXED, __HIP_MEMORY_SCOPE_AGENT); }
__device__ __forceinline__ unsigned xb_add(unsigned* p, unsigned v) { return __hip_atomic_fetch_add(p, v, __ATOMIC_RELAXED, __HIP_MEMORY_SCOPE_AGENT); }
__device__ __forceinline__ unsigned xb_xcc_id() { return (unsigned)__builtin_amdgcn_s_getreg((3 << 11) | 20) & 0xFu; }
#define XB_SPIN(cond, bar) do { unsigned _sp = 0; while (cond) { __builtin_amdgcn_s_sleep(1); \
    if ((++_sp & 255u) == 0u) { if (xb_ld(&(bar)[XB_TMO])) break; if (_sp > XB_SPIN_CAP) { atomicAdd(&(bar)[XB_TMO], 1u); break; } } } } while (0)
struct XcdBarrier { unsigned* bar; unsigned x; volatile LAS unsigned* st; };
__device__ __forceinline__ XcdBarrier xcd_barrier_make(unsigned* bar, volatile LAS unsigned* st) {
    XcdBarrier b; b.bar = bar; b.x = xb_xcc_id(); b.st = st;
    return b;
}
__device__ __forceinline__ void xcd_barrier_complete(unsigned* bar, unsigned x, unsigned& nloc, unsigned& nx) {
    const unsigned G = gridDim.x * gridDim.y * gridDim.z;
    unsigned sum, cnt, mine, sp = 0u;
    for (;;) {
        sum = 0u; cnt = 0u; mine = 0u;
#pragma unroll
        for (unsigned j = 0; j < 16; ++j) { const unsigned c = xb_ld(&bar[XB_XCNT(j)]); sum += c; cnt += (c > 0u) ? 1u : 0u; mine = (j == x) ? c : mine; }
        if (sum == G) break;
        __builtin_amdgcn_s_sleep(1);
        if ((++sp & 255u) == 0u) { if (xb_ld(&bar[XB_TMO])) break; if (sp > XB_SPIN_CAP) { atomicAdd(&bar[XB_TMO], 1u); break; } }
    }
    nloc = mine > 0u ? mine : 1u; nx = cnt > 0u ? cnt : 1u;
}
__device__ __forceinline__ void xcd_barrier(const XcdBarrier& b) {
    asm volatile("s_waitcnt vmcnt(0)" ::: "memory");
    __syncthreads();
    if (threadIdx.x == 0) {
        unsigned* bar = b.bar;
        __builtin_amdgcn_s_waitcnt(0);
        unsigned nloc = b.st[0], nx = b.st[1];
        if (nloc == 0u) { xcd_barrier_complete(bar, b.x, nloc, nx); b.st[0] = nloc; b.st[1] = nx; }
        const unsigned old = xb_add(&bar[XB_XSUB(b.x)], 1u);
        const unsigned gen = old / nloc;
        asm volatile("buffer_inv sc1" ::: "memory");
        if (old + 1u == (gen + 1u) * nloc) {
            __builtin_amdgcn_fence(__ATOMIC_RELEASE, "agent");
            asm volatile("s_waitcnt vmcnt(0)" ::: "memory");
            const unsigned og = xb_add(&bar[XB_TOP], 1u);
            const unsigned tg = og / nx;
            if (og + 1u == (tg + 1u) * nx) xb_add(&bar[XB_TOPGEN], 1u);
            else XB_SPIN(xb_ld(&bar[XB_TOPGEN]) == tg, bar);
            xb_add(&bar[XB_XGEN(b.x)], 1u);
            asm volatile("s_waitcnt vmcnt(0)" ::: "memory");
        } else {
            XB_SPIN(xb_ld(&bar[XB_XGEN(b.x)]) == gen, bar);
            asm volatile("s_waitcnt vmcnt(0)" ::: "memory");
        }
    }
    __syncthreads();
}

template <class W> __device__ __forceinline__ void xcd_barrier_with(const XcdBarrier& b, const W& work) {
    asm volatile("s_waitcnt vmcnt(0)" ::: "memory");
    __syncthreads();
    if (threadIdx.x == 0) {
        unsigned* bar = b.bar;
        __builtin_amdgcn_s_waitcnt(0);
        unsigned nloc = b.st[0], nx = b.st[1];
        if (nloc == 0u) { xcd_barrier_complete(bar, b.x, nloc, nx); b.st[0] = nloc; b.st[1] = nx; }
        const unsigned old = xb_add(&bar[XB_XSUB(b.x)], 1u);
        const unsigned gen = old / nloc;
        asm volatile("buffer_inv sc1" ::: "memory");
        if (old + 1u == (gen + 1u) * nloc) {
            __builtin_amdgcn_fence(__ATOMIC_RELEASE, "agent");
            asm volatile("s_waitcnt vmcnt(0)" ::: "memory");
            const unsigned og = xb_add(&bar[XB_TOP], 1u);
            const unsigned tg = og / nx;
            if (og + 1u == (tg + 1u) * nx) xb_add(&bar[XB_TOPGEN], 1u);
            else XB_SPIN(xb_ld(&bar[XB_TOPGEN]) == tg, bar);
            xb_add(&bar[XB_XGEN(b.x)], 1u);
            asm volatile("s_waitcnt vmcnt(0)" ::: "memory");
        } else {
            XB_SPIN(xb_ld(&bar[XB_XGEN(b.x)]) == gen, bar);
            asm volatile("s_waitcnt vmcnt(0)" ::: "memory");
        }
    } else if (threadIdx.x >= 64) work();
    __syncthreads();
}

struct Args {
    const float* in[19]; float* out; unsigned char* ws; int ph_lo, ph_hi;
};

struct Frame {
    unsigned char* lds;
    int tid, lane, wave, G, gw, NGW, gt, NGT;
};

__device__ __forceinline__ void p0_transpose_item(const float* W, int K, int N, bf16* WT, float* scr, int item, int lane, const float* gk = nullptr, bool win_remap = false) {
    const int nblk = N / 32, kb = item / nblk, nb = item % nblk, k0 = 64 * kb, n0 = 32 * nb;

    f32x4 tv[8];
#pragma unroll
    for (int i = 0; i < 8; ++i) { const int kk = 8 * i + (lane >> 3); tv[i] = *(const f32x4*)(W + (size_t)(k0 + kk) * N + n0 + 4 * (lane & 7)); }
    if (gk) {
#pragma unroll
        for (int i = 0; i < 8; ++i) tv[i] = tv[i] * gk[k0 + 8 * i + (lane >> 3)];
    }
#pragma unroll
    for (int i = 0; i < 8; ++i) { const int kk = 8 * i + (lane >> 3); float* sd = scr + kk * 33 + 4 * (lane & 7); sd[0] = tv[i][0]; sd[1] = tv[i][1]; sd[2] = tv[i][2]; sd[3] = tv[i][3]; }
    asm volatile("s_waitcnt lgkmcnt(0)" ::: "memory");
    const int c = lane & 7;
#pragma unroll
    for (int j = 0; j < 4; ++j) { const int n = (lane >> 3) + 8 * j; const float* s = scr + (8 * c) * 33 + n;
        v4u o; o.x = pk2(s[0 * 33], s[1 * 33]); o.y = pk2(s[2 * 33], s[3 * 33]); o.z = pk2(s[4 * 33], s[5 * 33]); o.w = pk2(s[6 * 33], s[7 * 33]);
        int dn = n0 + n;
        if (win_remap) {
            if (dn < 1024) { const int hc = dn & 127, i = hc & 63; dn = (dn & ~127) + 8 * (i >> 2) + ((hc >> 6) << 2) + (i & 3); }
            else if (dn >= 4096 && dn < 6144) { const int cc = dn - 4096; dn = cc < 1024 ? 4096 + (cc >> 7) * 256 + (cc & 127) : 4096 + ((cc - 1024) >> 7) * 256 + 128 + ((cc - 1024) & 127); } }
        *(v4u*)(WT + (size_t)dn * K + k0 + 8 * c) = o; }
    asm volatile("s_waitcnt lgkmcnt(0)" ::: "memory");
}
__device__ __forceinline__ void cvt_f32_bf16(const Frame& F, const float* src, bf16* dst, size_t count) {
    const size_t n4 = count / 4, st = (size_t)F.NGT;
    size_t i = F.gt;
    for (; i + 3 * st < n4; i += 4 * st) { f32x4 v[4];
#pragma unroll
        for (int q = 0; q < 4; ++q) v[q] = ((const f32x4*)src)[i + q * st];
#pragma unroll
        for (int q = 0; q < 4; ++q) { v2u o; o.x = pk2(v[q][0], v[q][1]); o.y = pk2(v[q][2], v[q][3]); ((v2u*)dst)[i + q * st] = o; } }
    for (; i < n4; i += st) { const f32x4 v = ((const f32x4*)src)[i]; v2u o; o.x = pk2(v[0], v[1]); o.y = pk2(v[2], v[3]); ((v2u*)dst)[i] = o; }
}
__device__ __forceinline__ void rms_row_to_bf16(const float* xrow, const float* g, bf16* orow, int lane) {
    const f32x4* xr = (const f32x4*)xrow + lane; const f32x4* gr = (const f32x4*)g + lane;
    f32x4 v[4]; float s = 0.f;
#pragma unroll
    for (int j = 0; j < 4; ++j) { v[j] = xr[64 * j]; s += (v[j][0] * v[j][0] + v[j][1] * v[j][1]) + (v[j][2] * v[j][2] + v[j][3] * v[j][3]); }
    const float rs = 1.0f / sqrtf(wave_sum(s) * (1.f / D) + EPS);
    unsigned long long* o8 = (unsigned long long*)orow + lane;
#pragma unroll
    for (int j = 0; j < 4; ++j) { const f32x4 gg = gr[64 * j]; o8[64 * j] = (unsigned long long)pk2(v[j][0] * rs * gg[0], v[j][1] * rs * gg[1]) | ((unsigned long long)pk2(v[j][2] * rs * gg[2], v[j][3] * rs * gg[3]) << 32); }
}


__device__ __forceinline__ void quant_row_fp8(const float* srow, unsigned char* drow, float* inv_scale, int lane, const float* gcol = nullptr) {
    const f32x4* xr = (const f32x4*)srow + lane;
    f32x4 v[4]; float am = 0.f;
#pragma unroll
    for (int j = 0; j < 4; ++j) { v[j] = xr[64 * j]; if (gcol) v[j] = v[j] * ((const f32x4*)gcol + lane)[64 * j]; am = fmaxf(am, fmaxf(fmaxf(fabsf(v[j][0]), fabsf(v[j][1])), fmaxf(fabsf(v[j][2]), fabsf(v[j][3])))); }
    am = wave_max(am);
    int k = 0;
    if (am > 0.f) { k = (int)floorf(log2f(224.0f / am)); k = k < -100 ? -100 : (k > 100 ? 100 : k); }
    const float sc = ldexpf(1.0f, k), isc = ldexpf(1.0f, -k);
    v4u o;
    { int w = __builtin_amdgcn_cvt_pk_fp8_f32(v[0][0] * sc, v[0][1] * sc, 0, false); w = __builtin_amdgcn_cvt_pk_fp8_f32(v[0][2] * sc, v[0][3] * sc, w, true); o.x = (unsigned)w; }
    { int w = __builtin_amdgcn_cvt_pk_fp8_f32(v[1][0] * sc, v[1][1] * sc, 0, false); w = __builtin_amdgcn_cvt_pk_fp8_f32(v[1][2] * sc, v[1][3] * sc, w, true); o.y = (unsigned)w; }
    { int w = __builtin_amdgcn_cvt_pk_fp8_f32(v[2][0] * sc, v[2][1] * sc, 0, false); w = __builtin_amdgcn_cvt_pk_fp8_f32(v[2][2] * sc, v[2][3] * sc, w, true); o.z = (unsigned)w; }
    { int w = __builtin_amdgcn_cvt_pk_fp8_f32(v[3][0] * sc, v[3][1] * sc, 0, false); w = __builtin_amdgcn_cvt_pk_fp8_f32(v[3][2] * sc, v[3][3] * sc, w, true); o.w = (unsigned)w; }
    *((v4u*)drow + lane) = o;
    if (lane == 0) *inv_scale = isc;
}
__device__ __forceinline__ void quant_row_fp8_cp(const float* srow, unsigned char* tab, int e, float* inv_scale, int lane, const float* gcol = nullptr) {
    const f32x4* xr = (const f32x4*)(srow + 16 * lane);
    f32x4 v[4]; float am = 0.f;
#pragma unroll
    for (int q = 0; q < 4; ++q) { v[q] = xr[q]; if (gcol) v[q] = v[q] * ((const f32x4*)(gcol + 16 * lane))[q]; am = fmaxf(am, fmaxf(fmaxf(fabsf(v[q][0]), fabsf(v[q][1])), fmaxf(fabsf(v[q][2]), fabsf(v[q][3])))); }
    am = wave_max(am);
    int k = 0;
    if (am > 0.f) { k = (int)floorf(log2f(224.0f / am)); k = k < -100 ? -100 : (k > 100 ? 100 : k); }
    const float sc = ldexpf(1.0f, k), isc = ldexpf(1.0f, -k);
    v4u o;
    { int w = __builtin_amdgcn_cvt_pk_fp8_f32(v[0][0] * sc, v[0][1] * sc, 0, false); w = __builtin_amdgcn_cvt_pk_fp8_f32(v[0][2] * sc, v[0][3] * sc, w, true); o.x = (unsigned)w; }
    { int w = __builtin_amdgcn_cvt_pk_fp8_f32(v[1][0] * sc, v[1][1] * sc, 0, false); w = __builtin_amdgcn_cvt_pk_fp8_f32(v[1][2] * sc, v[1][3] * sc, w, true); o.y = (unsigned)w; }
    { int w = __builtin_amdgcn_cvt_pk_fp8_f32(v[2][0] * sc, v[2][1] * sc, 0, false); w = __builtin_amdgcn_cvt_pk_fp8_f32(v[2][2] * sc, v[2][3] * sc, w, true); o.z = (unsigned)w; }
    { int w = __builtin_amdgcn_cvt_pk_fp8_f32(v[3][0] * sc, v[3][1] * sc, 0, false); w = __builtin_amdgcn_cvt_pk_fp8_f32(v[3][2] * sc, v[3][3] * sc, w, true); o.w = (unsigned)w; }
    *(v4u*)(tab + ((size_t)(lane >> 3) * PNE_ROWS + e) * 128 + (lane & 7) * 16) = o;
    if (lane == 0) *inv_scale = isc;
}
__device__ __forceinline__ void quant_row_i8_cp_fin(f32x4 (&v)[4], unsigned char* tab, int e, float* inv_scale, int lane, const float* gcol) {
    float am = 0.f;
#pragma unroll
    for (int q = 0; q < 4; ++q) { if (gcol) v[q] = v[q] * ((const f32x4*)(gcol + 16 * lane))[q]; am = fmaxf(am, fmaxf(fmaxf(fabsf(v[q][0]), fabsf(v[q][1])), fmaxf(fabsf(v[q][2]), fabsf(v[q][3])))); }
    am = wave_max(am);
    const float sc = am > 0.f ? 127.0f * __builtin_amdgcn_rcpf(am) : 0.f;
    unsigned w[4];
#pragma unroll
    for (int q = 0; q < 4; ++q) { const int q0 = (int)rintf(v[q][0] * sc), q1 = (int)rintf(v[q][1] * sc), q2 = (int)rintf(v[q][2] * sc), q3 = (int)rintf(v[q][3] * sc);
        w[q] = (unsigned)(q0 & 0xff) | ((unsigned)(q1 & 0xff) << 8) | ((unsigned)(q2 & 0xff) << 16) | ((unsigned)(q3 & 0xff) << 24); }
    *(v4u*)(tab + ((size_t)(lane >> 3) * PNE_ROWS + e) * 128 + (lane & 7) * 16) = (v4u){w[0], w[1], w[2], w[3]};
    if (lane == 0) *inv_scale = am * (1.0f / 127.0f);
}
__device__ __forceinline__ void quant_row_i8_stage(f32x4 (&v)[4], LAS unsigned char* row, float* inv_scale, int lane) {
    float am = 0.f;
#pragma unroll
    for (int q = 0; q < 4; ++q) am = fmaxf(am, fmaxf(fmaxf(fabsf(v[q][0]), fabsf(v[q][1])), fmaxf(fabsf(v[q][2]), fabsf(v[q][3]))));
    am = wave_max(am);
    const float sc = am > 0.f ? 127.0f * __builtin_amdgcn_rcpf(am) : 0.f;
    unsigned w[4];
#pragma unroll
    for (int q = 0; q < 4; ++q) { const int q0 = (int)rintf(v[q][0] * sc), q1 = (int)rintf(v[q][1] * sc), q2 = (int)rintf(v[q][2] * sc), q3 = (int)rintf(v[q][3] * sc);
        w[q] = (unsigned)(q0 & 0xff) | ((unsigned)(q1 & 0xff) << 8) | ((unsigned)(q2 & 0xff) << 16) | ((unsigned)(q3 & 0xff) << 24); }
    *(LAS v4u*)(row + 16 * lane) = (v4u){w[0], w[1], w[2], w[3]};
    if (lane == 0) *inv_scale = am * (1.0f / 127.0f);
}
__device__ __forceinline__ void quant_row_i8_slices(f32x4 (&v)[4], unsigned char* tab, int e, float* inv_scale, int lane) {
    float am = 0.f;
#pragma unroll
    for (int q = 0; q < 4; ++q) am = fmaxf(am, fmaxf(fmaxf(fabsf(v[q][0]), fabsf(v[q][1])), fmaxf(fabsf(v[q][2]), fabsf(v[q][3]))));
    am = wave_max(am);
    const float sc = am > 0.f ? 127.0f * __builtin_amdgcn_rcpf(am) : 0.f;
    unsigned w[4];
#pragma unroll
    for (int q = 0; q < 4; ++q) { const int q0 = (int)rintf(v[q][0] * sc), q1 = (int)rintf(v[q][1] * sc), q2 = (int)rintf(v[q][2] * sc), q3 = (int)rintf(v[q][3] * sc);
        w[q] = (unsigned)(q0 & 0xff) | ((unsigned)(q1 & 0xff) << 8) | ((unsigned)(q2 & 0xff) << 16) | ((unsigned)(q3 & 0xff) << 24); }
    *(v2u*)(tab + ((size_t)(2 * lane) * PNE_ROWS + e) * 8) = (v2u){w[0], w[1]};
    *(v2u*)(tab + ((size_t)(2 * lane + 1) * PNE_ROWS + e) * 8) = (v2u){w[2], w[3]};
    if (lane == 0) *inv_scale = am * (1.0f / 127.0f);
}
typedef float f32x2 __attribute__((ext_vector_type(2)));
typedef unsigned v4u_raw __attribute__((__vector_size__(16)));
typedef unsigned v2u_raw __attribute__((__vector_size__(8)));
__device__ __forceinline__ void fp8x16_to_f32(const v4u w, float* f) {
    f32x2 t;
    t = __builtin_amdgcn_cvt_pk_f32_fp8((int)w.x, false); f[0] = t.x; f[1] = t.y; t = __builtin_amdgcn_cvt_pk_f32_fp8((int)w.x, true); f[2] = t.x; f[3] = t.y;
    t = __builtin_amdgcn_cvt_pk_f32_fp8((int)w.y, false); f[4] = t.x; f[5] = t.y; t = __builtin_amdgcn_cvt_pk_f32_fp8((int)w.y, true); f[6] = t.x; f[7] = t.y;
    t = __builtin_amdgcn_cvt_pk_f32_fp8((int)w.z, false); f[8] = t.x; f[9] = t.y; t = __builtin_amdgcn_cvt_pk_f32_fp8((int)w.z, true); f[10] = t.x; f[11] = t.y;
    t = __builtin_amdgcn_cvt_pk_f32_fp8((int)w.w, false); f[12] = t.x; f[13] = t.y; t = __builtin_amdgcn_cvt_pk_f32_fp8((int)w.w, true); f[14] = t.x; f[15] = t.y;
}

__device__ __forceinline__ float gelu_f(float v) {
    const float av = fabsf(v), t = __builtin_amdgcn_rcpf(av * 0.2316418882f + 1.0f);
    float q = t * 0.5307027145f + (-0.7265760135f); q = q * t + 0.7107068705f; q = q * t + (-0.142248368f); q = q * t + 0.127414796f; q = q * t;
    const float e = __builtin_amdgcn_exp2f((v * v) * (-0.72134752044f));
    const float m = v * (q * e);
    return v < 0.f ? m : v - m;
}
__device__ __forceinline__ float gamma_of(int h) { return 1.0f - exp2f(-5.0f - (float)h); }

__global__ void __launch_bounds__(NTHREADS, 2) mega(Args args) {
    extern __shared__ __attribute__((aligned(16))) unsigned char lds[];
    Frame F;
    F.lds = lds; F.tid = threadIdx.x; F.lane = F.tid & 63; F.wave = __builtin_amdgcn_readfirstlane(F.tid >> 6);
    F.G = gridDim.x; F.gw = blockIdx.x * NWAVES + F.wave; F.NGW = F.G * NWAVES; F.gt = blockIdx.x * NTHREADS + F.tid; F.NGT = F.G * NTHREADS;
    unsigned char* ws = args.ws;
    const float* x = args.in[0]; const float* p = args.in[1]; const float* g_mix = args.in[2]; const float* w_in = args.in[3];
    const float* conv_w = args.in[4]; const float* conv_b = args.in[5]; const float* w_ret_up = args.in[6]; const float* w_conv_up = args.in[7];
    const float* w_out = args.in[8]; const float* g_ffn = args.in[9]; const float* w_peer_q = args.in[10]; const float* peer_k1 = args.in[11];
    const float* peer_k2 = args.in[12]; const float* peer_u = args.in[13]; const float* peer_v = args.in[14]; const float* g_ple = args.in[15];
    const float* w_ple_proj = args.in[16]; const float* w_ple_gate = args.in[17]; const float* g_final = args.in[18];
    float* out = args.out;
    float* COS = (float*)(ws + WS_COS); float* SIN = (float*)(ws + WS_SIN);
    bf16* WIN = (bf16*)(ws + WS_WIN); bf16* WRU = (bf16*)(ws + WS_WRU); bf16* WCU = (bf16*)(ws + WS_WCU); bf16* WOUT = (bf16*)(ws + WS_WOUT);
    bf16* WPQ = (bf16*)(ws + WS_WPQ); bf16* WPP = (bf16*)(ws + WS_WPP); bf16* K1 = (bf16*)(ws + WS_K1); bf16* K2 = (bf16*)(ws + WS_K2); bf16* WPG = (bf16*)(ws + WS_WPG);
    unsigned char* U8 = ws + WS_UB; unsigned char* V8 = ws + WS_VB;
    float* SU = (float*)(ws + 128 * 1024); float* SV = (float*)(ws + 256 * 1024);
    float* SS2 = (float*)(ws + 80 * MiB);
    unsigned char* XQ = ws + WS_BIG + 128 * MiB; float* XS = (float*)(ws + WS_BIG + 160 * MiB);
    float* RS2 = (float*)(ws + 512 * 1024);
    unsigned* KK = (unsigned*)(ws + WS_BIG + 64 * MiB);
    float* SSP = (float*)(ws + WS_ARET);
    unsigned* W4 = (unsigned*)(ws + WS_ARET + 16 * MiB);
    float* WSC = (float*)(ws + 82 * MiB);
    unsigned* WCNT = (unsigned*)(ws + 32 * 1024);
    float* PACT = (float*)(ws + WS_PREV);
    float* SS1 = (float*)(ws + WS_COS);
    float* SS3 = (float*)(ws + WS_IDX);
    bf16* XN = (bf16*)(ws + WS_XN); bf16* BIG = (bf16*)(ws + WS_BIG); bf16* PREV = (bf16*)(ws + WS_PREV); bf16* ARET = (bf16*)(ws + WS_ARET);
    int* IDX = (int*)(ws + WS_IDX); float* GATE = (float*)(ws + WS_GATE);
    bf16* CB = BIG;
    bf16* UU = BIG + (size_t)T * 1024;
    bf16* ACONV = CB;
    bf16* GATES = BIG + (size_t)T * 2048;
    bf16* M1 = UU;
    bf16* HB = XN;
    bf16* PB = (bf16*)(ws + 48 * MiB);
    bf16* QP = PREV;
    bf16* PLEB = BIG;
    bf16* H3B = BIG + (size_t)T * 1024;
    PG8_LAS unsigned char* ldsl = (PG8_LAS unsigned char*)lds;

    const int lo = args.ph_lo, hi = args.ph_hi;
#if MK_ONE_LAUNCH
    cg::grid_group grid = cg::this_grid();
    volatile LAS unsigned* lctl = (volatile LAS unsigned*)((LAS unsigned char*)lds + LDS_BYTES - 64);
    if (F.tid < 16) lctl[F.tid] = 0u;
    __syncthreads();
    const XcdBarrier xbar = xcd_barrier_make((unsigned*)(ws + WS_CTL), lctl);
    if (blockIdx.x == 0) {
        unsigned* bar0 = (unsigned*)(ws + WS_CTL);
        if (F.tid < 16) { bar0[XB_XCNT(F.tid)] = 0u; bar0[XB_XSUB(F.tid)] = 0u; bar0[XB_XGEN(F.tid)] = 0u; ((unsigned*)(ws + 32 * 1024))[F.tid] = 0u; }
        if (F.tid == 16) { bar0[XB_TOP] = 0u; bar0[XB_TOPGEN] = 0u; bar0[XB_TMO] = 0u; }
    }
#define SEAM(k) do { if ((k) + 1 < hi) { if ((k) == 0) grid.sync(); else xcd_barrier(xbar); } } while (0)
#define SEAM_WITH(k, wk) do { if ((k) + 1 < hi) xcd_barrier_with(xbar, wk); else if (F.tid >= 64) wk(); } while (0)
#else
#define SEAM(k) do { } while (0)
#define SEAM_WITH(k, wk) do { if (F.tid >= 64) wk(); __syncthreads(); } while (0)
#endif
#define IN(k) (lo <= (k) && (k) < hi)

    auto defer_weights = [&](int jlo, int jhi) __attribute__((always_inline)) {
        float* scr = (float*)(lds + F.wave * 16384);
        for (int j = jlo + (int)blockIdx.x * 7 + (F.wave - 1); j < jhi; j += 7 * F.G) {
            int r = j, item; const float* W; bf16* WT; const float* gk = nullptr; int K = D, N = D; bool rm = false;
            if (r < 2560) { W = w_in; WT = WIN; N = INW; rm = true; item = (r / 160) * (INW / 32) + 96 + r % 160; }
            else if ((r -= 2560) < 512) { W = w_ret_up; WT = WRU; item = r; }
            else if ((r -= 512) < 512) { W = w_conv_up; WT = WCU; item = r; }
            else if ((r -= 512) < 512) { W = w_out; WT = WOUT; item = r; }
            else if ((r -= 512) < 1024) { W = w_peer_q; WT = WPQ; N = 2048; gk = g_ffn; item = r; }
            else if ((r -= 1024) < 512) { W = w_ple_gate; WT = WPG; gk = g_ple; item = r; }
            else { r -= 512; W = w_ple_proj; WT = WPP; K = PLE; item = r; }
            p0_transpose_item(W, K, N, WT, scr, item, F.lane, gk, rm);
        } };
    if (IN(0)) {
        float* scr = (float*)(lds + F.wave * 16384);
        constexpr int I_IN = (D / 64) * (INW / 32), I_SQ = (D / 64) * (D / 32), I_PQ = (D / 64) * (2048 / 32), I_PP = (PLE / 64) * (D / 32);
        (void)I_IN; (void)I_SQ; (void)I_PQ; (void)I_PP;
        for (int it = F.gw; it < (D / 64) * 96; it += F.NGW) p0_transpose_item(w_in, D, INW, WIN, scr, (it / 96) * (INW / 32) + it % 96, F.lane, nullptr, true);
        cvt_f32_bf16(F, p, PB, (size_t)T * PLE);
        cvt_f32_bf16(F, peer_k1, K1, (size_t)PH * PNK * PHALF);
        cvt_f32_bf16(F, peer_k2, K2, (size_t)PH * PNK * PHALF);
        {
            constexpr int VROW = 1040;
            LAS unsigned char* vst = (LAS unsigned char*)lds;
            __syncthreads();
            constexpr int NGRP = PNE / 16;
#define P0_TAB_LOAD(U0, U1, V0, V1, GRP) do { const int g_ = (GRP) < NGRP ? (GRP) : NGRP - 1; const size_t ro_ = (size_t)(16 * g_ + 2 * F.wave) * D + 16 * F.lane; \
                _Pragma("unroll") for (int q = 0; q < 4; ++q) { U0[q] = ((const f32x4*)(peer_u + ro_))[q]; U1[q] = ((const f32x4*)(peer_u + ro_ + D))[q]; \
                                                                V0[q] = ((const f32x4*)(peer_v + ro_))[q]; V1[q] = ((const f32x4*)(peer_v + ro_ + D))[q]; } } while (0)
#define P0_TAB_PROC(U0, U1, V0, V1, GRP) do { const int r0 = 16 * (GRP) + 2 * F.wave; \
                quant_row_i8_cp_fin(U0, U8, r0, SU + r0, F.lane, g_ffn); quant_row_i8_cp_fin(U1, U8, r0 + 1, SU + r0 + 1, F.lane, g_ffn); \
                quant_row_i8_stage(V0, vst + (2 * F.wave) * VROW, SV + r0, F.lane); quant_row_i8_stage(V1, vst + (2 * F.wave + 1) * VROW, SV + r0 + 1, F.lane); \
                __syncthreads(); \
                {   const int s = F.tid >> 2, q4 = F.tid & 3; \
                    const v2u a0 = *(LAS v2u*)(vst + (4 * q4 + 0) * VROW + 8 * s), a1 = *(LAS v2u*)(vst + (4 * q4 + 1) * VROW + 8 * s); \
                    const v2u a2 = *(LAS v2u*)(vst + (4 * q4 + 2) * VROW + 8 * s), a3 = *(LAS v2u*)(vst + (4 * q4 + 3) * VROW + 8 * s); \
                    v4u* dst = (v4u*)(V8 + ((size_t)s * PNE_ROWS + 16 * (GRP) + 4 * q4) * 8); \
                    dst[0] = (v4u){a0.x, a0.y, a1.x, a1.y}; dst[1] = (v4u){a2.x, a2.y, a3.x, a3.y}; } \
                __syncthreads(); } while (0)
            f32x4 au0[4], au1[4], av0[4], av1[4], bu0[4], bu1[4], bv0[4], bv1[4];
            int grp = blockIdx.x;
            P0_TAB_LOAD(au0, au1, av0, av1, grp);
            for (; grp < NGRP; grp += 2 * F.G) {
                P0_TAB_LOAD(bu0, bu1, bv0, bv1, grp + F.G);
                P0_TAB_PROC(au0, au1, av0, av1, grp);
                P0_TAB_LOAD(au0, au1, av0, av1, grp + 2 * F.G);
                if (grp + F.G < NGRP) P0_TAB_PROC(bu0, bu1, bv0, bv1, grp + F.G);
            }
#undef P0_TAB_LOAD
#undef P0_TAB_PROC
        }
        for (int e = F.gt; e < SEQ * 64; e += F.NGT) { const int s = e >> 6, i = e & 63; const double inv = (double)exp2f(-(float)i * (13.287712379549449f / 64.0f));
            const double ang = (double)s * inv; const double kk_ = rint(ang * 0.15915494309189535); const float r_ = (float)fma(kk_, -6.283185307179586, ang);
            COS[e] = cosf(r_); SIN[e] = sinf(r_); }
        {
            const f32x4* gr = (const f32x4*)g_mix + F.lane; f32x4 gg[4];
#pragma unroll
            for (int j = 0; j < 4; ++j) gg[j] = gr[64 * j];
            for (int m = F.gw; m < T / 2; m += F.NGW) {
                const int ma = m, mb = m + T / 2;
                const f32x4* xa_ = (const f32x4*)(x + (size_t)ma * D) + F.lane; const f32x4* xb_ = (const f32x4*)(x + (size_t)mb * D) + F.lane;
                f32x4 va[4], vb[4]; float sa = 0.f, sb = 0.f;
#pragma unroll
                for (int j = 0; j < 4; ++j) { va[j] = xa_[64 * j]; vb[j] = xb_[64 * j]; }
#pragma unroll
                for (int j = 0; j < 4; ++j) { sa += (va[j][0] * va[j][0] + va[j][1] * va[j][1]) + (va[j][2] * va[j][2] + va[j][3] * va[j][3]); sb += (vb[j][0] * vb[j][0] + vb[j][1] * vb[j][1]) + (vb[j][2] * vb[j][2] + vb[j][3] * vb[j][3]); }
                const float ra = 1.0f / sqrtf(wave_sum(sa) * (1.f / D) + EPS), rb = 1.0f / sqrtf(wave_sum(sb) * (1.f / D) + EPS);
                unsigned long long* oa = (unsigned long long*)(XN + (size_t)ma * D) + F.lane; unsigned long long* ob = (unsigned long long*)(XN + (size_t)mb * D) + F.lane;
#pragma unroll
                for (int j = 0; j < 4; ++j) {
                    oa[64 * j] = (unsigned long long)pk2(va[j][0] * ra * gg[j][0], va[j][1] * ra * gg[j][1]) | ((unsigned long long)pk2(va[j][2] * ra * gg[j][2], va[j][3] * ra * gg[j][3]) << 32);
                    ob[64 * j] = (unsigned long long)pk2(vb[j][0] * rb * gg[j][0], vb[j][1] * rb * gg[j][1]) | ((unsigned long long)pk2(vb[j][2] * rb * gg[j][2], vb[j][3] * rb * gg[j][3]) << 32); }
            }
        }
        SEAM(0);
#if MK_ONE_LAUNCH
        if (F.tid == 0) (void)xb_add(&xbar.bar[XB_XCNT(xbar.x)], 1u);
#endif
    }

    if (IN(1)) {
        pg8::Gemm g{XN, WIN, T, 3072, D, D, 0}; pg8::StaticOrder S; S.init(T, 3072, F.G, (int)blockIdx.x);
        pg8::EpiQKVG E{BIG, COS, SIN};
        pg8::gemm_phase<pg8::EpiQKVG, pg8::StaticOrder, true>(ldsl, g, S, E);
        { auto dw_ = [&]() { defer_weights(0, 1792); }; SEAM_WITH(1, dw_); }
    }

    if (IN(2)) {
        constexpr int KS = 160;
        bf16* kt = (bf16*)lds;
        bf16* vt = kt + 128 * KS;
        LAS const unsigned char* kt3 = (LAS const unsigned char*)lds; LAS const unsigned char* vt3 = kt3 + 128 * KS * 2;
        constexpr int PS = 136;
        bf16* pt = vt + 128 * KS;
        const int r32 = F.lane & 31, hg = F.lane >> 5;
        const int tq = (F.lane & 15) >> 2, tp = F.lane & 3, tcs = (F.lane >> 4) & 1;
        for (int cid = blockIdx.x; cid < BATCH * RH * 8; cid += F.G) {
            const int xg = cid & 7, yg = cid >> 3; const int chn = ((xg * 4 + (yg >> 3)) << 3) | (yg & 7);
            const int es = chn & 7, h = (chn >> 3) & 3, b = chn >> 5;
            const float gam = gamma_of(h), lg = logf(gam), cd = powf(gam, (float)RC);
            v4u kb0[4], kb1[4], kb2[4], kb3[4], vb0, vb1, vb2, vb3;
#define R1_LOAD(kreg, vreg, nn) do { const size_t t0_ = (size_t)b * SEQ + (size_t)(nn) * RC; \
            _Pragma("unroll") for (int q = 0; q < 4; ++q) { const int c = F.tid + q * NTHREADS, j = c >> 4, c8 = c & 15; kreg[q] = *(const v4u*)(BIG + (t0_ + j) * 3072 + RQK + h * RDK + c8 * 8); } \
            { const int j = F.tid >> 2, c8 = F.tid & 3; vreg = *(const v4u*)(BIG + (t0_ + j) * 3072 + 2 * RQK + h * RDV + es * 32 + c8 * 8); } } while (0)
#define R1_STEP(kreg, vreg, knext, vnext, n) do { \
                __syncthreads(); \
                _Pragma("unroll") for (int q = 0; q < 4; ++q) { const int c = F.tid + q * NTHREADS, j = c >> 4, c8 = c & 15; *(v4u*)(kt + j * KS + c8 * 8) = kreg[q]; } \
                { const int j = F.tid >> 2, c8 = F.tid & 3; float f[8]; unpack8(vreg, f);        \
                    v4u z1; z1.x = pk2(f[0] * zv, f[1] * zv); z1.y = pk2(f[2] * zv, f[3] * zv); z1.z = pk2(f[4] * zv, f[5] * zv); z1.w = pk2(f[6] * zv, f[7] * zv); \
                    *(v4u*)(vt + j * KS + c8 * 8) = z1; } \
                if ((n) > 0) { const int up = b * 128 + ((n) - 1) * 4 + h; const int e_ = F.tid >> 4, c8 = F.tid & 15;        \
                    *(v4u*)(PREV + ((size_t)up * 256 + es * 32 + e_) * 128 + c8 * 8) = *(const v4u*)(pt + e_ * PS + c8 * 8); } \
                __syncthreads(); \
                R1_LOAD(knext, vnext, ((n) + 3 < NCH ? (n) + 3 : NCH - 1));        \
                if (F.wave < 4) { \
                    _Pragma("unroll") for (int g = 0; g < 4; ++g) { const int d0 = 32 * F.wave + 8 * g + 4 * hg; v2u o; o.x = pk2(st[4 * g], st[4 * g + 1]); o.y = pk2(st[4 * g + 2], st[4 * g + 3]); \
                        *(v2u*)(pt + r32 * PS + d0) = o; } \
                    f32x16 acc; \
                    _Pragma("unroll") for (int z = 0; z < 16; ++z) acc[z] = 0.f; \
                    _Pragma("unroll") for (int ks = 0; ks < 8; ++ks) { \
                        LAS const unsigned char* ka = kt3 + ((16 * ks + 8 * hg + tq) * KS + 32 * F.wave + 16 * tcs + 4 * tp) * 2; \
                        LAS const unsigned char* va = vt3 + ((16 * ks + 8 * hg + tq) * KS + 16 * tcs + 4 * tp) * 2; \
                        const bf16x8v af = cat8(ds_tr4(ka), ds_tr4(ka + 4 * KS * 2)), bfr = cat8(ds_tr4(va), ds_tr4(va + 4 * KS * 2)); \
                        acc = __builtin_amdgcn_mfma_f32_32x32x16_bf16(af, bfr, acc, 0, 0, 0); } \
                    _Pragma("unroll") for (int z = 0; z < 16; ++z) st[z] = st[z] * cd + acc[z]; \
                } } while (0)
            const float zv = __expf(lg * (float)(RC - 1 - (F.tid >> 2)));
            R1_LOAD(kb0, vb0, 0); R1_LOAD(kb1, vb1, 1); R1_LOAD(kb2, vb2, 2);
            f32x16 st;
#pragma unroll
            for (int z = 0; z < 16; ++z) st[z] = 0.f;
#pragma unroll 1
            for (int n4 = 0; n4 < NCH; n4 += 4) {
                R1_STEP(kb0, vb0, kb3, vb3, n4);
                R1_STEP(kb1, vb1, kb0, vb0, n4 + 1);
                R1_STEP(kb2, vb2, kb1, vb1, n4 + 2);
                R1_STEP(kb3, vb3, kb2, vb2, n4 + 3);
            }
            __syncthreads();
            { const int up = b * 128 + (NCH - 1) * 4 + h; const int e_ = F.tid >> 4, c8 = F.tid & 15;
              *(v4u*)(PREV + ((size_t)up * 256 + es * 32 + e_) * 128 + c8 * 8) = *(const v4u*)(pt + e_ * PS + c8 * 8); }
#undef R1_STEP
#undef R1_LOAD
        }
        { auto dw_ = [&]() { defer_weights(1792, 2560); }; SEAM_WITH(2, dw_); }
    }


    if (IN(4)) {
        constexpr int LS = 136;
        bf16* ksN = (bf16*)lds;
        constexpr int VS = 288;
        bf16* vt = ksN + 128 * LS;
        LAS const unsigned char* vt3 = (LAS const unsigned char*)lds + 128 * LS * 2;
        float* stx = (float*)(vt + 128 * VS);
        const int tq = (F.lane & 15) >> 2, tp = F.lane & 3, tcs = (F.lane >> 4) & 1;
        const int r32 = F.lane & 31, hg = F.lane >> 5, iw = F.wave & 3, eh = F.wave >> 2;
        const int i = 32 * iw + r32;
        v4u kstN[4], pstN[8]; bf16x8v qfN[8];
#define R3_PREFETCH(uu) do { const int h_ = (uu) & 3, n_ = ((uu) >> 2) & 31, b_ = (uu) >> 7; const size_t t0_ = (size_t)b_ * SEQ + (size_t)n_ * RC; \
            _Pragma("unroll") for (int q = 0; q < 4; ++q) { const int c = F.tid + q * NTHREADS, j = c >> 4, c8 = c & 15; kstN[q] = *(const v4u*)(BIG + (t0_ + j) * 3072 + RQK + h_ * RDK + c8 * 8); } \
            _Pragma("unroll") for (int q = 0; q < 8; ++q) { const int c = F.tid + q * NTHREADS, e_ = c >> 4, c8 = c & 15; pstN[q] = *(const v4u*)(PREV + ((size_t)(uu) * 256 + e_) * 128 + c8 * 8); } \
            { const bf16* qrow = BIG + (t0_ + i) * 3072 + h_ * RDK + 8 * hg; _Pragma("unroll") for (int ks = 0; ks < 8; ++ks) qfN[ks] = *(const bf16x8v*)(qrow + 16 * ks); } } while (0)
        R3_PREFETCH((int)blockIdx.x < NUNITS_R ? (int)blockIdx.x : 0);
#pragma unroll 1
        for (int u = blockIdx.x; u < NUNITS_R; u += F.G) {
            const int h = u & 3, n = (u >> 2) & 31, b = u >> 7; const size_t t0 = (size_t)b * SEQ + (size_t)n * RC;
            const float lg = logf(gamma_of(h));
            __syncthreads();
            bf16* pt = vt;
#pragma unroll
            for (int q = 0; q < 4; ++q) { const int c = F.tid + q * NTHREADS, j = c >> 4, c8 = c & 15; *(v4u*)(ksN + j * LS + c8 * 8) = kstN[q]; }
#pragma unroll
            for (int q = 0; q < 8; ++q) { const int c = F.tid + q * NTHREADS, e_ = c >> 4, c8 = c & 15; *(v4u*)(pt + e_ * LS + c8 * 8) = pstN[q]; }
            bf16x8v qf[8];
#pragma unroll
            for (int ks = 0; ks < 8; ++ks) qf[ks] = qfN[ks];
            v4u vst[8];
#pragma unroll
            for (int q = 0; q < 8; ++q) { const int c = F.tid + q * NTHREADS, j = c >> 5, c8 = c & 31; vst[q] = *(const v4u*)(BIG + (t0 + j) * 3072 + 2 * RQK + h * RDV + c8 * 8); }
            f32x16 acc[4];
#pragma unroll
            for (int eb = 0; eb < 4; ++eb)
#pragma unroll
                for (int z = 0; z < 16; ++z) acc[eb][z] = 0.f;
            __syncthreads();
            {
                const bf16* pp = pt + (128 * eh + r32) * LS + 8 * hg;
#pragma unroll
                for (int ks = 0; ks < 8; ++ks)
#pragma unroll
                    for (int eb = 0; eb < 4; ++eb) { const bf16x8v a = *(const bf16x8v*)(pp + (32 * eb) * LS + 16 * ks); acc[eb] = __builtin_amdgcn_mfma_f32_32x32x16_bf16(a, qf[ks], acc[eb], 0, 0, 0); }
                const float xi = __expf(lg * (float)(i + 1));
#pragma unroll
                for (int eb = 0; eb < 4; ++eb)
#pragma unroll
                    for (int z = 0; z < 16; ++z) acc[eb][z] *= xi;
            }
            __syncthreads();
#pragma unroll
            for (int q = 0; q < 8; ++q) { const int c = F.tid + q * NTHREADS, j = c >> 5, c8 = c & 31; *(v4u*)(vt + j * VS + c8 * 8) = vst[q]; }
            __syncthreads();
            float dcol[16];
#pragma unroll
            for (int z = 0; z < 16; ++z) dcol[z] = __expf(-lg * (float)((z & 3) + 8 * (z >> 2) + 4 * hg));
#pragma unroll 1
            for (int jb = 0; jb <= iw; ++jb) {
                const float drow = __expf(lg * (float)(i - 32 * jb));
                f32x16 X;
#pragma unroll
                for (int z = 0; z < 16; ++z) X[z] = 0.f;
#pragma unroll
                for (int ks = 0; ks < 8; ++ks) { const bf16x8v a = *(const bf16x8v*)(ksN + (32 * jb + r32) * LS + 16 * ks + 8 * hg); X = __builtin_amdgcn_mfma_f32_32x32x16_bf16(a, qf[ks], X, 0, 0, 0); }
#pragma unroll
                for (int z = 0; z < 16; ++z) { const int jo = (z & 3) + 8 * (z >> 2) + 4 * hg;
                    const float v = X[z] * dcol[z] * drow; X[z] = (jb < iw || r32 >= jo) ? v : 0.f; }
#pragma unroll
                for (int s2 = 0; s2 < 2; ++s2) {
                    v4u pw; pw.x = pk2(X[8 * s2 + 0], X[8 * s2 + 1]); pw.y = pk2(X[8 * s2 + 2], X[8 * s2 + 3]); pw.z = pk2(X[8 * s2 + 4], X[8 * s2 + 5]); pw.w = pk2(X[8 * s2 + 6], X[8 * s2 + 7]);
                    const bf16x8v pf = __builtin_bit_cast(bf16x8v, pw);
#pragma unroll
                    for (int eb = 0; eb < 4; ++eb) {
                        LAS const unsigned char* va = vt3 + ((32 * jb + 16 * s2 + 4 * hg + tq) * VS + 128 * eh + 32 * eb + 16 * tcs + 4 * tp) * 2;
                        acc[eb] = __builtin_amdgcn_mfma_f32_32x32x16_bf16(cat8(ds_tr4(va), ds_tr4(va + 8 * VS * 2)), pf, acc[eb], 0, 0, 0); }
                }
            }
            float s1 = 0.f, s2 = 0.f;
#pragma unroll
            for (int eb = 0; eb < 4; ++eb)
#pragma unroll
                for (int z = 0; z < 16; ++z) { const float v = acc[eb][z]; s1 += v; s2 += v * v; }
            { auto r1 = __builtin_amdgcn_permlane32_swap(__float_as_uint(s1), __float_as_uint(s1), false, false); s1 = __uint_as_float(r1[0]) + __uint_as_float(r1[1]);
              auto r2 = __builtin_amdgcn_permlane32_swap(__float_as_uint(s2), __float_as_uint(s2), false, false); s2 = __uint_as_float(r2[0]) + __uint_as_float(r2[1]); }
            if (hg == 0) { stx[(eh * 128 + i) * 2] = s1; stx[(eh * 128 + i) * 2 + 1] = s2; }
            __syncthreads();
            { const float o1 = stx[((eh ^ 1) * 128 + i) * 2], o2 = stx[((eh ^ 1) * 128 + i) * 2 + 1]; s1 += o1; s2 += o2; }
            const float mu = s1 * (1.f / 256.f); const float var = fmaxf(s2 * (1.f / 256.f) - mu * mu, 0.f); const float rstd = 1.0f / sqrtf(var + EPS);
            {
                constexpr int YS = 264;
                bf16* ys = vt;
#pragma unroll
                for (int eb = 0; eb < 4; ++eb)
#pragma unroll
                    for (int g = 0; g < 4; ++g) { const int ec = 128 * eh + 32 * eb + 8 * g + 4 * hg;
                        v2u o; o.x = pk2((acc[eb][4 * g] - mu) * rstd, (acc[eb][4 * g + 1] - mu) * rstd); o.y = pk2((acc[eb][4 * g + 2] - mu) * rstd, (acc[eb][4 * g + 3] - mu) * rstd);
                        *(v2u*)(ys + i * YS + ec) = o; }
                __syncthreads();
                v4u gpre[8];
#pragma unroll
                for (int q = 0; q < 8; ++q) { const int c = F.tid + q * NTHREADS, tkn = c >> 5, c8 = c & 31; gpre[q] = *(const v4u*)(BIG + (t0 + tkn) * 3072 + 2 * RQK + RV + h * RDV + c8 * 8); }
                { const int un_ = u + F.G < NUNITS_R ? u + F.G : u; R3_PREFETCH(un_); }
#pragma unroll
                for (int q = 0; q < 8; ++q) { const int c = F.tid + q * NTHREADS, tkn = c >> 5, c8 = c & 31;
                    float yf[8], gf[8]; unpack8(*(const v4u*)(ys + tkn * YS + c8 * 8), yf); unpack8(gpre[q], gf);
                    float o[8];
#pragma unroll
                    for (int z = 0; z < 8; ++z) o[z] = yf[z] * gf[z] * __builtin_amdgcn_rcpf(1.0f + __expf(-gf[z]));
                    v4u w; w.x = pk2(o[0], o[1]); w.y = pk2(o[2], o[3]); w.z = pk2(o[4], o[5]); w.w = pk2(o[6], o[7]);
                    *(v4u*)(ARET + (t0 + tkn) * 1024 + h * RDV + c8 * 8) = w; }
            }
        }
#undef R3_PREFETCH
        { auto dw_ = [&]() { defer_weights(2560, 3584); }; SEAM_WITH(4, dw_); }
    }

    if (IN(5)) {
        pg8::Gemm g{XN, WIN + (size_t)3072 * D, T, 5120, D, D, 0}; pg8::StaticOrder S; S.init(T, 5120, F.G, (int)blockIdx.x);
        pg8::EpiConvGates E{CB, UU, GATES};
        pg8::gemm_phase<pg8::EpiConvGates, pg8::StaticOrder, true>(ldsl, g, S, E);
        { auto dw_ = [&]() { defer_weights(3584, 4096); }; SEAM_WITH(5, dw_); }
    }

    if (IN(6)) {
        for (int it = F.gt; it < (T / 8) * 128; it += F.NGT) {
            const int c8 = it & 127, t0 = (it >> 7) * 8, s0 = t0 & (SEQ - 1); const int col = c8 * 8;
            v4u uw[10], cw[8];
#pragma unroll
            for (int r = 0; r < 8; ++r) { uw[r + 2] = *(const v4u*)(UU + (size_t)(t0 + r) * 1024 + col); cw[r] = *(const v4u*)(CB + (size_t)(t0 + r) * 1024 + col); }
            if (s0 != 0) { uw[0] = *(const v4u*)(UU + (size_t)(t0 - 2) * 1024 + col); uw[1] = *(const v4u*)(UU + (size_t)(t0 - 1) * 1024 + col); }
            else { uw[0] = (v4u){0u, 0u, 0u, 0u}; uw[1] = (v4u){0u, 0u, 0u, 0u}; }
            float w0[8], w1[8], w2[8], bs[8];
            *(f32x4*)w0 = *(const f32x4*)(conv_w + col); *(f32x4*)(w0 + 4) = *(const f32x4*)(conv_w + col + 4);
            *(f32x4*)w1 = *(const f32x4*)(conv_w + 1024 + col); *(f32x4*)(w1 + 4) = *(const f32x4*)(conv_w + 1024 + col + 4);
            *(f32x4*)w2 = *(const f32x4*)(conv_w + 2048 + col); *(f32x4*)(w2 + 4) = *(const f32x4*)(conv_w + 2048 + col + 4);
            *(f32x4*)bs = *(const f32x4*)(conv_b + col); *(f32x4*)(bs + 4) = *(const f32x4*)(conv_b + col + 4);
            float ua[8], ub[8], uc[8];
            unpack8(uw[0], ua); unpack8(uw[1], ub);
#pragma unroll
            for (int r = 0; r < 8; ++r) {
                float cb[8], o[8]; unpack8(uw[r + 2], uc); unpack8(cw[r], cb);
#pragma unroll
                for (int z = 0; z < 8; ++z) { o[z] = cb[z] * (w0[z] * ua[z] + w1[z] * ub[z] + w2[z] * uc[z] + bs[z]); ua[z] = ub[z]; ub[z] = uc[z]; }
                v4u w; w.x = pk2(o[0], o[1]); w.y = pk2(o[2], o[3]); w.z = pk2(o[4], o[5]); w.w = pk2(o[6], o[7]);
                *(v4u*)(ACONV + (size_t)(t0 + r) * 1024 + col) = w;
            }
        }
        { auto dw_ = [&]() { defer_weights(4096, 5120); }; SEAM_WITH(6, dw_); }
    }


    if (IN(8)) {
        pg8::StaticOrder S; S.init(T, D, F.G, (int)blockIdx.x);
        { pg8::Gemm g{ARET, WRU, T, D, D, D, 0}; pg8::EpiGate<false> E{M1, D, GATES, 2048, 0};
          pg8::gemm_phase<pg8::EpiGate<false>, pg8::StaticOrder, true>(ldsl, g, S, E); }
        asm volatile("s_waitcnt vmcnt(0)" ::: "memory"); __syncthreads();
        { pg8::Gemm g{ACONV, WCU, T, D, D, D, 0}; pg8::EpiGate<true> E{M1, D, GATES, 2048, 1024};
          pg8::gemm_phase<pg8::EpiGate<true>, pg8::StaticOrder, true>(ldsl, g, S, E); }
        { auto dw_ = [&]() { defer_weights(5120, 5760); }; SEAM_WITH(8, dw_); }
    }

    if (IN(9)) {
        pg8::Gemm g{M1, WOUT, T, D, D, D, 0}; pg8::StaticOrder S; S.init(T, D, F.G, (int)blockIdx.x);
        pg8::EpiResBf16SS E{x, HB, SS1, D, T, XQ, XS};
        pg8::gemm_phase<pg8::EpiResBf16SS, pg8::StaticOrder, true>(ldsl, g, S, E);
        SEAM(9);
    }


    if (IN(11)) {
        { pg8::Gemm g{HB, WPQ, T, 2048, D, D, 0, 1}; pg8::StaticOrder S; S.init(T, 2048, F.G, (int)blockIdx.x);
          pg8::EpiBf16 E{QP, 2048};
          pg8::gemm_phase<pg8::EpiBf16, pg8::StaticOrder, true>(ldsl, g, S, E); }
        {
            auto stage = [&]() { constexpr int LS = 136; bf16* k1s = (bf16*)lds; bf16* k2s = k1s + 128 * LS; const int h = blockIdx.x & 7; const int tt_ = F.tid - 64; v4u s1_[5], s2_[5];
#pragma unroll
                for (int q = 0; q < 5; ++q) { int c = tt_ + q * 448; c = c < 2048 ? c : 2047; const int j = c >> 4, c8 = c & 15; s1_[q] = *(const v4u*)(K1 + ((size_t)h * 128 + j) * 128 + c8 * 8); s2_[q] = *(const v4u*)(K2 + ((size_t)h * 128 + j) * 128 + c8 * 8); }
#pragma unroll
                for (int q = 0; q < 5; ++q) { const int c = tt_ + q * 448; if (c < 2048) { const int j = c >> 4, c8 = c & 15; *(v4u*)(k1s + j * LS + c8 * 8) = s1_[q]; *(v4u*)(k2s + j * LS + c8 * 8) = s2_[q]; } } };
            SEAM_WITH(11, stage);
        }
    }

    if (IN(12)) {
        constexpr int LS = 136;
        bf16* k1s = (bf16*)lds; bf16* k2s = k1s + 128 * LS;
        const int h = blockIdx.x & 7;
        const int r32 = F.lane & 31, hg = F.lane >> 5;
        const int nwv = (F.G >> 3) * NWAVES;
        volatile LAS unsigned* vlw = (volatile LAS unsigned*)((LAS unsigned char*)lds + 71680 + F.wave * 4096) + (hg * 16) * 32 + r32;
        volatile LAS unsigned* vlr = (volatile LAS unsigned*)((LAS unsigned char*)lds + 71680 + F.wave * 4096) + r32;
        for (int tt = (blockIdx.x >> 3) * NWAVES + F.wave; tt < T / 32; tt += nwv) {
            const int t0 = tt * 32;
            unsigned V1[16], V2[16];
            peer_half_topk(QP + (size_t)(t0 + r32) * 2048 + h * 256 + 8 * hg, k1s + r32 * 136 + 8 * hg, hg, V1);
            __builtin_amdgcn_sched_barrier(0);
            peer_half_topk(QP + (size_t)(t0 + r32) * 2048 + h * 256 + 128 + 8 * hg, k2s + r32 * 136 + 8 * hg, hg, V2);
            __builtin_amdgcn_sched_barrier(0);
            float v1[16], v2[16];
#pragma unroll
            for (int z = 0; z < 16; ++z) { v1[z] = ord_val(V1[z] & ~0x7Fu); v2[z] = ord_val(V2[z] & ~0x7Fu); }
#define CKEY(a, b) ((ord_key(v1[a] + v2[b]) & ~0xFFu) | (unsigned)(255 - ((a) * 16 + (b))))
            unsigned g0[16], g1[16], g2[16], g3[16];
#pragma unroll
            for (int b = 0; b < 16; ++b) g0[b] = CKEY(0, b);
#pragma unroll
            for (int b = 0; b < 8; ++b) g1[b] = CKEY(1, b);
#pragma unroll
            for (int b = 0; b < 5; ++b) g1[8 + b] = CKEY(2, b);
#pragma unroll
            for (int b = 0; b < 3; ++b) g1[13 + b] = CKEY(3, b);
            g2[0] = CKEY(3, 3);
#pragma unroll
            for (int b = 0; b < 3; ++b) g2[1 + b] = CKEY(4, b);
#pragma unroll
            for (int b = 0; b < 2; ++b) { g2[4 + b] = CKEY(5, b); g2[6 + b] = CKEY(6, b); g2[8 + b] = CKEY(7, b); }
#pragma unroll
            for (int a = 8; a < 14; ++a) g2[10 + (a - 8)] = CKEY(a, 0);
            { const unsigned c14 = CKEY(14, 0), c15 = CKEY(15, 0); g3[0] = max(c14, c15); g3[1] = min(c14, c15); }
#pragma unroll
            for (int z = 2; z < 16; ++z) g3[z] = 0u;
#undef CKEY
            sort16_desc(g1); sort16_desc(g2); merge16_desc(g1, g2); merge16_desc(g1, g3); merge16_desc(g0, g1);
            float ts[16], ex[16]; float den = 0.f;
            float rs1;
            { const f32x4* sp = (const f32x4*)(SS1 + (size_t)(t0 + r32) * 16); const f32x4 s0 = sp[0], s1 = sp[1], s2 = sp[2], s3 = sp[3];
              const float ssum = ((s0[0] + s0[1]) + (s0[2] + s0[3])) + ((s1[0] + s1[1]) + (s1[2] + s1[3])) + ((s2[0] + s2[1]) + (s2[2] + s2[3])) + ((s3[0] + s3[1]) + (s3[2] + s3[3]));
              rs1 = 1.0f / sqrtf(ssum * (1.f / D) + EPS); }
#pragma unroll
            for (int z = 0; z < 16; ++z) ts[z] = ord_val(g0[z] & ~0xFFu) * rs1;
#pragma unroll
            for (int z = 0; z < 16; ++z) { ex[z] = __expf(ts[z] - ts[0]); den += ex[z]; }
            const float inv = 1.0f / den;
#pragma unroll
            for (int z = 0; z < 16; ++z) { unsigned va_ = V1[z], vb_ = V2[z]; asm volatile("" : "+v"(va_), "+v"(vb_)); vlw[z * 32] = hg ? vb_ : va_; }
            asm volatile("s_waitcnt lgkmcnt(0)" ::: "memory"); __builtin_amdgcn_wave_barrier();
            int oi[8]; float og[8];
#pragma unroll
            for (int rr = 0; rr < 8; ++rr) {
                unsigned klo = g0[rr], khi = g0[8 + rr]; float elo = ex[rr], ehi = ex[8 + rr];
                asm volatile("" : "+v"(klo), "+v"(khi), "+v"(elo), "+v"(ehi));
                const unsigned key = hg ? khi : klo; const int c = 255 - (int)(key & 0xFFu); const int a = c >> 4, b = c & 15;
                const unsigned ka = vlr[a * 32], kb2 = vlr[(16 + b) * 32];
                oi[rr] = (127 - (int)(ka & 0x7Fu)) * PNK + (127 - (int)(kb2 & 0x7Fu));
                og[rr] = (hg ? ehi : elo) * inv;
            }
            asm volatile("s_waitcnt lgkmcnt(0)" ::: "memory"); __builtin_amdgcn_wave_barrier();
            int* ip = IDX + (size_t)(t0 + r32) * NSEL + h * PTOPK + 8 * hg; float* gp = GATE + (size_t)(t0 + r32) * NSEL + h * PTOPK + 8 * hg;
            *(v4u*)ip = (v4u){(unsigned)oi[0], (unsigned)oi[1], (unsigned)oi[2], (unsigned)oi[3]}; *(v4u*)(ip + 4) = (v4u){(unsigned)oi[4], (unsigned)oi[5], (unsigned)oi[6], (unsigned)oi[7]};
            *(f32x4*)gp = (f32x4){og[0], og[1], og[2], og[3]}; *(f32x4*)(gp + 4) = (f32x4){og[4], og[5], og[6], og[7]};
        }
        SEAM(12);
    }

    if (IN(13)) {
        volatile int* item_w = (volatile int*)(lds + 1024);
        const int s8 = F.lane & 7, r8 = F.lane >> 3; const int xcc = (int)(xb_xcc_id() & 7u);
        const unsigned so16 = (unsigned)s8 * 16u;
        constexpr unsigned NCHK = (unsigned)(T / 64);
#define P13_OPS(IDA, IDB, XA, XSC, itv) do { const int j_ = (itv) >> 16, tb_ = ((itv) & 0xffff) * 64 + F.wave * 8; \
            _Pragma("unroll") for (int tt = 0; tt < 8; ++tt) { IDA[tt] = IDX[(size_t)(tb_ + tt) * NSEL + F.lane]; IDB[tt] = IDX[(size_t)(tb_ + tt) * NSEL + 64 + F.lane]; \
                XA[tt] = *(const v4u*)(XQ + (size_t)(tb_ + tt) * D + 128 * j_ + 16 * s8); XSC[tt] = XS[(size_t)(tb_ + tt) * 32 + 4 * j_ + (s8 >> 1)]; } } while (0)
#define P13_ROWS(buf, idv, tab) do { _Pragma("unroll") for (int g = 0; g < 8; ++g) { const unsigned id = (unsigned)__shfl((idv), 8 * g + r8); buf[g] = *(const v4u*)((tab) + (id * 128u + so16)); } } while (0)
#define P13_DOT(buf, hh, xq, sx, pp) do { \
                _Pragma("unroll") for (int g = 0; g < 8; ++g) { int d_ = __builtin_amdgcn_sdot4((int)buf[g].x, xq[0], 0, false); d_ = __builtin_amdgcn_sdot4((int)buf[g].y, xq[1], d_, false); \
                    d_ = __builtin_amdgcn_sdot4((int)buf[g].z, xq[2], d_, false); d_ = __builtin_amdgcn_sdot4((int)buf[g].w, xq[3], d_, false); \
                    pp[8 * (hh) + g] = (float)d_ * sx; } } while (0)
        __syncthreads();
        if (F.tid == 0) { int it = -1;
            for (int k = 0; k < 8 && it < 0; ++k) { const int jj = (xcc + k) & 7; const unsigned cc = __hip_atomic_fetch_add(WCNT + jj, 1u, __ATOMIC_RELAXED, __HIP_MEMORY_SCOPE_AGENT); if (cc < NCHK) it = (jj << 16) | (int)cc; }
            item_w[0] = it; }
        __syncthreads();
        int item = item_w[0], slot = 0;
        int ida[8], idb[8]; v4u xa[8]; float xsc[8];
        v4u rowsA[8], rowsB[8];
        if (item >= 0) { P13_OPS(ida, idb, xa, xsc, item); P13_ROWS(rowsA, ida[0], U8 + (size_t)__builtin_amdgcn_readfirstlane(item >> 16) * PNE_ROWS * 128); }
#pragma unroll 1
        while (item >= 0) {
            const int j = item >> 16, ch = item & 0xffff;
            const unsigned char* tabj = U8 + (size_t)__builtin_amdgcn_readfirstlane(j) * PNE_ROWS * 128;
            const int tb = ch * 64 + F.wave * 8;
            unsigned ccn = 0;
            if (F.tid == 0) ccn = __hip_atomic_fetch_add(WCNT + xcc, 1u, __ATOMIC_RELAXED, __HIP_MEMORY_SCOPE_AGENT);
            int item_n = -1;
            int ida_n[8], idb_n[8]; v4u xa_n[8]; float xsc_n[8];
            const unsigned char* tabn = tabj;
#pragma unroll
            for (int tt = 0; tt < 8; ++tt) {
                if (tt == 4) {
                    if (F.tid == 0) item_w[slot ^ 1] = ccn < NCHK ? ((xcc << 16) | (int)ccn) : -2;
                    __syncthreads();
                    item_n = item_w[slot ^ 1];
                    const int item_c = item_n >= 0 ? item_n : item;
                    P13_OPS(ida_n, idb_n, xa_n, xsc_n, item_c);
                    tabn = U8 + (size_t)__builtin_amdgcn_readfirstlane(item_c >> 16) * PNE_ROWS * 128;
                }
                float pp[16];
                P13_ROWS(rowsB, idb[tt], tabj);
                const float sx = xsc[tt]; int xq[4]; xq[0] = (int)xa[tt].x; xq[1] = (int)xa[tt].y; xq[2] = (int)xa[tt].z; xq[3] = (int)xa[tt].w;
                P13_DOT(rowsA, 0, xq, sx, pp); __builtin_amdgcn_sched_barrier(0);
                if (tt < 7) P13_ROWS(rowsA, ida[tt + 1], tabj); else P13_ROWS(rowsA, ida_n[0], tabn);
                P13_DOT(rowsB, 1, xq, sx, pp);
                float rr[8];
                asm volatile("s_nop 1\n"
                    "v_add_f32_dpp %0, %8, %8 row_half_mirror row_mask:0xf bank_mask:0xf\n"   "v_add_f32_dpp %0, %16, %16 row_half_mirror row_mask:0xf bank_mask:0xa\n"
                    "v_add_f32_dpp %1, %9, %9 row_half_mirror row_mask:0xf bank_mask:0xf\n"   "v_add_f32_dpp %1, %17, %17 row_half_mirror row_mask:0xf bank_mask:0xa\n"
                    "v_add_f32_dpp %2, %10, %10 row_half_mirror row_mask:0xf bank_mask:0xf\n" "v_add_f32_dpp %2, %18, %18 row_half_mirror row_mask:0xf bank_mask:0xa\n"
                    "v_add_f32_dpp %3, %11, %11 row_half_mirror row_mask:0xf bank_mask:0xf\n" "v_add_f32_dpp %3, %19, %19 row_half_mirror row_mask:0xf bank_mask:0xa\n"
                    "v_add_f32_dpp %4, %12, %12 row_half_mirror row_mask:0xf bank_mask:0xf\n" "v_add_f32_dpp %4, %20, %20 row_half_mirror row_mask:0xf bank_mask:0xa\n"
                    "v_add_f32_dpp %5, %13, %13 row_half_mirror row_mask:0xf bank_mask:0xf\n" "v_add_f32_dpp %5, %21, %21 row_half_mirror row_mask:0xf bank_mask:0xa\n"
                    "v_add_f32_dpp %6, %14, %14 row_half_mirror row_mask:0xf bank_mask:0xf\n" "v_add_f32_dpp %6, %22, %22 row_half_mirror row_mask:0xf bank_mask:0xa\n"
                    "v_add_f32_dpp %7, %15, %15 row_half_mirror row_mask:0xf bank_mask:0xf\n" "v_add_f32_dpp %7, %23, %23 row_half_mirror row_mask:0xf bank_mask:0xa\n"
                    "v_add_f32_dpp %0, %0, %0 quad_perm:[1,0,3,2] row_mask:0xf bank_mask:0xf\n" "v_add_f32_dpp %1, %1, %1 quad_perm:[1,0,3,2] row_mask:0xf bank_mask:0xf\n"
                    "v_add_f32_dpp %2, %2, %2 quad_perm:[1,0,3,2] row_mask:0xf bank_mask:0xf\n" "v_add_f32_dpp %3, %3, %3 quad_perm:[1,0,3,2] row_mask:0xf bank_mask:0xf\n"
                    "v_add_f32_dpp %4, %4, %4 quad_perm:[1,0,3,2] row_mask:0xf bank_mask:0xf\n" "v_add_f32_dpp %5, %5, %5 quad_perm:[1,0,3,2] row_mask:0xf bank_mask:0xf\n"
                    "v_add_f32_dpp %6, %6, %6 quad_perm:[1,0,3,2] row_mask:0xf bank_mask:0xf\n" "v_add_f32_dpp %7, %7, %7 quad_perm:[1,0,3,2] row_mask:0xf bank_mask:0xf\n"
                    "v_add_f32_dpp %0, %0, %0 quad_perm:[2,3,0,1] row_mask:0xf bank_mask:0xf\n" "v_add_f32_dpp %1, %1, %1 quad_perm:[2,3,0,1] row_mask:0xf bank_mask:0xf\n"
                    "v_add_f32_dpp %2, %2, %2 quad_perm:[2,3,0,1] row_mask:0xf bank_mask:0xf\n" "v_add_f32_dpp %3, %3, %3 quad_perm:[2,3,0,1] row_mask:0xf bank_mask:0xf\n"
                    "v_add_f32_dpp %4, %4, %4 quad_perm:[2,3,0,1] row_mask:0xf bank_mask:0xf\n" "v_add_f32_dpp %5, %5, %5 quad_perm:[2,3,0,1] row_mask:0xf bank_mask:0xf\n"
                    "v_add_f32_dpp %6, %6, %6 quad_perm:[2,3,0,1] row_mask:0xf bank_mask:0xf\n" "v_add_f32_dpp %7, %7, %7 quad_perm:[2,3,0,1] row_mask:0xf bank_mask:0xf\n"
                    : "=&v"(rr[0]), "=&v"(rr[1]), "=&v"(rr[2]), "=&v"(rr[3]), "=&v"(rr[4]), "=&v"(rr[5]), "=&v"(rr[6]), "=&v"(rr[7])
                    : "v"(pp[0]), "v"(pp[1]), "v"(pp[2]), "v"(pp[3]), "v"(pp[4]), "v"(pp[5]), "v"(pp[6]), "v"(pp[7]),
                      "v"(pp[8]), "v"(pp[9]), "v"(pp[10]), "v"(pp[11]), "v"(pp[12]), "v"(pp[13]), "v"(pp[14]), "v"(pp[15]));
                {
                    const unsigned p0_ = pk2(rr[0], rr[1]), p1_ = pk2(rr[2], rr[3]), p2_ = pk2(rr[4], rr[5]), p3_ = pk2(rr[6], rr[7]);
                    const unsigned plo_ = (s8 & 1) ? p1_ : p0_, phi_ = (s8 & 1) ? p3_ : p2_;
                    ((unsigned*)PACT)[((size_t)j * T + (tb + tt)) * 64 + 8 * s8 + r8] = (s8 & 2) ? phi_ : plo_; }
                __builtin_amdgcn_sched_barrier(0);
            }
            if (item_n == -2) {
                __syncthreads();
                if (F.tid == 0) { int it = -1;
                    for (int k = 1; k < 8 && it < 0; ++k) { const int jj = (xcc + k) & 7; const unsigned cc = __hip_atomic_fetch_add(WCNT + jj, 1u, __ATOMIC_RELAXED, __HIP_MEMORY_SCOPE_AGENT); if (cc < NCHK) it = (jj << 16) | (int)cc; }
                    item_w[slot ^ 1] = it; }
                __syncthreads();
                item_n = item_w[slot ^ 1];
                if (item_n >= 0) { P13_OPS(ida_n, idb_n, xa_n, xsc_n, item_n); P13_ROWS(rowsA, ida_n[0], U8 + (size_t)__builtin_amdgcn_readfirstlane(item_n >> 16) * PNE_ROWS * 128); }
            }
            item = item_n; slot ^= 1;
#pragma unroll
            for (int tt = 0; tt < 8; ++tt) { ida[tt] = ida_n[tt]; idb[tt] = idb_n[tt]; xa[tt] = xa_n[tt]; xsc[tt] = xsc_n[tt]; }
        }
#undef P13_OPS
#undef P13_ROWS
#undef P13_DOT
        {
            auto fillsc = [&]() { const int tt_ = F.tid - 64; unsigned* sct = (unsigned*)(lds + 34816);
#pragma unroll
                for (int q = 0; q < 10; ++q) { int c = tt_ + q * 448; const bool ok = c < PNE / 4; c = ok ? c : PNE / 4 - 1;
                    const f32x4 a_ = ((const f32x4*)SU)[c], b_ = ((const f32x4*)SV)[c];
                    if (ok) *(v4u*)(sct + 4 * c) = (v4u){pk2(a_[0], b_[0]), pk2(a_[1], b_[1]), pk2(a_[2], b_[2]), pk2(a_[3], b_[3])}; } };
            SEAM_WITH(13, fillsc);
        }
    }

    if (IN(14)) {
        unsigned* tl = (unsigned*)lds;
        const unsigned* sct = (const unsigned*)(lds + 34816);
        const unsigned ldsb = (unsigned)(size_t)(LAS unsigned char*)lds;
        float ssv[4], nsv[4]; unsigned pw[4][8][2], npw[4][8][2]; int i0_[4], i1_[4], ni0[4], ni1[4]; float gg0[4], gg1[4], ng0[4], ng1[4];
#define P14_LOAD(SSV, PW, I0, I1, G0, G1, chv, tqv) do { const int tg0_ = (chv) * 64 + F.wave * 8 + 4 * (tqv); \
            _Pragma("unroll") for (int u = 0; u < 4; ++u) { const int t = tg0_ + u; \
                SSV[u] = SS1[(size_t)t * 16 + (F.lane & 15)]; \
                _Pragma("unroll") for (int j = 0; j < 8; ++j) { const unsigned* pa = (const unsigned*)PACT + ((size_t)j * T + t) * 64 + 8 * (F.lane >> 4) + (F.lane & 7); PW[u][j][0] = pa[0]; PW[u][j][1] = pa[32]; } \
                I0[u] = IDX[(size_t)t * NSEL + F.lane]; I1[u] = IDX[(size_t)t * NSEL + 64 + F.lane]; \
                G0[u] = GATE[(size_t)t * NSEL + F.lane]; G1[u] = GATE[(size_t)t * NSEL + 64 + F.lane]; } } while (0)
        int ch = blockIdx.x, tq4 = 0;
        P14_LOAD(ssv, pw, i0_, i1_, gg0, gg1, (ch < T / 64 ? ch : 0), 0);
#pragma unroll 1
        while (ch < T / 64) {
            int chn = ch, tqn = tq4 + 1; if (tqn == 2) { tqn = 0; chn = ch + F.G; }
            const bool hasn = chn < T / 64;
            if (tq4 == 0) __syncthreads();
            P14_LOAD(nsv, npw, ni0, ni1, ng0, ng1, (hasn ? chn : ch), (hasn ? tqn : tq4));
            {
                const int tl0 = F.wave * 8 + 4 * tq4, tg0 = ch * 64 + tl0;
                float su0[4], su1[4], sv0[4], sv1[4];
#pragma unroll
                for (int u = 0; u < 4; ++u) { const unsigned p0_ = sct[i0_[u]], p1_ = sct[i1_[u]]; su0[u] = bflo(p0_); sv0[u] = bfhi(p0_); su1[u] = bflo(p1_); sv1[u] = bfhi(p1_); }
#pragma unroll
                for (int u = 0; u < 4; ++u) { const int tloc = tl0 + u, t = tg0 + u;
                    const float ssum = wave_sum(F.lane < 16 ? ssv[u] : 0.f);
                    const float rs1 = 1.0f / sqrtf(ssum * (1.f / D) + EPS);
                    float a0 = 0.f, a1 = 0.f;
#pragma unroll
                    for (int j = 0; j < 8; ++j) { const unsigned w0_ = pw[u][j][0], w1_ = pw[u][j][1]; a0 += (F.lane & 8) ? bfhi(w0_) : bflo(w0_); a1 += (F.lane & 8) ? bfhi(w1_) : bflo(w1_); }
                    const int id0 = i0_[u], id1 = i1_[u];
                    const float w0 = gg0[u] * gelu_f(a0 * rs1 * su0[u]) * sv0[u], w1 = gg1[u] * gelu_f(a1 * rs1 * su1[u]) * sv1[u];
                    const float am = wave_max(fmaxf(fabsf(w0), fabsf(w1))); const float qs = am > 0.f ? 127.0f * __builtin_amdgcn_rcpf(am) : 0.f;
                    tl[F.lane * 65 + tloc] = ((((unsigned)id0 << 3) + ldsb) << 8) | ((unsigned)((int)rintf(w0 * qs)) & 0xffu);
                    tl[(64 + F.lane) * 65 + tloc] = ((((unsigned)id1 << 3) + ldsb) << 8) | ((unsigned)((int)rintf(w1 * qs)) & 0xffu);
                    if (F.lane == 0) WSC[t] = am * (1.0f / 127.0f); }
            }
            if (tq4 == 1) {
                __syncthreads();
#pragma unroll
                for (int q = 0; q < 4; ++q) { const int c = F.tid + q * NTHREADS, q4_ = c >> 6, tl_ = c & 63; const unsigned* tq = tl + (4 * q4_) * 65 + tl_;
                    ((v4u*)KK)[(size_t)q4_ * T + ch * 64 + tl_] = (v4u){tq[0] >> 8, tq[65] >> 8, tq[130] >> 8, tq[195] >> 8}; }
                {   const int o8_ = F.tid >> 6, tl_ = F.tid & 63; const unsigned* tq = tl + (16 * o8_) * 65 + tl_; unsigned wq[4];
#pragma unroll
                    for (int i = 0; i < 4; ++i) wq[i] = (tq[(4 * i) * 65] & 0xffu) | ((tq[(4 * i + 1) * 65] & 0xffu) << 8) | ((tq[(4 * i + 2) * 65] & 0xffu) << 16) | (tq[(4 * i + 3) * 65] << 24);
                    ((v4u*)W4)[(size_t)o8_ * T + ch * 64 + tl_] = (v4u){wq[0], wq[1], wq[2], wq[3]}; }
            }
#pragma unroll
            for (int u = 0; u < 4; ++u) { ssv[u] = nsv[u]; i0_[u] = ni0[u]; i1_[u] = ni1[u]; gg0[u] = ng0[u]; gg1[u] = ng1[u];
#pragma unroll
                for (int j = 0; j < 8; ++j) { pw[u][j][0] = npw[u][j][0]; pw[u][j][1] = npw[u][j][1]; } }
            ch = chn; tq4 = tqn;
        }
#undef P14_LOAD
        {
            const int sl0 = ((int)blockIdx.x < 256 ? (int)blockIdx.x : 0) >> 1;
            auto fill = [&]() { const int tt_ = F.tid - 64; const v4u* srcv = (const v4u*)(V8 + (size_t)sl0 * PNE_ROWS * 8); v4u fl_[19];
#pragma unroll
                for (int q = 0; q < 19; ++q) { const int c = tt_ + q * 448; fl_[q] = srcv[c < 8192 ? c : 8191]; }
#pragma unroll
                for (int q = 0; q < 19; ++q) { const int c = tt_ + q * 448; if (c < 8192) *((v4u*)lds + c) = fl_[q]; } };
            SEAM_WITH(14, fill);
        }
    }

    if (IN(7)) {
        const __amdgpu_buffer_rsrc_t rsK = __builtin_amdgcn_make_buffer_rsrc((void*)KK, 0, NSEL * T * 4, 0x00020000);
        const __amdgpu_buffer_rsrc_t rsW = __builtin_amdgcn_make_buffer_rsrc((void*)W4, 0, (NSEL / 4) * T * 4, 0x00020000);
        for (int work = blockIdx.x; work < 256; work += F.G) {
            const int sl = work >> 1, tbase = (work & 1) * (T / 2);
            if (work != (int)blockIdx.x) {
                __syncthreads();
                {   v4u fl_[16];
#pragma unroll
                    for (int q = 0; q < 16; ++q) fl_[q] = *((const v4u*)(V8 + (size_t)sl * PNE_ROWS * 8) + F.tid + q * NTHREADS);
#pragma unroll
                    for (int q = 0; q < 16; ++q) *((v4u*)lds + F.tid + q * NTHREADS) = fl_[q]; }
                __syncthreads();
            }
            unsigned kc[4][32], wc[4][8];
#define P7_KEYS(bufv, tokv, chv) do { const int ko_ = (tokv) * 16; \
                _Pragma("unroll") for (int q = 0; q < 8; ++q) { const v4u k4_ = __builtin_bit_cast(v4u, __builtin_amdgcn_raw_buffer_load_b128(rsK, ko_, (8 * (chv) + q) * (T * 16), 0)); \
                    kc[bufv][4 * q] = k4_.x; kc[bufv][4 * q + 1] = k4_.y; kc[bufv][4 * q + 2] = k4_.z; kc[bufv][4 * q + 3] = k4_.w; } \
                _Pragma("unroll") for (int q = 0; q < 2; ++q) { const v4u w4v_ = __builtin_bit_cast(v4u, __builtin_amdgcn_raw_buffer_load_b128(rsW, ko_, (2 * (chv) + q) * (T * 16), 0)); \
                    wc[bufv][4 * q] = w4v_.x; wc[bufv][4 * q + 1] = w4v_.y; wc[bufv][4 * q + 2] = w4v_.z; wc[bufv][4 * q + 3] = w4v_.w; } } while (0)
#define P7_LD(buf, ckv, e8v) do { _Pragma("unroll") for (int q = 0; q < 8; ++q) buf[q] = *(const LAS v2u*)(unsigned)(kc[ckv][8 * (e8v) + q]); } while (0)
#define P7_PROC(vr, ckv, e8v) do { _Pragma("unroll") for (int g4 = 0; g4 < 2; ++g4) { \
                            const int w4_ = (int)wc[ckv][2 * (e8v) + g4]; \
                            _Pragma("unroll") for (int c4 = 0; c4 < 2; ++c4) { const unsigned a_ = vr[4 * g4][c4], b_ = vr[4 * g4 + 1][c4], c_ = vr[4 * g4 + 2][c4], d_ = vr[4 * g4 + 3][c4]; \
                                const unsigned t0_ = __builtin_amdgcn_perm(b_, a_, 0x05010400u), t1_ = __builtin_amdgcn_perm(b_, a_, 0x07030602u), t2_ = __builtin_amdgcn_perm(d_, c_, 0x05010400u), t3_ = __builtin_amdgcn_perm(d_, c_, 0x07030602u); \
                                acci[4 * c4 + 0] = __builtin_amdgcn_sdot4((int)__builtin_amdgcn_perm(t2_, t0_, 0x05040100u), w4_, acci[4 * c4 + 0], false); \
                                acci[4 * c4 + 1] = __builtin_amdgcn_sdot4((int)__builtin_amdgcn_perm(t2_, t0_, 0x07060302u), w4_, acci[4 * c4 + 1], false); \
                                acci[4 * c4 + 2] = __builtin_amdgcn_sdot4((int)__builtin_amdgcn_perm(t3_, t1_, 0x05040100u), w4_, acci[4 * c4 + 2], false); \
                                acci[4 * c4 + 3] = __builtin_amdgcn_sdot4((int)__builtin_amdgcn_perm(t3_, t1_, 0x07060302u), w4_, acci[4 * c4 + 3], false); } } } while (0)
            constexpr int NGRPW = T / 2 / 64 / NWAVES;
            int t = tbase + F.wave * 64 + F.lane;
            P7_KEYS(0, t, 0); P7_KEYS(1, t, 1);
#pragma unroll 1
            for (int gi = 0; gi < NGRPW; ++gi, t += 64 * NWAVES) {
                const int tn = gi + 1 < NGRPW ? t + 64 * NWAVES : t;
                const float wsc = WSC[t];
                v4u* hp = (v4u*)(HB + ((size_t)sl * T + t) * 8);
                const v4u hv = *hp;
                int acci[8];
#pragma unroll
                for (int z = 0; z < 8; ++z) acci[z] = 0;
                v2u vr3[3][8];
                P7_LD(vr3[0], 0, 0); P7_LD(vr3[1], 0, 1);
#pragma unroll
                for (int s = 0; s < 16; ++s) {
                    if ((s & 3) == 0) { const int ck = s >> 2; if (ck < 2) P7_KEYS(ck + 2, t, ck + 2); else P7_KEYS(ck - 2, tn, ck - 2); }
                    if (s + 2 < 16) P7_LD(vr3[(s + 2) % 3], (s + 2) >> 2, (s + 2) & 3);
                    __builtin_amdgcn_sched_barrier(0); P7_PROC(vr3[s % 3], s >> 2, s & 3); __builtin_amdgcn_sched_barrier(0);
                }
                float hf[8]; unpack8(hv, hf);
                float ssq = 0.f;
#pragma unroll
                for (int z = 0; z < 8; ++z) { hf[z] += (float)acci[z] * wsc; ssq += hf[z] * hf[z]; }
                v4u o; o.x = pk2(hf[0], hf[1]); o.y = pk2(hf[2], hf[3]); o.z = pk2(hf[4], hf[5]); o.w = pk2(hf[6], hf[7]);
                *hp = o;
                SSP[(size_t)sl * T + t] = ssq;
            }
#undef P7_KEYS
#undef P7_LD
#undef P7_PROC
        }
        SEAM(7);
    }


    if (IN(15)) {
        { pg8::Gemm gp{PB, WPP, T, D, PLE, PLE, 0}; pg8::StaticOrder Sp; Sp.init(T, D, F.G, (int)blockIdx.x);
          pg8::EpiBf16 Ep{PLEB, D};
          pg8::gemm_phase<pg8::EpiBf16, pg8::StaticOrder, true>(ldsl, gp, Sp, Ep); }
        pg8::Gemm g{HB, WPG, T, D, D, D, 0, 1}; pg8::StaticOrder S; S.init(T, D, F.G, (int)blockIdx.x);
        PG8_LAS float* rsl = (PG8_LAS float*)(ldsl + 131072); PG8_LAS int* rtag = (PG8_LAS int*)(ldsl + 131072 + 4096);
        if (F.tid < 4) rtag[F.tid] = -1;
        __syncthreads();
#pragma unroll
        for (int k = 0; k < 4; ++k) { pg8::Unit uu; uu.pm = 0; uu.pn = 0; if (!S.next(k, uu)) break;
            bool dup = false;
#pragma unroll
            for (int q = 0; q < 4; ++q) if (q < k) dup = dup || (rtag[q] == uu.pm);
            if (F.tid < 256) { float s_ = 0.f; const float* sp = SSP + (size_t)uu.pm * 256 + F.tid;
#pragma unroll 16
                for (int sl = 0; sl < 128; ++sl) s_ += sp[(size_t)sl * T];
                rsl[k * 256 + F.tid] = 1.0f / sqrtf(s_ * (1.f / D) + EPS); }
            if (F.tid == 0) rtag[k] = dup ? -2 : uu.pm;
            __syncthreads(); }
        pg8::EpiPleBf16SS E{HB, PLEB, H3B, rsl, rtag, SS3, D};
        pg8::gemm_phase<pg8::EpiPleBf16SS, pg8::StaticOrder, true>(ldsl, g, S, E);
        SEAM(15);
    }

    if (IN(16)) {
        const f32x4* gr = (const f32x4*)g_final + F.lane;
        f32x4 gg[4];
#pragma unroll
        for (int j = 0; j < 4; ++j) gg[j] = gr[64 * j];
        for (int m = F.gw; m < T / 2; m += F.NGW) {
            const int ma = m, mb = m + T / 2;
            float sa = 0.f, sb = 0.f;
            if (F.lane < 16) { sa = SS3[(size_t)ma * 16 + F.lane]; sb = SS3[(size_t)mb * 16 + F.lane]; }
            const v2u* ha = (const v2u*)(H3B + (size_t)ma * D) + F.lane; const v2u* hb = (const v2u*)(H3B + (size_t)mb * D) + F.lane;
            v2u wa[4], wb[4];
#pragma unroll
            for (int j = 0; j < 4; ++j) { wa[j] = ha[64 * j]; wb[j] = hb[64 * j]; }
            sa = wave_sum(sa); sb = wave_sum(sb);
            const float ra = 1.0f / sqrtf(sa * (1.f / D) + EPS), rb = 1.0f / sqrtf(sb * (1.f / D) + EPS);
            f32x4* oa = (f32x4*)(out + (size_t)ma * D) + F.lane; f32x4* ob = (f32x4*)(out + (size_t)mb * D) + F.lane;
#pragma unroll
            for (int j = 0; j < 4; ++j) {
                oa[64 * j] = (f32x4){bflo(wa[j].x) * ra * gg[j][0], bfhi(wa[j].x) * ra * gg[j][1], bflo(wa[j].y) * ra * gg[j][2], bfhi(wa[j].y) * ra * gg[j][3]};
                ob[64 * j] = (f32x4){bflo(wb[j].x) * rb * gg[j][0], bfhi(wb[j].x) * rb * gg[j][1], bflo(wb[j].y) * rb * gg[j][2], bfhi(wb[j].y) * rb * gg[j][3]}; }
        }
    }
#undef IN
#undef SEAM
}

constexpr int N_PHASES = 17;

extern "C" void kernel_launch(void* const* d_in, const int* in_sizes, int n_in, void* d_out, int out_size, void* d_ws, size_t ws_size, hipStream_t stream) {
    static int grid = 0;
    if (grid == 0) {
        if (n_in != 19 || out_size != T * D || ws_size < WS_END) { fprintf(stderr, "kernel_launch: unexpected shapes: n_in %d out %d ws %zu\n", n_in, out_size, ws_size); grid = -1; return; }
        int dev = 0, cus = 0, per_cu = 0;
        hipGetDevice(&dev); hipDeviceGetAttribute(&cus, hipDeviceAttributeMultiprocessorCount, dev);
        if (hipFuncSetAttribute((const void*)mega, hipFuncAttributeMaxDynamicSharedMemorySize, LDS_BYTES) != hipSuccess) { fprintf(stderr, "kernel_launch: hipFuncSetAttribute failed\n"); grid = -1; return; }
        if (hipOccupancyMaxActiveBlocksPerMultiprocessor(&per_cu, (const void*)mega, NTHREADS, LDS_BYTES) != hipSuccess || per_cu < 1) { fprintf(stderr, "kernel_launch: occupancy query says %d\n", per_cu); per_cu = 1; }
        (void)hipGetLastError();
        grid = cus;
        if (grid % 8 != 0) fprintf(stderr, "kernel_launch: grid %d not a multiple of 8\n", grid);
    }
    if (grid < 0) return;
    Args a{};
    for (int i = 0; i < 19; ++i) a.in[i] = (const float*)d_in[i];
    a.out = (float*)d_out; a.ws = (unsigned char*)d_ws;
#if MK_ONE_LAUNCH
    a.ph_lo = 0; a.ph_hi = N_PHASES;
    void* kargs[] = {&a};
    hipError_t e = hipLaunchCooperativeKernel((const void*)mega, dim3(grid), dim3(NTHREADS), kargs, LDS_BYTES, stream);
    if (e != hipSuccess) fprintf(stderr, "cooperative launch failed: %s (grid %d)\n", hipGetErrorString(e), grid);
#else
    for (int ph = 0; ph < N_PHASES; ++ph) {
        a.ph_lo = ph; a.ph_hi = ph + 1;
        hipLaunchKernelGGL(mega, dim3(grid), dim3(NTHREADS), LDS_BYTES, stream, a);
    }
#endif
}
```
